# Optimizing an MI355X kernel written in HIP

```python
import numpy as np
import jax
import jax.numpy as jnp
from jax import lax

D_MODEL = 4096
BATCH = 4
SEQ = 2048
DEPTH = 2

HEAD_DIM = 128
N_MIX_HEADS = D_MODEL // HEAD_DIM
ROPE_THETA = 10000.0
NORM_EPS = 1e-6
Q_BLOCK = 128
GATHER_Q_BLOCK = 16
TINY = 1e-30

MOBA_HEADS = N_MIX_HEADS // 2
MOBA_BLOCK = 256
MOBA_TOPK = 3
NSA_HEADS = N_MIX_HEADS - MOBA_HEADS
NSA_KV_GROUPS = 4
NSA_CMP_LEN = 32
NSA_CMP_STRIDE = 16
NSA_SEL_BLOCK = 64
NSA_SEL_TOPN = 16
NSA_WINDOW = 512
DIL_CONFIGS = ((128, 1), (512, 4), (2048, 16))
DIL_GROUPS = len(DIL_CONFIGS)
DIL_HEADS = N_MIX_HEADS // 4
SB_HEADS = N_MIX_HEADS - DIL_HEADS
MEM_LEN = 256
XATTN_HEADS = 4
FFN_HIDDEN = -((-8 * D_MODEL) // (3 * 256)) * 256

EVEN_SPLITS = (MOBA_HEADS * HEAD_DIM,) * 3 + (NSA_HEADS * HEAD_DIM,) + (NSA_KV_GROUPS * HEAD_DIM,) * 6 + (3 * NSA_HEADS,)
ODD_SPLITS = (SB_HEADS * HEAD_DIM,) * 3 + (DIL_GROUPS * DIL_HEADS * HEAD_DIM,) * 3
EVEN_COLS = sum(EVEN_SPLITS)
ODD_COLS = sum(ODD_SPLITS)

kernel_name = 'hybrid_moba_nsa_stickbreak_dilated'


def rms_norm(x, g):
    xf = x.astype(jnp.float32)
    y = xf * lax.rsqrt(jnp.mean(xf * xf, axis=-1, keepdims=True) + NORM_EPS)
    return (y * g.astype(jnp.float32)).astype(x.dtype)


def rope(x, pos):
    half = x.shape[-1] // 2
    inv_freq = ROPE_THETA ** (-jnp.arange(half, dtype=jnp.float32) / half)
    ang = pos.astype(jnp.float32)[:, None, :, None] * inv_freq
    cos = jnp.cos(ang).astype(x.dtype)
    sin = jnp.sin(ang).astype(x.dtype)
    x1, x2 = x[..., :half], x[..., half:]
    return jnp.concatenate([x1 * cos - x2 * sin, x1 * sin + x2 * cos], axis=-1)


def split_heads(y, n):
    b, t, _ = y.shape
    return y.reshape(b, t, n, -1).transpose(0, 2, 1, 3)


def merge_heads(y):
    b, h, t, d = y.shape
    return y.transpose(0, 2, 1, 3).reshape(b, t, h * d)


def split_cols(y, sizes):
    cuts = [int(c) for c in np.cumsum(sizes)[:-1]]
    return jnp.split(y, cuts, axis=-1)


def masked_softmax_lse(s, mask):
    s = jnp.where(mask, s, -jnp.inf)
    m = jnp.max(s, axis=-1, keepdims=True)
    m = jnp.where(jnp.isfinite(m), m, 0.0)
    e = jnp.exp(s - m)
    den = jnp.maximum(jnp.sum(e, axis=-1, keepdims=True), TINY)
    return e / den, (m + jnp.log(den))[..., 0]


def masked_softmax(s, mask):
    return masked_softmax_lse(s, mask)[0]


def sweep_queries(fn, n_queries, qb):
    outs = lax.map(fn, jnp.arange(n_queries // qb, dtype=jnp.int32) * qb)

    def assemble(o):
        n, b, h, _, d = o.shape
        return o.transpose(1, 2, 0, 3, 4).reshape(b, h, n_queries, d)
    return jax.tree_util.tree_map(assemble, outs)


def gather_blocks(blocks, idx):
    return jax.vmap(jax.vmap(lambda bl, ix: bl[ix]))(blocks, idx)


def moba_attention(q, k, v):
    b, h, t, d = q.shape
    scale = d ** -0.5
    nblk = -(-t // MOBA_BLOCK)
    pad = ((0, 0), (0, 0), (0, nblk * MOBA_BLOCK - t), (0, 0))
    kp, vp = jnp.pad(k, pad), jnp.pad(v, pad)
    kb = kp.reshape(b, h, nblk, MOBA_BLOCK, d)
    vb = vp.reshape(b, h, nblk, MOBA_BLOCK, d)
    kmean = jnp.mean(kb.astype(jnp.float32), axis=3).astype(q.dtype)
    gate = jnp.einsum('bhtd,bhnd->bhtn', q, kmean, preferred_element_type=jnp.float32)
    cur = jnp.arange(t) // MOBA_BLOCK
    past = jnp.arange(nblk)[None, :] < cur[:, None]
    topk = min(MOBA_TOPK, nblk)
    _, sel = lax.top_k(jnp.where(past, gate, -jnp.inf), topk)
    sel_ok = sel < cur[:, None]

    def chunk(q0):
        qb = GATHER_Q_BLOCK
        qc = lax.dynamic_slice_in_dim(q, q0, qb, axis=2)
        selc = lax.dynamic_slice_in_dim(sel, q0, qb, axis=2)
        okc = lax.dynamic_slice_in_dim(sel_ok, q0, qb, axis=2)
        tq = q0 + jnp.arange(qb)
        own0 = (q0 // MOBA_BLOCK) * MOBA_BLOCK
        ko = lax.dynamic_slice_in_dim(kp, own0, MOBA_BLOCK, axis=2)
        vo = lax.dynamic_slice_in_dim(vp, own0, MOBA_BLOCK, axis=2)
        s_own = jnp.einsum('bhqd,bhkd->bhqk', qc, ko, preferred_element_type=jnp.float32) * scale
        m_own = (own0 + jnp.arange(MOBA_BLOCK))[None, :] <= tq[:, None]
        kg = gather_blocks(kb, selc)
        vg = gather_blocks(vb, selc)
        s_sel = jnp.einsum('bhqd,bhqnkd->bhqnk', qc, kg, preferred_element_type=jnp.float32)
        s_sel = s_sel.reshape(b, h, qb, topk * MOBA_BLOCK) * scale
        m_sel = jnp.repeat(okc, MOBA_BLOCK, axis=-1)
        s = jnp.concatenate([s_own, s_sel], axis=-1)
        m = jnp.concatenate([jnp.broadcast_to(m_own, (b, h, qb, MOBA_BLOCK)), m_sel], axis=-1)
        p = masked_softmax(s, m).astype(v.dtype)
        p_sel = p[..., MOBA_BLOCK:].reshape(b, h, qb, topk, MOBA_BLOCK)
        return (jnp.einsum('bhqk,bhkd->bhqd', p[..., :MOBA_BLOCK], vo)
                + jnp.einsum('bhqnk,bhqnkd->bhqd', p_sel, vg))
    return sweep_queries(chunk, t, GATHER_Q_BLOCK)


def nsa_attention(q, k_cmp_raw, v_cmp_raw, k_slc, v_slc, k_win, v_win, gate_logits, pos,
                  pe_k, pe_v, phi_k, phi_v, g_kc):
    b, hq, t, d = q.shape
    g = k_slc.shape[1]
    hg = hq // g
    scale = d ** -0.5
    qg = q.reshape(b, g, hg, t, d)
    t_idx = jnp.arange(t)
    n_cmp = (t - NSA_CMP_LEN) // NSA_CMP_STRIDE + 1
    starts = np.arange(n_cmp) * NSA_CMP_STRIDE
    ends = starts + NSA_CMP_LEN - 1
    win_idx = starts[:, None] + np.arange(NSA_CMP_LEN)[None, :]
    k_c = jnp.einsum('bgnld,lde->bgne', k_cmp_raw[:, :, win_idx] + pe_k, phi_k)
    v_c = jnp.einsum('bgnld,lde->bgne', v_cmp_raw[:, :, win_idx] + pe_v, phi_v)
    k_c = rope(rms_norm(k_c, g_kc), pos[:, ends])
    s_c = jnp.einsum('bghtd,bgnd->bghtn', qg, k_c, preferred_element_type=jnp.float32) * scale
    p_c = masked_softmax(s_c, ends[None, :] <= t_idx[:, None])
    o_c = jnp.einsum('bghtn,bgnd->bghtd', p_c.astype(v_c.dtype), v_c).reshape(b, hq, t, d)
    n_sel = t // NSA_SEL_BLOCK
    sel_start = np.arange(n_sel) * NSA_SEL_BLOCK
    overlap = ((starts[:, None] < sel_start[None, :] + NSA_SEL_BLOCK)
               & (starts[:, None] + NSA_CMP_LEN > sel_start[None, :])).astype(np.float32)
    importance = jnp.einsum('bghtn,nj->bgtj', p_c, jnp.asarray(overlap))
    cur = t_idx // NSA_SEL_BLOCK
    blk = jnp.arange(n_sel)
    forced = (blk[None, :] == cur[:, None]) | (blk[None, :] == 0)
    importance = jnp.where(forced, jnp.inf,
                           jnp.where(blk[None, :] <= cur[:, None], importance, -jnp.inf))
    topn = min(NSA_SEL_TOPN, n_sel)
    _, sel = lax.top_k(importance, topn)
    ks_blocks = k_slc.reshape(b, g, n_sel, NSA_SEL_BLOCK, d)
    vs_blocks = v_slc.reshape(b, g, n_sel, NSA_SEL_BLOCK, d)
    wpad = ((0, 0), (0, 0), (NSA_WINDOW, 0), (0, 0))
    kw_pad, vw_pad = jnp.pad(k_win, wpad), jnp.pad(v_win, wpad)

    def chunk(q0):
        qb = GATHER_Q_BLOCK
        qc = lax.dynamic_slice_in_dim(qg, q0, qb, axis=3)
        tq = q0 + jnp.arange(qb)
        selc = lax.dynamic_slice_in_dim(sel, q0, qb, axis=2)
        kg = gather_blocks(ks_blocks, selc)
        vg = gather_blocks(vs_blocks, selc)
        s_s = jnp.einsum('bghqd,bgqnkd->bghqnk', qc, kg, preferred_element_type=jnp.float32) * scale
        key_pos = selc[..., None] * NSA_SEL_BLOCK + jnp.arange(NSA_SEL_BLOCK)
        m_s = (key_pos <= tq[:, None, None]).reshape(b, g, 1, qb, topn * NSA_SEL_BLOCK)
        p_s = masked_softmax(s_s.reshape(b, g, hg, qb, topn * NSA_SEL_BLOCK), m_s)
        p_s = p_s.reshape(b, g, hg, qb, topn, NSA_SEL_BLOCK).astype(vg.dtype)
        o_s = jnp.einsum('bghqnk,bgqnkd->bghqd', p_s, vg)
        span = qb + NSA_WINDOW
        kwc = lax.dynamic_slice_in_dim(kw_pad, q0, span, axis=2)
        vwc = lax.dynamic_slice_in_dim(vw_pad, q0, span, axis=2)
        s_w = jnp.einsum('bghqd,bgkd->bghqk', qc, kwc, preferred_element_type=jnp.float32) * scale
        kpos = q0 - NSA_WINDOW + jnp.arange(span)
        m_w = ((kpos[None, :] <= tq[:, None]) & (kpos[None, :] > tq[:, None] - NSA_WINDOW)
               & (kpos[None, :] >= 0))
        p_w = masked_softmax(s_w, m_w).astype(vwc.dtype)
        o_w = jnp.einsum('bghqk,bgkd->bghqd', p_w, vwc)
        return o_s.reshape(b, hq, qb, d), o_w.reshape(b, hq, qb, d)
    o_s, o_w = sweep_queries(chunk, t, GATHER_Q_BLOCK)
    gates = jax.nn.sigmoid(gate_logits.astype(jnp.float32)).astype(q.dtype).transpose(0, 2, 1, 3)
    return gates[..., 0:1] * o_c + gates[..., 1:2] * o_s + gates[..., 2:3] * o_w


def stick_breaking_attention(q, k, v):
    b, h, t, d = q.shape
    scale = d ** -0.5
    spos = jnp.arange(t)

    def chunk(q0):
        qc = lax.dynamic_slice_in_dim(q, q0, Q_BLOCK, axis=2)
        z = jnp.einsum('bhqd,bhkd->bhqk', qc, k, preferred_element_type=jnp.float32) * scale
        tq = q0 + jnp.arange(Q_BLOCK)
        strict = spos[None, :] < tq[:, None]
        log_rest = jnp.where(strict, jax.nn.log_sigmoid(-z), 0.0)
        after = lax.cumsum(log_rest, axis=3, reverse=True) - log_rest
        a = jnp.where(strict, jnp.exp(jax.nn.log_sigmoid(z) + after), 0.0)
        return jnp.einsum('bhqk,bhkd->bhqd', a.astype(v.dtype), v)
    return sweep_queries(chunk, t, Q_BLOCK)


def dilated_attention(q, k, v):
    b, ng, hd, t, d = q.shape
    scale = d ** -0.5
    max_w = max(w for w, _ in DIL_CONFIGS)
    pad = ((0, 0), (0, 0), (0, 0), (max_w, 0), (0, 0))
    kp, vp = jnp.pad(k, pad), jnp.pad(v, pad)

    def chunk(q0):
        tq = q0 + jnp.arange(GATHER_Q_BLOCK)
        outs, lses = [], []
        for gi, (window, dil) in enumerate(DIL_CONFIGS):
            offs = np.arange(window // dil + 1) * dil
            src = tq[:, None] - offs[None, :]
            kg = kp[:, gi][:, :, src + max_w]
            vg = vp[:, gi][:, :, src + max_w]
            qc = lax.dynamic_slice_in_dim(q[:, gi], q0, GATHER_Q_BLOCK, axis=2)
            s = jnp.einsum('bhqd,bhqkd->bhqk', qc, kg, preferred_element_type=jnp.float32) * scale
            p, lse = masked_softmax_lse(s, src >= 0)
            outs.append(jnp.einsum('bhqk,bhqkd->bhqd', p.astype(vg.dtype), vg))
            lses.append(lse)
        weights = jax.nn.softmax(jnp.stack(lses), axis=0)[..., None]
        return jnp.sum(weights.astype(v.dtype) * jnp.stack(outs), axis=0)
    return sweep_queries(chunk, t, GATHER_Q_BLOCK)


def even_mixer(h, pos, w_in, w_out, moba_gq, moba_gk, nsa_gq, nsa_gk_cmp, nsa_gk_slc, nsa_gk_win,
               nsa_pe_k, nsa_pe_v, nsa_phi_k, nsa_phi_v):
    b, t, _ = h.shape
    mq, mk, mv, nq, kc, vc, ks, vs, kw, vw, gl = split_cols(h @ w_in, EVEN_SPLITS)
    mq = rope(rms_norm(split_heads(mq, MOBA_HEADS), moba_gq), pos)
    mk = rope(rms_norm(split_heads(mk, MOBA_HEADS), moba_gk), pos)
    o_a = moba_attention(mq, mk, split_heads(mv, MOBA_HEADS))
    nq = rope(rms_norm(split_heads(nq, NSA_HEADS), nsa_gq), pos)
    ks = rope(rms_norm(split_heads(ks, NSA_KV_GROUPS), nsa_gk_slc), pos)
    kw = rope(rms_norm(split_heads(kw, NSA_KV_GROUPS), nsa_gk_win), pos)
    o_b = nsa_attention(nq, split_heads(kc, NSA_KV_GROUPS), split_heads(vc, NSA_KV_GROUPS),
                        ks, split_heads(vs, NSA_KV_GROUPS), kw, split_heads(vw, NSA_KV_GROUPS),
                        gl.reshape(b, t, NSA_HEADS, 3), pos, nsa_pe_k, nsa_pe_v,
                        nsa_phi_k, nsa_phi_v, nsa_gk_cmp)
    return jnp.concatenate([merge_heads(o_a), merge_heads(o_b)], axis=-1) @ w_out


def odd_mixer(h, pos, w_in, w_out, dil_gq, dil_gk):
    b, t, _ = h.shape
    sq, sk, sv, dq, dk, dv = split_cols(h @ w_in, ODD_SPLITS)
    o_c = stick_breaking_attention(split_heads(sq, SB_HEADS), split_heads(sk, SB_HEADS),
                                   split_heads(sv, SB_HEADS))
    nd = DIL_GROUPS * DIL_HEADS
    shape = (b, DIL_GROUPS, DIL_HEADS, t, HEAD_DIM)
    dq = rope(rms_norm(split_heads(dq, nd), dil_gq), pos).reshape(shape)
    dk = rope(rms_norm(split_heads(dk, nd), dil_gk), pos).reshape(shape)
    o_d = dilated_attention(dq, dk, split_heads(dv, nd).reshape(shape))
    return jnp.concatenate([merge_heads(o_c), merge_heads(o_d)], axis=-1) @ w_out


def memory_cross_attention(h, mem_n, wq, wkv, wo, gq, gk):
    q = rms_norm(split_heads(h @ wq, XATTN_HEADS), gq)
    k, v = jnp.split(mem_n @ wkv, 2, axis=-1)
    k = rms_norm(split_heads(k, XATTN_HEADS), gk)
    v = split_heads(v, XATTN_HEADS)
    s = jnp.einsum('bhtd,bhmd->bhtm', q, k, preferred_element_type=jnp.float32) * HEAD_DIM ** -0.5
    p = jax.nn.softmax(s, axis=-1).astype(v.dtype)
    return merge_heads(jnp.einsum('bhtm,bhmd->bhtd', p, v)) @ wo


def swiglu(h, wg, wu, wd):
    return (jax.nn.silu(h @ wg) * (h @ wu)) @ wd


def setup_inputs(seed: int = 0) -> dict:
    key = jax.random.key(seed)
    keys = jax.random.split(key, 48)
    counter = [0]

    def nk():
        counter[0] += 1
        return keys[counter[0] - 1]

    def w(shape, fan_in):
        return jax.random.normal(nk(), shape, jnp.float32) * fan_in ** -0.5

    def gain(shape):
        return 1.0 + 0.02 * jax.random.normal(nk(), shape, jnp.float32)

    n_even = (DEPTH + 1) // 2
    n_odd = DEPTH // 2
    mix_w = N_MIX_HEADS * HEAD_DIM
    xw = XATTN_HEADS * HEAD_DIM
    x = jax.random.normal(nk(), (BATCH, SEQ, D_MODEL), jnp.float32)
    mem = jax.random.normal(nk(), (BATCH, MEM_LEN, D_MODEL), jnp.float32)
    offsets = jax.random.randint(nk(), (BATCH, 1), 0, 1024, dtype=jnp.int32)
    positions = offsets + jnp.arange(SEQ, dtype=jnp.int32)[None, :]
    return {
        'x': x,
        'mem': mem,
        'positions': positions,
        'mix_norm': gain((DEPTH, D_MODEL)),
        'even_w_in': w((n_even, D_MODEL, EVEN_COLS), D_MODEL),
        'even_w_out': w((n_even, mix_w, D_MODEL), mix_w),
        'moba_gq': gain((n_even, HEAD_DIM)),
        'moba_gk': gain((n_even, HEAD_DIM)),
        'nsa_gq': gain((n_even, HEAD_DIM)),
        'nsa_gk_cmp': gain((n_even, HEAD_DIM)),
        'nsa_gk_slc': gain((n_even, HEAD_DIM)),
        'nsa_gk_win': gain((n_even, HEAD_DIM)),
        'nsa_pe_k': 0.1 * jax.random.normal(nk(), (n_even, NSA_CMP_LEN, HEAD_DIM), jnp.float32),
        'nsa_pe_v': 0.1 * jax.random.normal(nk(), (n_even, NSA_CMP_LEN, HEAD_DIM), jnp.float32),
        'nsa_phi_k': w((n_even, NSA_CMP_LEN, HEAD_DIM, HEAD_DIM), NSA_CMP_LEN * HEAD_DIM),
        'nsa_phi_v': w((n_even, NSA_CMP_LEN, HEAD_DIM, HEAD_DIM), NSA_CMP_LEN * HEAD_DIM),
        'odd_w_in': w((n_odd, D_MODEL, ODD_COLS), D_MODEL),
        'odd_w_out': w((n_odd, (SB_HEADS + DIL_HEADS) * HEAD_DIM, D_MODEL), (SB_HEADS + DIL_HEADS) * HEAD_DIM),
        'dil_gq': gain((n_odd, HEAD_DIM)),
        'dil_gk': gain((n_odd, HEAD_DIM)),
        'xattn_norm': gain((DEPTH, D_MODEL)),
        'mem_norm': gain((DEPTH, D_MODEL)),
        'xattn_wq': w((DEPTH, D_MODEL, xw), D_MODEL),
        'xattn_wkv': w((DEPTH, D_MODEL, 2 * xw), D_MODEL),
        'xattn_wo': w((DEPTH, xw, D_MODEL), xw),
        'xattn_gq': gain((DEPTH, HEAD_DIM)),
        'xattn_gk': gain((DEPTH, HEAD_DIM)),
        'ffn_norm': gain((DEPTH, D_MODEL)),
        'ffn_wg': w((DEPTH, D_MODEL, FFN_HIDDEN), D_MODEL),
        'ffn_wu': w((DEPTH, D_MODEL, FFN_HIDDEN), D_MODEL),
        'ffn_wd': w((DEPTH, FFN_HIDDEN, D_MODEL), FFN_HIDDEN),
    }


def reference(x, mem, positions, mix_norm, even_w_in, even_w_out, moba_gq, moba_gk, nsa_gq,
              nsa_gk_cmp, nsa_gk_slc, nsa_gk_win, nsa_pe_k, nsa_pe_v, nsa_phi_k, nsa_phi_v,
              odd_w_in, odd_w_out, dil_gq, dil_gk, xattn_norm, mem_norm, xattn_wq, xattn_wkv,
              xattn_wo, xattn_gq, xattn_gk, ffn_norm, ffn_wg, ffn_wu, ffn_wd):
    for layer in range(DEPTH):
        h = rms_norm(x, mix_norm[layer])
        if layer % 2 == 0:
            e = layer // 2
            x = x + even_mixer(h, positions, even_w_in[e], even_w_out[e], moba_gq[e], moba_gk[e],
                               nsa_gq[e], nsa_gk_cmp[e], nsa_gk_slc[e], nsa_gk_win[e],
                               nsa_pe_k[e], nsa_pe_v[e], nsa_phi_k[e], nsa_phi_v[e])
        else:
            o = layer // 2
            x = x + odd_mixer(h, positions, odd_w_in[o], odd_w_out[o], dil_gq[o], dil_gk[o])
        h = rms_norm(x, xattn_norm[layer])
        mem_n = rms_norm(mem, mem_norm[layer])
        x = x + memory_cross_attention(h, mem_n, xattn_wq[layer], xattn_wkv[layer], xattn_wo[layer],
                                       xattn_gq[layer], xattn_gk[layer])
        h = rms_norm(x, ffn_norm[layer])
        x = x + swiglu(h, ffn_wg[layer], ffn_wu[layer], ffn_wd[layer])
    return x
```

```cpp
#define MK_ONE_LAUNCH 1

#include <hip/hip_runtime.h>
#include <cstdio>
#include <cstdint>
namespace pg8 {
#define PG8_LAS __attribute__((address_space(3)))
typedef unsigned short bf16_t;
typedef short bf16x8 __attribute__((ext_vector_type(8)));
typedef float f32x4 __attribute__((ext_vector_type(4)));
typedef unsigned u32x4 __attribute__((ext_vector_type(4)));
constexpr int BM = 256, BK = 64, HALF = 128, HTB = HALF * BK * 2  , STAGE_BYTES = 8 * HTB, NXCD = 8, WGM = 8;

__host__ __device__ __forceinline__ int lds_byte(int r, int c) { const int st = (r >> 4) * 2 + (c >> 5), rr = r & 15, cc = c & 31, ob = rr * 64 + cc * 2; return st * 1024 + (ob ^ (((ob >> 9) & 1) << 5)); }
__host__ __device__ __forceinline__ void stage_rc(int b, int& R, int& C) { const int st = b / 1024, sb = b % 1024, swz = sb ^ (((sb >> 9) & 1) << 5); R = (st >> 1) * 16 + swz / 64; C = (st & 1) * 32 + (swz % 64) / 2; }
__host__ __device__ __forceinline__ int perm32(int rho) { const int n = rho >> 4, i = rho & 15; return 8 * (i >> 2) + 4 * n + (i & 3); }

struct Unit { int pm, pn; };
struct Gemm { const bf16_t* A; const bf16_t* Bt; int M, N, K; };

struct StaticOrder {
    int nM, nN, nwg, G, c;
    __host__ __device__ void init(int M, int N, int G_, int c_) { nM = M / BM; nN = N / BM; nwg = nM * nN; G = G_; c = c_; }
    __host__ __device__ bool next(int i, Unit& u) const {
        const long L = (long)i * G + c; if (L >= nwg) return false;
        int wgid = (int)L; { const int q = nwg / NXCD, r = nwg % NXCD, xcd = wgid % NXCD, off = wgid / NXCD; wgid = (xcd < r ? xcd * (q + 1) : r * (q + 1) + (xcd - r) * q) + off; }
        const int nig = WGM * nN, gid = wgid / nig, fm = gid * WGM, gsz = (nM - fm) < WGM ? (nM - fm) : WGM;
        u.pm = fm + ((wgid % nig) % gsz); u.pn = (wgid % nig) / gsz; return true;
    }
    __device__ __forceinline__ void a_ready(const Unit&) const {}
    __device__ __forceinline__ void done(const Unit&) const {}
};

typedef float f32x2c_t __attribute__((ext_vector_type(2)));
typedef __bf16 bf16x2c_t __attribute__((ext_vector_type(2)));
__device__ __forceinline__ unsigned cvt_pk_bf16(float lo, float hi) { const f32x2c_t v = {lo, hi}; const bf16x2c_t b = __builtin_convertvector(v, bf16x2c_t); return __builtin_bit_cast(unsigned, b); }
typedef float f32x2 __attribute__((ext_vector_type(2)));
struct EpiBf16P {
    static constexpr bool PERM = true, AFTER_DRAIN = false;
    bf16_t* O; int ldc;
    __device__ __forceinline__ void operator()(const f32x4 (&acc)[2][2][4][2], const Unit& u, int wr, int wc, int fr, int fq) const {
        const int row0 = u.pm * BM + wr * 64 + fr, col0 = u.pn * BM + wc * 32 + 8 * fq;
#pragma unroll
        for (int ai = 0; ai < 2; ++ai)
#pragma unroll
            for (int m = 0; m < 4; ++m) { bf16_t* rowp = O + (size_t)(row0 + ai * HALF + m * 16) * ldc + col0;
#pragma unroll
                for (int bj = 0; bj < 2; ++bj) { const f32x4 v0 = acc[ai][bj][m][0], v1 = acc[ai][bj][m][1];
                    u32x4 w; w.x = cvt_pk_bf16(v0[0], v0[1]); w.y = cvt_pk_bf16(v0[2], v0[3]); w.z = cvt_pk_bf16(v1[0], v1[1]); w.w = cvt_pk_bf16(v1[2], v1[3]);
                    *(u32x4*)(rowp + bj * HALF) = w; } }
    }
};
struct EpiResF32 {
    static constexpr bool PERM = false, AFTER_DRAIN = false;
    const float* base; float* out; int ldc;
    __device__ __forceinline__ void operator()(const f32x4 (&acc)[2][2][4][2], const Unit& u, int wr, int wc, int fr, int fq) const {
        const int row0 = u.pm * BM + wr * 64 + fr, col0 = u.pn * BM + wc * 32 + 4 * fq;
#pragma unroll
        for (int ai = 0; ai < 2; ++ai)
#pragma unroll
            for (int m = 0; m < 4; ++m) { const size_t off = (size_t)(row0 + ai * HALF + m * 16) * ldc + col0;
#pragma unroll
                for (int bj = 0; bj < 2; ++bj)
#pragma unroll
                    for (int n = 0; n < 2; ++n) { const f32x4 bs = *(const f32x4*)(base + off + bj * HALF + n * 16); *(f32x4*)(out + off + bj * HALF + n * 16) = bs + acc[ai][bj][m][n]; }
                asm volatile("" ::: "memory"); }
    }
};
__device__ __forceinline__ float silu_mul(float g, float u) { return g * __builtin_amdgcn_rcpf(1.0f + __builtin_amdgcn_exp2f(-1.4426950408889634f * g)) * u; }
struct EpiSwiGLU {
    static constexpr bool PERM = true, AFTER_DRAIN = false;
    bf16_t* O; int ldc;
    __device__ __forceinline__ void operator()(const f32x4 (&acc)[2][2][4][2], const Unit& u, int wr, int wc, int fr, int fq) const {
        const int row0 = u.pm * BM + wr * 64 + fr, col0 = u.pn * HALF + wc * 32 + 8 * fq;
#pragma unroll
        for (int ai = 0; ai < 2; ++ai)
#pragma unroll
            for (int m = 0; m < 4; ++m) { bf16_t* rowp = O + (size_t)(row0 + ai * HALF + m * 16) * ldc + col0;
                const f32x4 g0 = acc[ai][0][m][0], g1 = acc[ai][0][m][1], u0 = acc[ai][1][m][0], u1 = acc[ai][1][m][1];
                u32x4 w; w.x = cvt_pk_bf16(silu_mul(g0[0], u0[0]), silu_mul(g0[1], u0[1])); w.y = cvt_pk_bf16(silu_mul(g0[2], u0[2]), silu_mul(g0[3], u0[3]));
                w.z = cvt_pk_bf16(silu_mul(g1[0], u1[0]), silu_mul(g1[1], u1[1])); w.w = cvt_pk_bf16(silu_mul(g1[2], u1[2]), silu_mul(g1[3], u1[3]));
                *(u32x4*)rowp = w; }
    }
};
template <class Epi, class Sched, bool ALIGN_EPI = false, bool SP2 = false>
__device__ __forceinline__ void gemm_phase(PG8_LAS unsigned char* lds, const Gemm g, const Sched& S, const Epi& E) {
    const int tid = threadIdx.x, wid = __builtin_amdgcn_readfirstlane(tid >> 6), lane = tid & 63, wr = wid >> 2, wc = wid & 3, fr = lane & 15, fq = lane >> 4;
    const int K = g.K, nt = K / BK;
    unsigned voffA[2], voffB[2];
#pragma unroll
    for (int i = 0; i < 2; ++i) { int R, C; stage_rc(tid * 16 + i * 8192, R, C); const int Rb = Epi::PERM ? ((R & ~31) + perm32(R & 31)) : R;
        voffA[i] = (unsigned)(R * K + C) * 2u; voffB[i] = (unsigned)(Rb * K + C) * 2u; }
    const size_t kstep = (size_t)(BK * 2);
    const size_t hstep = (size_t)HALF * K * 2;
    const size_t tstep = 2 * hstep;
    const unsigned ldsw = (unsigned)wid * 1024u;
    const int aoff = lds_byte(wr * 64 + fr, fq * 8), boff = lds_byte(wc * 32 + fr, fq * 8);
#define PG8_SA(b, h) (((b) * 2 + (h)) * HTB)
#define PG8_SB(b, h) ((4 + (b) * 2 + (h)) * HTB)
#define PG8_STAGE(bufoff, gbase, voff) do { _Pragma("unroll") for (int _i = 0; _i < 2; ++_i) \
        __builtin_amdgcn_global_load_lds((const unsigned*)((const char*)(gbase) + (voff)[_i]), (PG8_LAS unsigned*)(lds + (bufoff) + ldsw + _i * 8192), 16, 0, 0); } while (0)
#define PG8_LDA(dst, b, h) do { _Pragma("unroll") for (int m = 0; m < 4; ++m) _Pragma("unroll") for (int k = 0; k < 2; ++k) dst[m][k] = *(const PG8_LAS bf16x8*)(lds + PG8_SA(b, h) + aoff + m * 2048 + k * 1024); } while (0)
#define PG8_LDB(dst, b, h) do { _Pragma("unroll") for (int n = 0; n < 2; ++n) _Pragma("unroll") for (int k = 0; k < 2; ++k) dst[n][k] = *(const PG8_LAS bf16x8*)(lds + PG8_SB(b, h) + boff + n * 2048 + k * 1024); } while (0)
#define PG8_MMA(ai, bj, At, Bt) do { __builtin_amdgcn_s_setprio(1); _Pragma("unroll") for (int m = 0; m < 4; ++m) _Pragma("unroll") for (int n = 0; n < 2; ++n) _Pragma("unroll") for (int k = 0; k < 2; ++k) \
        acc[ai][bj][m][n] = __builtin_amdgcn_mfma_f32_16x16x32_bf16(Bt[n][k], At[m][k], acc[ai][bj][m][n], 0, 0, 0); __builtin_amdgcn_s_setprio(0); } while (0)
#define PG8_WAIT_V(n) asm volatile("s_waitcnt vmcnt(" #n ")" ::: "memory")
#define PG8_WAIT_L(n) asm volatile("s_waitcnt lgkmcnt(" #n ")" ::: "memory")
#define PG8_BAR __builtin_amdgcn_s_barrier()
#define PG8_SCHED __builtin_amdgcn_sched_barrier(0)
    Unit cur, nxt; int ui = 0;
    if (!S.next(0, cur)) return;
    f32x4 acc[2][2][4][2];
#pragma unroll
    for (int a = 0; a < 2; ++a)
#pragma unroll
        for (int b = 0; b < 2; ++b)
#pragma unroll
            for (int m = 0; m < 4; ++m)
#pragma unroll
                for (int n = 0; n < 2; ++n) acc[a][b][m][n] = (f32x4){0.f, 0.f, 0.f, 0.f};
    bf16x8 At[4][2], B0[2][2], B1[2][2];
    const char* cA = (const char*)g.A + (size_t)cur.pm * tstep; const char* cB = (const char*)g.Bt + (size_t)cur.pn * tstep;
    S.a_ready(cur);
    if constexpr (SP2) {
        PG8_STAGE(PG8_SB(0, 0), cB, voffB); PG8_STAGE(PG8_SB(0, 1), cB + hstep, voffB); PG8_STAGE(PG8_SA(0, 0), cA, voffA); PG8_STAGE(PG8_SA(0, 1), cA + hstep, voffA);
        if (wr == 1) PG8_BAR;
        PG8_WAIT_V(2); PG8_BAR;
        PG8_STAGE(PG8_SB(1, 0), cB + kstep, voffB); PG8_STAGE(PG8_SA(1, 0), cA + kstep, voffA); PG8_STAGE(PG8_SB(1, 1), cB + hstep + kstep, voffB);
        PG8_WAIT_V(6); PG8_BAR;
    } else {
        PG8_STAGE(PG8_SB(0, 0), cB, voffB); PG8_STAGE(PG8_SA(0, 0), cA, voffA); PG8_STAGE(PG8_SB(0, 1), cB + hstep, voffB); PG8_STAGE(PG8_SA(0, 1), cA + hstep, voffA);
        if (wr == 1) PG8_BAR;
        PG8_WAIT_V(4); PG8_BAR;
        PG8_STAGE(PG8_SB(1, 0), cB + kstep, voffB); PG8_STAGE(PG8_SA(1, 0), cA + kstep, voffA); PG8_STAGE(PG8_SB(1, 1), cB + hstep + kstep, voffB);
        PG8_WAIT_V(6); PG8_BAR;
    }
    for (;;) {
        const bool has_next = S.next(ui + 1, nxt);
        const char* nA = has_next ? (const char*)g.A + (size_t)nxt.pm * tstep : cA; const char* nB = has_next ? (const char*)g.Bt + (size_t)nxt.pn * tstep : cB;
        for (int t = 0; t < nt; t += 2) {
            const bool last = (t == nt - 2);
            const char* a1 = cA + (size_t)(t + 1) * kstep;
            const char* a2 = last ? nA : cA + (size_t)(t + 2) * kstep; const char* b2 = last ? nB : cB + (size_t)(t + 2) * kstep;
            const char* a3 = a2 + kstep; const char* b3 = b2 + kstep;
            if (last && has_next) S.a_ready(nxt);
            if constexpr (SP2) {
            PG8_LDB(B0, 0, 0); PG8_LDB(B1, 0, 1); PG8_SCHED; PG8_LDA(At, 0, 0); PG8_STAGE(PG8_SA(1, 1), a1 + hstep, voffA);
            PG8_WAIT_V(8); PG8_WAIT_L(0); PG8_BAR; PG8_MMA(0, 0, At, B0); PG8_MMA(0, 1, At, B1); PG8_BAR; PG8_SCHED;
            PG8_LDA(At, 0, 1); PG8_STAGE(PG8_SB(0, 0), b2, voffB); PG8_STAGE(PG8_SB(0, 1), b2 + hstep, voffB); PG8_STAGE(PG8_SA(0, 0), a2, voffA);
            PG8_WAIT_V(8); PG8_WAIT_L(0); PG8_BAR; PG8_MMA(1, 0, At, B0); PG8_MMA(1, 1, At, B1); PG8_BAR; PG8_SCHED;
            PG8_LDB(B0, 1, 0); PG8_LDB(B1, 1, 1); PG8_SCHED; PG8_LDA(At, 1, 0); PG8_STAGE(PG8_SA(0, 1), a2 + hstep, voffA);
            PG8_WAIT_V(8); PG8_WAIT_L(0); PG8_BAR; PG8_MMA(0, 0, At, B0); PG8_MMA(0, 1, At, B1); PG8_BAR; PG8_SCHED;
            PG8_LDA(At, 1, 1); PG8_STAGE(PG8_SB(1, 0), b3, voffB); PG8_STAGE(PG8_SB(1, 1), b3 + hstep, voffB); PG8_STAGE(PG8_SA(1, 0), a3, voffA);
            PG8_WAIT_V(8); PG8_WAIT_L(0); PG8_BAR; PG8_MMA(1, 0, At, B0); PG8_MMA(1, 1, At, B1); PG8_BAR; PG8_SCHED;
            } else {
            PG8_LDB(B0, 0, 0); PG8_SCHED; PG8_LDA(At, 0, 0); PG8_STAGE(PG8_SA(1, 1), a1 + hstep, voffA);
            PG8_WAIT_L(8); PG8_BAR; PG8_WAIT_L(0); PG8_MMA(0, 0, At, B0); PG8_BAR; PG8_SCHED;
            PG8_LDB(B1, 0, 1); PG8_STAGE(PG8_SB(0, 0), b2, voffB);
            PG8_BAR; PG8_WAIT_L(0); PG8_MMA(0, 1, At, B1); PG8_BAR;
            PG8_LDA(At, 0, 1); PG8_STAGE(PG8_SA(0, 0), a2, voffA);
            PG8_BAR; PG8_WAIT_L(0); PG8_MMA(1, 0, At, B0); PG8_BAR; PG8_SCHED;
            PG8_STAGE(PG8_SB(0, 1), b2 + hstep, voffB);
            PG8_WAIT_V(6); PG8_BAR; PG8_MMA(1, 1, At, B1); PG8_BAR;
            PG8_LDB(B0, 1, 0); PG8_SCHED; PG8_LDA(At, 1, 0); PG8_STAGE(PG8_SA(0, 1), a2 + hstep, voffA);
            PG8_WAIT_L(8); PG8_BAR; PG8_WAIT_L(0); PG8_MMA(0, 0, At, B0); PG8_BAR; PG8_SCHED;
            PG8_LDB(B1, 1, 1); PG8_STAGE(PG8_SB(1, 0), b3, voffB);
            PG8_BAR; PG8_WAIT_L(0); PG8_MMA(0, 1, At, B1); PG8_BAR;
            PG8_LDA(At, 1, 1); PG8_STAGE(PG8_SA(1, 0), a3, voffA);
            PG8_BAR; PG8_WAIT_L(0); PG8_MMA(1, 0, At, B0); PG8_BAR; PG8_SCHED;
            PG8_STAGE(PG8_SB(1, 1), b3 + hstep, voffB);
            PG8_WAIT_V(6); PG8_BAR; PG8_MMA(1, 1, At, B1); PG8_BAR;
            }
        }
        if constexpr (ALIGN_EPI) { if (wr == 0) PG8_BAR; }
        if constexpr (!Epi::AFTER_DRAIN) { E(acc, cur, wr, wc, fr, fq); S.done(cur); }
        if (!has_next) break;
#pragma unroll
        for (int a = 0; a < 2; ++a)
#pragma unroll
            for (int b = 0; b < 2; ++b)
#pragma unroll
                for (int m = 0; m < 4; ++m)
#pragma unroll
                    for (int n = 0; n < 2; ++n) acc[a][b][m][n] = (f32x4){0.f, 0.f, 0.f, 0.f};
        cur = nxt; cA = nA; cB = nB; ++ui;
        if constexpr (ALIGN_EPI) { if (wr == 1) PG8_BAR; }
    }
    PG8_WAIT_V(0);
    if constexpr (!ALIGN_EPI) { if (wr == 0) PG8_BAR; }
    PG8_BAR;
    if constexpr (Epi::AFTER_DRAIN) { E.fused(acc, cur, wr, wc, fr, fq, lds, wid, lane); S.done(cur); }
#undef PG8_SA
#undef PG8_SB
#undef PG8_STAGE
#undef PG8_LDA
#undef PG8_LDB
#undef PG8_MMA
#undef PG8_WAIT_V
#undef PG8_WAIT_L
#undef PG8_BAR
#undef PG8_SCHED
}
}
#define GAS __attribute__((address_space(1)))
#define LAS __attribute__((address_space(3)))
typedef unsigned short bf16;
typedef unsigned v4u __attribute__((ext_vector_type(4)));
typedef float f32x4 __attribute__((ext_vector_type(4)));
constexpr int NB = 4, T = 2048, DM = 4096, MTOK = NB * T, HD = 128;
constexpr int EVEN_N = 11312, EVEN_LD = 11520, ODD_LD = 18432, FFN = 11008, GU_ROWS = 2 * FFN;
constexpr int MEM_LEN = 256, MEM_ROWS = NB * MEM_LEN, XW = 512;
constexpr float NORM_EPS = 1e-6f;
constexpr float ATT_SCALE = 0.08838834764831845f;
#define NEG_INF (-__builtin_inff())
constexpr int C_MQ = 0, C_MK = 2048, C_MV = 4096, C_NQ = 6144, C_KC = 8192, C_VC = 8704, C_KS = 9216, C_VS = 9728, C_KW = 10240, C_VW = 10752, C_GL = 11264;
constexpr int C_SQ = 0, C_SK = 3072, C_SV = 6144, C_DQ = 9216, C_DK = 12288, C_DV = 15360;
constexpr size_t MiB = 1u << 20;
constexpr size_t WS_CTL = 0, CTL_ZERO_BYTES = 1 * MiB;
constexpr size_t WS_ROPE = 1 * MiB;
constexpr size_t WS_KMEAN = 5 * MiB;
constexpr size_t WS_KCR = 6 * MiB, WS_VCR = 7 * MiB;
constexpr size_t WS_KCN = 8 * MiB, WS_VCN = 9 * MiB;
constexpr size_t WS_MEMN = 10 * MiB;
constexpr size_t WS_QX = 18 * MiB;
constexpr size_t WS_KVX = 26 * MiB;
constexpr size_t WS_OX = 28 * MiB;
constexpr size_t WS_WQ = 36 * MiB, WS_WKV = 40 * MiB, WS_WO = 48 * MiB, WS_WOUT = 52 * MiB, WS_WIN = 84 * MiB, WS_WGU = 228 * MiB, WS_WD = 400 * MiB;
constexpr size_t WS_X = 486 * MiB;
constexpr size_t WS_H = 614 * MiB;
constexpr size_t WS_O = 678 * MiB;
constexpr size_t WS_Y = 742 * MiB;
constexpr size_t WS_VT = 1030 * MiB;
constexpr size_t WS_PART = 1126 * MiB;
constexpr size_t WS_LSE = 1222 * MiB;
constexpr size_t WS_VTX = 1223 * MiB;
constexpr size_t WS_SELM = 5 * MiB + 256 * 1024, WS_SELN = 5 * MiB + 768 * 1024;
constexpr size_t WS_END = 1224 * MiB;
constexpr int CW_BAR = 4096;
constexpr int RING_BYTES = 131072, LDSCTL_OFF = RING_BYTES, MISC_OFF = LDSCTL_OFF + 320, LDS_BYTES = 147456;
constexpr int NWAVES = 8;
#ifndef MK_ONE_LAUNCH
#define MK_ONE_LAUNCH 0
#endif
constexpr int NPL = 16, NPH = 2 * NPL;
#ifndef DUP_PHASE
#define DUP_PHASE (-1)
#endif
#ifndef DUP_N
#define DUP_N 2
#endif
#define REPS(k) for (int rep_ = 0; rep_ < ((DUP_PHASE == (k)) ? DUP_N : 1); ++rep_)
#ifndef FA_EVEN
#define FA_EVEN 1
#endif
#ifndef FA_ODD
#define FA_ODD 1
#endif
#ifndef FA_SB
#define FA_SB 1
#endif
#ifndef FA_DIL
#define FA_DIL 1
#endif
#ifndef FA_XATTN
#define FA_XATTN 1
#endif

__device__ __forceinline__ unsigned f2bf(float f) { unsigned u = __builtin_bit_cast(unsigned, f); return (u + 0x7fffu + ((u >> 16) & 1u)) >> 16; }
__device__ __forceinline__ unsigned pk2(float lo, float hi) { return f2bf(lo) | (f2bf(hi) << 16); }
__device__ __forceinline__ float bflo(unsigned w) { return __builtin_bit_cast(float, w << 16); }
__device__ __forceinline__ float bfhi(unsigned w) { return __builtin_bit_cast(float, w & 0xffff0000u); }
__device__ __forceinline__ float bf2f(bf16 b) { return __builtin_bit_cast(float, ((unsigned)b) << 16); }
__device__ __forceinline__ float wsum(float v) {
#pragma unroll
    for (int o = 1; o < 64; o <<= 1) v += __shfl_xor(v, o);
    return v; }
__device__ __forceinline__ float wmax(float v) {
#pragma unroll
    for (int o = 1; o < 64; o <<= 1) v = fmaxf(v, __shfl_xor(v, o));
    return v; }
__device__ __forceinline__ float rdlane(float v, int j) { return __builtin_bit_cast(float, __builtin_amdgcn_readlane(__builtin_bit_cast(int, v), j)); }
#define LDS_FENCE() do { asm volatile("s_waitcnt lgkmcnt(0)" ::: "memory"); __builtin_amdgcn_wave_barrier(); } while (0)

#define XB_TMO      128
#define XB_XCNT(j)  (256  + 64 * (j))
#define XB_XSUB(j)  (1280 + 64 * (j))
#define XB_XGEN(j)  (2304 + 64 * (j))
#define XB_TOP      3328
#define XB_TOPGEN   3392
#define XCD_BAR_WORDS 3456
#define XB_SPIN_CAP (1u << 18)

__device__ __forceinline__ unsigned xb_ld(unsigned* p)              { return __hip_atomic_load(p, __ATOMIC_RELAXED, __HIP_MEMORY_SCOPE_AGENT); }
__device__ __forceinline__ unsigned xb_add(unsigned* p, unsigned v) { return __hip_atomic_fetch_add(p, v, __ATOMIC_RELAXED, __HIP_MEMORY_SCOPE_AGENT); }
__device__ __forceinline__ unsigned xb_xcc_id() { return (unsigned)__builtin_amdgcn_s_getreg((3 << 11) | 20) & 0xFu; }
#define XB_SPIN(cond, bar) do { unsigned _sp = 0; while (cond) { __builtin_amdgcn_s_sleep(1); \
    if ((++_sp & 255u) == 0u) { if (xb_ld(&(bar)[XB_TMO])) break; if (_sp > XB_SPIN_CAP) { atomicAdd(&(bar)[XB_TMO], 1u); break; } } } } while (0)

struct XcdBarrier {
    unsigned* bar; unsigned x;
    volatile LAS unsigned* st;
};

__device__ __forceinline__ XcdBarrier xcd_barrier_post(unsigned* bar, volatile LAS unsigned* st) {
    XcdBarrier b; b.bar = bar; b.x = xb_xcc_id(); b.st = st;
    if (threadIdx.x == 0) (void)xb_add(&bar[XB_XCNT(b.x)], 1u);
    return b;
}
__device__ __forceinline__ void xcd_barrier_complete(unsigned* bar, unsigned x, unsigned& nloc, unsigned& nx) {
    const unsigned G = gridDim.x * gridDim.y * gridDim.z;
    unsigned sum, cnt, mine, sp = 0u;
    for (;;) {
        sum = 0u; cnt = 0u; mine = 0u;
#pragma unroll
        for (unsigned j = 0; j < 16; ++j) { const unsigned c = xb_ld(&bar[XB_XCNT(j)]); sum += c; cnt += (c > 0u) ? 1u : 0u; mine = (j == x) ? c : mine; }
        if (sum == G) break;
        __builtin_amdgcn_s_sleep(1);
        if ((++sp & 255u) == 0u) { if (xb_ld(&bar[XB_TMO])) break; if (sp > XB_SPIN_CAP) { atomicAdd(&bar[XB_TMO], 1u); break; } }
    }
    nloc = mine > 0u ? mine : 1u; nx = cnt > 0u ? cnt : 1u;
}

__device__ __forceinline__ void xcd_barrier(const XcdBarrier& b) {
    asm volatile("s_waitcnt vmcnt(0)" ::: "memory");
    __syncthreads();
    if (threadIdx.x == 0) {
        unsigned* bar = b.bar;
        __builtin_amdgcn_s_waitcnt(0);
        unsigned nloc = b.st[0], nx = b.st[1];
        if (nloc == 0u) { xcd_barrier_complete(bar, b.x, nloc, nx); b.st[0] = nloc; b.st[1] = nx; }
        const unsigned old = xb_add(&bar[XB_XSUB(b.x)], 1u);
        const unsigned gen = old / nloc;
        if (old + 1u == (gen + 1u) * nloc) {
            __builtin_amdgcn_fence(__ATOMIC_RELEASE, "agent");
            asm volatile("s_waitcnt vmcnt(0)" ::: "memory");
            const unsigned og = xb_add(&bar[XB_TOP], 1u);
            const unsigned tg = og / nx;
            if (og + 1u == (tg + 1u) * nx) xb_add(&bar[XB_TOPGEN], 1u);
            else XB_SPIN(xb_ld(&bar[XB_TOPGEN]) == tg, bar);
            __builtin_amdgcn_fence(__ATOMIC_ACQUIRE, "agent");
            xb_add(&bar[XB_XGEN(b.x)], 1u);
            asm volatile("s_waitcnt vmcnt(0)" ::: "memory");
        } else {
            XB_SPIN(xb_ld(&bar[XB_XGEN(b.x)]) == gen, bar);
            __builtin_amdgcn_fence(__ATOMIC_ACQUIRE, "agent");
            asm volatile("s_waitcnt vmcnt(0)" ::: "memory");
        }
    }
    __syncthreads();
}


struct Ctx { LAS unsigned char* lds; int tid, lane, wave, gw, ngw, G; };

struct RmId { int off; __device__ __forceinline__ int operator()(int n) const { return off + n; } };
struct RmGU { int up; __device__ __forceinline__ int operator()(int n) const { return (n >> 7) * 256 + up * 128 + (n & 127); } };
template <class RM>
__device__ __forceinline__ void conv_weight(const Ctx& c, const float* W, int K, int N, int Npad, bf16* WT, RM rm) {
    LAS float* scr = (LAS float*)(c.lds + c.wave * 16384);
    const int nblk = Npad / 32, items = (K / 64) * nblk, lane = c.lane;
    for (int it = c.gw; it < items; it += c.ngw) {
        const int kb = it / nblk, nb = it - kb * nblk, k0 = 64 * kb, n0 = 32 * nb;
        const int c4 = lane & 7; const bool ok = n0 + 4 * c4 < N;
        f32x4 wv[8];
#pragma unroll
        for (int i = 0; i < 8; ++i) { const int kk = 8 * i + (lane >> 3); wv[i] = ok ? *(const f32x4*)(W + (size_t)(k0 + kk) * N + n0 + 4 * c4) : (f32x4){0.f, 0.f, 0.f, 0.f}; }
#pragma unroll
        for (int i = 0; i < 8; ++i) { const int kk = 8 * i + (lane >> 3); LAS float* d = scr + kk * 33 + 4 * c4; d[0] = wv[i].x; d[1] = wv[i].y; d[2] = wv[i].z; d[3] = wv[i].w; }
        LDS_FENCE();
        const int ch = lane & 7, r0 = rm(n0);
#pragma unroll
        for (int j = 0; j < 4; ++j) { const int nn = (lane >> 3) + 8 * j; const LAS float* s = scr + (8 * ch) * 33 + nn;
            v4u o; o.x = pk2(s[0 * 33], s[1 * 33]); o.y = pk2(s[2 * 33], s[3 * 33]); o.z = pk2(s[4 * 33], s[5 * 33]); o.w = pk2(s[6 * 33], s[7 * 33]);
            *(v4u*)(WT + (size_t)(r0 + nn) * K + k0 + 8 * ch) = o; }
        LDS_FENCE();
    }
}
__device__ __forceinline__ void rmsnorm_rows(const Ctx& c, const float* X, const float* g, bf16* Hout, int nrows) {
    const int lane = c.lane;
    for (int m = c.gw; m < nrows; m += c.ngw) {
        const f32x4* xr = (const f32x4*)(X + (size_t)m * DM) + lane; f32x4 v[16]; float ss = 0.f;
#pragma unroll
        for (int j = 0; j < 16; ++j) { v[j] = xr[64 * j]; ss += (v[j].x * v[j].x + v[j].y * v[j].y) + (v[j].z * v[j].z + v[j].w * v[j].w); }
        const float rstd = 1.0f / sqrtf(wsum(ss) * (1.0f / DM) + NORM_EPS);
        const f32x4* gr = (const f32x4*)g + lane; unsigned long long* o8 = (unsigned long long*)(Hout + (size_t)m * DM) + lane;
#pragma unroll
        for (int j = 0; j < 16; ++j) { const f32x4 gg = gr[64 * j]; o8[64 * j] = (unsigned long long)pk2(v[j].x * rstd * gg.x, v[j].y * rstd * gg.y) | ((unsigned long long)pk2(v[j].z * rstd * gg.z, v[j].w * rstd * gg.w) << 32); }
    }
}
__device__ __forceinline__ void rope_table(const Ctx& c, const int* pos, float* ct, float* st) {
    for (int idx = c.gw * 64 + c.lane; idx < MTOK * 64; idx += c.ngw * 64) {
        const int row = idx >> 6, i = idx & 63;
        const float invf = exp2f(-(float)i * 0.20762050593046f);
        const float ang = (float)pos[row] * invf;
        double rev = (double)ang * 0.15915494309189535; rev -= floor(rev);
        const float r = (float)rev;
        ct[idx] = __builtin_amdgcn_cosf(r); st[idx] = __builtin_amdgcn_sinf(r);
    }
}
__device__ __forceinline__ void headnorm_bf16(const Ctx& c, bf16* Y, int ld, int col0, int nh, int nrows, const float* gain, const float* ct, const float* st) {
    const int lane = c.lane; const int items = nrows * nh;
    const float g1 = gain[lane], g2 = gain[lane + 64];
    for (int it = c.gw; it < items; it += c.ngw) {
        const int row = it / nh, hh = it - row * nh;
        bf16* p = Y + (size_t)row * ld + col0 + hh * 128;
        float x1 = bf2f(p[lane]), x2 = bf2f(p[lane + 64]);
        const float rstd = 1.0f / sqrtf(wsum(x1 * x1 + x2 * x2) * (1.0f / 128.0f) + NORM_EPS);
        x1 = x1 * rstd * g1; x2 = x2 * rstd * g2;
        if (ct) { const float cs = ct[row * 64 + lane], sn = st[row * 64 + lane]; const float y1 = x1 * cs - x2 * sn, y2 = x1 * sn + x2 * cs; x1 = y1; x2 = y2; }
        p[lane] = (bf16)f2bf(x1); p[lane + 64] = (bf16)f2bf(x2);
    }
}
__device__ __forceinline__ void cmp_finish(const Ctx& c, const float* KCR, const float* VCR, bf16* KCN, bf16* VCT, const float* gain, const float* ct, const float* st) {
    const int lane = c.lane; const float g1 = gain[lane], g2 = gain[lane + 64];
    for (int it = c.gw; it < 2 * 16 * 128; it += c.ngw) {
        const int which = it >> 11, r = it & 2047, bg = r >> 7, n = r & 127, b = bg >> 2;
        const size_t o = ((size_t)bg * 128 + n) * 128;
        if (which == 0) {
            if (n == 127) { KCN[o + lane] = 0; KCN[o + lane + 64] = 0; continue; }
            float x1 = KCR[o + lane], x2 = KCR[o + lane + 64];
            const float rstd = 1.0f / sqrtf(wsum(x1 * x1 + x2 * x2) * (1.0f / 128.0f) + NORM_EPS);
            x1 = x1 * rstd * g1; x2 = x2 * rstd * g2;
            const int row = b * T + 16 * n + 31; const float cs = ct[row * 64 + lane], sn = st[row * 64 + lane];
            KCN[o + lane] = (bf16)f2bf(x1 * cs - x2 * sn); KCN[o + lane + 64] = (bf16)f2bf(x1 * sn + x2 * cs);
        } else {
            const float v1 = n == 127 ? 0.f : VCR[o + lane], v2 = n == 127 ? 0.f : VCR[o + lane + 64];
            VCT[((size_t)bg * 128 + lane) * 128 + n] = (bf16)f2bf(v1); VCT[((size_t)bg * 128 + lane + 64) * 128 + n] = (bf16)f2bf(v2);
        }
    }
}
__device__ __forceinline__ void cmp_raw(const Ctx& c, const bf16* Y, const float* pe_k, const float* pe_v, const float* phi_k, const float* phi_v, float* KCR, float* VCR) {
    const int lane = c.lane;
    for (int it = c.gw; it < 2 * 16 * 127; it += c.ngw) {
        const int which = it / (16 * 127), r = it - which * (16 * 127), bg = r / 127, n = r - bg * 127, b = bg >> 2, g = bg & 3;
        const float* pe = which ? pe_v : pe_k; const float* phi = which ? phi_v : phi_k;
        const bf16* src = Y + ((size_t)b * T + 16 * n) * EVEN_LD + (which ? C_VC : C_KC) + g * 128;
        float a0 = 0.f, a1 = 0.f;
        for (int l = 0; l < 32; ++l) {
            const bf16* sr = src + (size_t)l * EVEN_LD;
#pragma unroll 4
            for (int d = 0; d < 128; ++d) { const float a = bf2f(sr[d]) + pe[l * 128 + d]; const float2 ph = *(const float2*)(phi + (size_t)(l * 128 + d) * 128 + 2 * lane); a0 += a * ph.x; a1 += a * ph.y; }
        }
        float* dst = (which ? VCR : KCR) + ((size_t)bg * 128 + n) * 128 + 2 * lane; dst[0] = a0; dst[1] = a1;
    }
}
__device__ __forceinline__ void moba_kmean(const Ctx& c, const bf16* Y, float* kmean) {
    const int lane = c.lane;
    for (int it = c.gw; it < NB * 16 * 8; it += c.ngw) {
        const int b = it >> 7, h = (it >> 3) & 15, n = it & 7;
        const bf16* src = Y + ((size_t)b * T + 256 * n) * EVEN_LD + C_MK + h * 128 + 2 * lane;
        float a0 = 0.f, a1 = 0.f;
        for (int k = 0; k < 256; ++k) { const unsigned w = *(const unsigned*)(src + (size_t)k * EVEN_LD); a0 += bflo(w); a1 += bfhi(w); }
        float* dst = kmean + (size_t)it * 128 + 2 * lane; dst[0] = a0 * (1.0f / 256.0f); dst[1] = a1 * (1.0f / 256.0f);
    }
}

__device__ __forceinline__ float dot128(const LAS float* qs, const bf16* krow) {
    const v4u* kp = (const v4u*)krow; float s = 0.f;
#pragma unroll 4
    for (int cch = 0; cch < 16; ++cch) { const v4u w = kp[cch]; const LAS f32x4* q4 = (const LAS f32x4*)(qs + 8 * cch); const f32x4 qa = q4[0], qb = q4[1];
        s += qa.x * bflo(w.x) + qa.y * bfhi(w.x) + qa.z * bflo(w.y) + qa.w * bfhi(w.y) + qb.x * bflo(w.z) + qb.y * bfhi(w.z) + qb.z * bflo(w.w) + qb.w * bfhi(w.w); }
    return s;
}
__device__ __forceinline__ void load_q(LAS float* qs, const bf16* qrow, int lane) {
    LDS_FENCE();
    const unsigned w = *(const unsigned*)(qrow + 2 * lane); qs[2 * lane] = bflo(w); qs[2 * lane + 1] = bfhi(w);
    LDS_FENCE();
}
__device__ __forceinline__ void pv_accum(float& a0, float& a1, float p, int voff, const bf16* Vb, int lane) {
    for (int j = 0; j < 64; ++j) {
        const float pj = rdlane(p, j);
        if (pj != 0.f) { const int off = __builtin_amdgcn_readlane(voff, j); const unsigned w = *(const unsigned*)(Vb + (size_t)off + 2 * lane); a0 += pj * bflo(w); a1 += pj * bfhi(w); }
    }
}
struct SoftAcc { float m, l, a0, a1; };
__device__ __forceinline__ void sa_init(SoftAcc& S) { S.m = NEG_INF; S.l = 0.f; S.a0 = 0.f; S.a1 = 0.f; }
__device__ __forceinline__ void sa_chunk(SoftAcc& S, float s  , int voff, const bf16* Vb, int lane) {
    const float cm = wmax(s);
    if (cm == NEG_INF) return;
    const float mn = fmaxf(S.m, cm);
    const float p = __expf(s - mn), alpha = __expf(S.m - mn);
    S.l = S.l * alpha + wsum(p); S.a0 *= alpha; S.a1 *= alpha; S.m = mn;
    pv_accum(S.a0, S.a1, p, voff, Vb, lane);
}
__device__ __forceinline__ void moba_row(const Ctx& c, LAS float* qs, const bf16* Y, const float* kmean, bf16* O, int b, int h, int t) {
    const int lane = c.lane; const size_t row = (size_t)b * T + t; const bf16* Yb = Y + (size_t)b * T * EVEN_LD;
    load_q(qs, Y + row * EVEN_LD + C_MQ + h * 128, lane);
    const int cur = t >> 8;
    float gate = NEG_INF;
    if (lane < cur) { const float* km = kmean + ((size_t)(b * 16 + h) * 8 + lane) * 128; float s = 0.f; for (int d = 0; d < 128; ++d) s += qs[d] * km[d]; gate = s; }
    int rank = 0;
    for (int m2 = 0; m2 < 8; ++m2) { const float gm = rdlane(gate, m2); rank += (gm > gate || (gm == gate && m2 < lane)) ? 1 : 0; }
    const unsigned selmask = (unsigned)__ballot((lane < cur) && (rank < 3));
    SoftAcc S; sa_init(S);
    const bf16* Kb = Yb + C_MK + h * 128; const bf16* Vb = Yb + C_MV + h * 128;
    const int nch = (t >> 6) + 1;
    for (int kc = 0; kc < nch; ++kc) {
        const int n = kc >> 2;
        if (n < cur && !((selmask >> n) & 1u)) continue;
        const int key = kc * 64 + lane; const bool valid = key <= t; const int koff = (valid ? key : t) * EVEN_LD;
        float s = dot128(qs, Kb + koff) * ATT_SCALE; if (!valid) s = NEG_INF;
        sa_chunk(S, s, koff, Vb, lane);
    }
    const float inv = 1.0f / fmaxf(S.l, 1e-30f);
    *(unsigned*)(O + row * DM + h * 128 + 2 * lane) = pk2(S.a0 * inv, S.a1 * inv);
}
__device__ __forceinline__ void nsa_item(const Ctx& c, LAS float* qs, LAS float* ps, const bf16* Y, const bf16* KCN, const bf16* VCN, bf16* O, int b, int g, int t) {
    const int lane = c.lane; const size_t row = (size_t)b * T + t; const bf16* Yb = Y + (size_t)b * T * EVEN_LD;
    const bf16* Kc = KCN + (size_t)(b * 4 + g) * 128 * 128; const bf16* Vc = VCN + (size_t)(b * 4 + g) * 128 * 128;
    float oc0[4], oc1[4]; float P0 = 0.f, P1 = 0.f;
    const int n0 = lane, n1 = 64 + lane; const bool v0 = 16 * n0 + 31 <= t, v1 = (n1 < 127) && (16 * n1 + 31 <= t);
#pragma unroll
    for (int hh = 0; hh < 4; ++hh) {
        load_q(qs, Y + row * EVEN_LD + C_NQ + (g * 4 + hh) * 128, lane);
        float s0 = dot128(qs, Kc + (v0 ? n0 : 0) * 128) * ATT_SCALE, s1 = dot128(qs, Kc + (v1 ? n1 : 0) * 128) * ATT_SCALE;
        if (!v0) s0 = NEG_INF; if (!v1) s1 = NEG_INF;
        const float m = wmax(fmaxf(s0, s1)); float a0 = 0.f, a1 = 0.f;
        if (m != NEG_INF) {
            float p0 = __expf(s0 - m), p1 = __expf(s1 - m);
            const float inv = 1.0f / fmaxf(wsum(p0 + p1), 1e-30f);
            p0 *= inv; p1 *= inv; P0 += p0; P1 += p1;
            pv_accum(a0, a1, p0, n0 * 128, Vc, lane); pv_accum(a0, a1, p1, (v1 ? n1 : 0) * 128, Vc, lane);
        }
        oc0[hh] = a0; oc1[hh] = a1;
    }
    LDS_FENCE(); ps[lane] = P0; ps[64 + lane] = P1; LDS_FENCE();
    float imp = 0.f;
    if (lane < 32) { for (int n = 4 * lane - 1; n <= 4 * lane + 3; ++n) if (n >= 0 && n < 127) imp += ps[n]; }
    const int cur = t >> 6;
    const float v = (lane >= 32) ? NEG_INF : ((lane == cur || lane == 0) ? __builtin_inff() : (lane <= cur ? imp : NEG_INF));
    int rank = 0;
    for (int m2 = 0; m2 < 32; ++m2) { const float vm = rdlane(v, m2); rank += (vm > v || (vm == v && m2 < lane)) ? 1 : 0; }
    const unsigned selmask = (unsigned)__ballot(lane < 32 && lane <= cur && rank < 16);
    const bf16* Ks = Yb + C_KS + g * 128; const bf16* Vs = Yb + C_VS + g * 128; const bf16* Kw = Yb + C_KW + g * 128; const bf16* Vw = Yb + C_VW + g * 128;
#pragma unroll
    for (int hh = 0; hh < 4; ++hh) {
        const int h = g * 4 + hh;
        load_q(qs, Y + row * EVEN_LD + C_NQ + h * 128, lane);
        SoftAcc S; sa_init(S);
        for (int j = 0; j <= cur; ++j) {
            if (!((selmask >> j) & 1u)) continue;
            const int key = 64 * j + lane; const bool valid = key <= t; const int koff = (valid ? key : t) * EVEN_LD;
            float s = dot128(qs, Ks + koff) * ATT_SCALE; if (!valid) s = NEG_INF;
            sa_chunk(S, s, koff, Vs, lane);
        }
        SoftAcc W; sa_init(W);
        for (int c0 = 0; c0 < 512 && c0 <= t; c0 += 64) {
            const int key = t - c0 - lane; const bool valid = key >= 0; const int koff = (valid ? key : 0) * EVEN_LD;
            float s = dot128(qs, Kw + koff) * ATT_SCALE; if (!valid) s = NEG_INF;
            sa_chunk(W, s, koff, Vw, lane);
        }
        const bf16* gl = Y + row * EVEN_LD + C_GL + h * 3;
        const float g0 = 1.0f / (1.0f + __expf(-bf2f(gl[0]))), g1 = 1.0f / (1.0f + __expf(-bf2f(gl[1]))), g2 = 1.0f / (1.0f + __expf(-bf2f(gl[2])));
        const float is = 1.0f / fmaxf(S.l, 1e-30f), iw = 1.0f / fmaxf(W.l, 1e-30f);
        const float o0 = g0 * oc0[hh] + g1 * (S.a0 * is) + g2 * (W.a0 * iw), o1 = g0 * oc1[hh] + g1 * (S.a1 * is) + g2 * (W.a1 * iw);
        *(unsigned*)(O + row * DM + 2048 + h * 128 + 2 * lane) = pk2(o0, o1);
    }
}
__device__ __forceinline__ void sb_row(const Ctx& c, LAS float* qs, const bf16* Y, bf16* O, int b, int h, int t) {
    const int lane = c.lane; const size_t row = (size_t)b * T + t; const bf16* Yb = Y + (size_t)b * T * ODD_LD;
    load_q(qs, Y + row * ODD_LD + C_SQ + h * 128, lane);
    const bf16* Kb = Yb + C_SK + h * 128; const bf16* Vb = Yb + C_SV + h * 128;
    float carry = 0.f, a0 = 0.f, a1 = 0.f;
    for (int c0 = 0; c0 < t; c0 += 64) {
        const int key = t - 1 - c0 - lane; const bool valid = key >= 0; const int koff = (valid ? key : 0) * ODD_LD;
        const float z = dot128(qs, Kb + koff) * ATT_SCALE;
        const float L = __logf(1.0f + __expf(-fabsf(z)));
        const float lsp = fminf(z, 0.f) - L;
        const float lr = valid ? (lsp - z) : 0.f;
        float incl = lr;
#pragma unroll
        for (int o = 1; o < 64; o <<= 1) { const float u = __shfl_up(incl, o); if (lane >= o) incl += u; }
        const float a = valid ? __expf(lsp + carry + (incl - lr)) : 0.f;
        carry += rdlane(incl, 63);
        pv_accum(a0, a1, a, koff, Vb, lane);
    }
    *(unsigned*)(O + row * DM + h * 128 + 2 * lane) = pk2(a0, a1);
}
__device__ __forceinline__ void dil_row(const Ctx& c, LAS float* qs, const bf16* Y, bf16* O, int b, int hd, int t) {
    const int lane = c.lane; const size_t row = (size_t)b * T + t; const bf16* Yb = Y + (size_t)b * T * ODD_LD;
    float og0[3], og1[3], lse[3];
#pragma unroll
    for (int gi = 0; gi < 3; ++gi) {
        const int r = gi == 0 ? 1 : (gi == 1 ? 4 : 16), nd = gi * 8 + hd;
        load_q(qs, Y + row * ODD_LD + C_DQ + nd * 128, lane);
        const bf16* Kb = Yb + C_DK + nd * 128; const bf16* Vb = Yb + C_DV + nd * 128;
        SoftAcc S; sa_init(S);
        for (int c0 = 0; c0 < 129; c0 += 64) {
            const int ci = c0 + lane, key = t - r * ci; const bool valid = (ci <= 128) && key >= 0; const int koff = (valid ? key : 0) * ODD_LD;
            float s = dot128(qs, Kb + koff) * ATT_SCALE; if (!valid) s = NEG_INF;
            sa_chunk(S, s, koff, Vb, lane);
        }
        const float inv = 1.0f / fmaxf(S.l, 1e-30f);
        og0[gi] = S.a0 * inv; og1[gi] = S.a1 * inv; lse[gi] = S.m + __logf(fmaxf(S.l, 1e-30f));
    }
    const float mx = fmaxf(lse[0], fmaxf(lse[1], lse[2]));
    const float w0 = __expf(lse[0] - mx), w1 = __expf(lse[1] - mx), w2 = __expf(lse[2] - mx), iw = 1.0f / (w0 + w1 + w2);
    *(unsigned*)(O + row * DM + 3072 + hd * 128 + 2 * lane) = pk2((w0 * og0[0] + w1 * og0[1] + w2 * og0[2]) * iw, (w0 * og1[0] + w1 * og1[1] + w2 * og1[2]) * iw);
}
__device__ __forceinline__ void xattn_row(const Ctx& c, LAS float* qs, const bf16* QX, const bf16* KVX, bf16* OX, int b, int h, int t) {
    const int lane = c.lane; const size_t row = (size_t)b * T + t;
    load_q(qs, QX + row * XW + h * 128, lane);
    const bf16* Kb = KVX + (size_t)b * MEM_LEN * 1024 + h * 128; const bf16* Vb = Kb + 512;
    SoftAcc S; sa_init(S);
    for (int c0 = 0; c0 < MEM_LEN; c0 += 64) { const int koff = (c0 + lane) * 1024; const float s = dot128(qs, Kb + koff) * ATT_SCALE; sa_chunk(S, s, koff, Vb, lane); }
    const float inv = 1.0f / fmaxf(S.l, 1e-30f);
    *(unsigned*)(OX + row * XW + h * 128 + 2 * lane) = pk2(S.a0 * inv, S.a1 * inv);
}
__device__ __forceinline__ int spread_t(int i) { return ((i & (T - 1)) + (i >> 11) * 997) & (T - 1); }


namespace fa {
typedef short bf16x8 __attribute__((ext_vector_type(8)));
typedef short s16x4 __attribute__((ext_vector_type(4)));
typedef float f32x16 __attribute__((ext_vector_type(16)));
typedef unsigned u32x2 __attribute__((ext_vector_type(2)));
constexpr int KT_BYTES = 64 * 256, VT_PITCH = 136, VT_BYTES = 128 * VT_PITCH, STAGE = KT_BYTES + VT_BYTES;
constexpr float C2 = 0.08838834764831845f * 1.4426950408889634f;
struct Unit {
    const bf16* q; int qstride;
    const bf16* k; int kstride;
    const bf16* vt; int vts;
    bf16* o; int ostride;
    float* lse; int lse_stride;
    const unsigned* sel; int sel_stride;
    int pos0, t_lo, t_hi;
    int window, causal;
    int sel_shift, own_blk, nrows;
    const float* kmean;
};
__device__ __forceinline__ unsigned cvtpk(float lo, float hi) { return pg8::cvt_pk_bf16(lo, hi); }
__device__ __forceinline__ bf16x8 pack8(const f32x16& p, const int b) { v4u w = {cvtpk(p[b + 0], p[b + 1]), cvtpk(p[b + 2], p[b + 3]), cvtpk(p[b + 4], p[b + 5]), cvtpk(p[b + 6], p[b + 7])}; return __builtin_bit_cast(bf16x8, w); }

#define FA_LOAD(tile) do { const int kb_ = (tile) * 64; const bf16* kp_ = u.k + (size_t)(kb_ + sr) * u.kstride + sc * 8; kq0 = *(const v4u*)kp_; kq1 = *(const v4u*)(kp_ + (size_t)32 * u.kstride); \
        const bf16* vp_ = u.vt + (size_t)vr * u.vts + kb_ + vc * 8; vq0 = *(const v4u*)vp_; vq1 = *(const v4u*)(vp_ + (size_t)64 * u.vts); } while (0)
#define FA_WRITE(st) do { LAS unsigned char* b_ = L + (st) * STAGE; *(LAS v4u*)(b_ + kw0) = kq0; *(LAS v4u*)(b_ + kw0 + 32 * 256) = kq1; \
        *(LAS u32x2*)(b_ + vw0) = (u32x2){vq0.x, vq0.y}; *(LAS u32x2*)(b_ + vw0 + 8) = (u32x2){vq0.z, vq0.w}; *(LAS u32x2*)(b_ + vw0 + 64 * VT_PITCH) = (u32x2){vq1.x, vq1.y}; *(LAS u32x2*)(b_ + vw0 + 64 * VT_PITCH + 8) = (u32x2){vq1.z, vq1.w}; } while (0)
#define FA_QK(st) do { const LAS unsigned char* kl_ = L + (st) * STAGE; p0 = f32x16{}; p1 = f32x16{}; \
        _Pragma("unroll") for (int d0 = 0; d0 < 8; ++d0) { const int cb_ = (d0 * 32 + hi * 16) ^ ((r32 & 7) << 4); const bf16x8 a0 = *(const LAS bf16x8*)(kl_ + r32 * 256 + cb_); const bf16x8 a1 = *(const LAS bf16x8*)(kl_ + (32 + r32) * 256 + cb_); \
            p0 = __builtin_amdgcn_mfma_f32_32x32x16_bf16(a0, q[d0], p0, 0, 0, 0); p1 = __builtin_amdgcn_mfma_f32_32x32x16_bf16(a1, q[d0], p1, 0, 0, 0); } } while (0)
#define FA_PV(st) do { const LAS unsigned char* vl_ = L + (st) * STAGE + KT_BYTES + r32 * VT_PITCH + hi * 8; \
        _Pragma("unroll") for (int db = 0; db < 4; ++db) { _Pragma("unroll") for (int j = 0; j < 4; ++j) { const s16x4 lo_ = *(const LAS s16x4*)(vl_ + db * 32 * VT_PITCH + 32 * j); const s16x4 hi_ = *(const LAS s16x4*)(vl_ + db * 32 * VT_PITCH + 32 * j + 16); \
            const bf16x8 a_ = {lo_[0], lo_[1], lo_[2], lo_[3], hi_[0], hi_[1], hi_[2], hi_[3]}; o[db] = __builtin_amdgcn_mfma_f32_32x32x16_bf16(a_, P[j], o[db], 0, 0, 0); } } } while (0)

template <int MODE>
__device__ __forceinline__ void run_unit(const Ctx& c, const Unit& u) {
    const int tid = c.tid, lane = c.lane, w = c.wave, r32 = lane & 31, hi = lane >> 5;
    LAS unsigned char* L = c.lds;
    const int row = 32 * w + r32; const bool wact = 32 * w < u.nrows;
    bf16x8 q[8];
    { const bf16* qp = u.q + (size_t)(wact ? row : 0) * u.qstride + hi * 8;
#pragma unroll
      for (int d0 = 0; d0 < 8; ++d0) q[d0] = *(const bf16x8*)(qp + 16 * d0); }
    const int pq = u.pos0 + row, wlo = u.pos0 + 32 * w, whi = wlo + 31;
    unsigned selm = 0xffffffffu; if (u.sel && wact) selm = u.sel[(size_t)row * u.sel_stride];
    const int sr = tid >> 4, sc = tid & 15, vr = tid >> 3, vc = tid & 7;
    const int kw0 = sr * 256 + ((sc * 16) ^ ((sr & 7) << 4)), vw0 = KT_BYTES + vr * VT_PITCH + vc * 16;
    v4u kq0, kq1, vq0, vq1;
    f32x16 o[4] = {f32x16{}, f32x16{}, f32x16{}, f32x16{}}; f32x16 p0, p1; bf16x8 P[4];
    float m_run = -1e30f, l_run = 0.f, carry = 0.f;
    const int nt = u.t_hi - u.t_lo;
    __syncthreads();
    if (nt > 0) { FA_LOAD(MODE == 0 ? u.t_lo : u.t_hi - 1); FA_WRITE(0); }
    if (MODE == 0 && u.kmean) {
        const int grow = tid >> 5, gd4 = (tid & 31) * 4, gn = grow & 7; const f32x4 km = *(const f32x4*)(u.kmean + gn * 128 + gd4);
        unsigned h0 = f2bf(km.x), h1 = f2bf(km.y), h2 = f2bf(km.z), h3 = f2bf(km.w);
        if (grow >> 3) { h0 = f2bf(km.x - bflo(h0)); h1 = f2bf(km.y - bflo(h1)); h2 = f2bf(km.z - bflo(h2)); h3 = f2bf(km.w - bflo(h3)); }
        *(LAS u32x2*)(L + STAGE + grow * 256 + ((gd4 * 2) ^ ((grow & 7) << 4))) = (u32x2){h0 | (h1 << 16), h2 | (h3 << 16)};
    }
    __syncthreads();
    if (MODE == 0 && u.kmean) {
        FA_QK(1);
        float gown[4], g8[8];
#pragma unroll
        for (int e = 0; e < 4; ++e) gown[e] = p0[e] + p0[4 + e];
#pragma unroll
        for (int e = 0; e < 4; ++e) { const float go = __shfl_xor(gown[e], 32); g8[e] = hi ? go : gown[e]; g8[4 + e] = hi ? gown[e] : go; }
#pragma unroll
        for (int n = 0; n < 8; ++n) if (n >= u.own_blk) g8[n] = NEG_INF;
        selm = 0u;
#pragma unroll
        for (int n = 0; n < 8; ++n) { int rank = 0;
#pragma unroll
            for (int m2 = 0; m2 < 8; ++m2) rank += (g8[m2] > g8[n] || (g8[m2] == g8[n] && m2 < n)) ? 1 : 0;
            if (rank < 3 && n < u.own_blk) selm |= 1u << n; }
        __syncthreads();
    }
    for (int i = 0; i < nt; ++i) {
        const int tile = MODE == 0 ? u.t_lo + i : u.t_hi - 1 - i, st = i & 1, kb = tile * 64;
        if (i + 1 < nt) FA_LOAD(MODE == 0 ? tile + 1 : tile - 1);
        if (MODE == 0) {
            bool act = wact;
            if (u.causal && (kb > whi || kb + 63 <= wlo - u.window)) act = false;
            bool allowed = true;
            if (u.sel || u.kmean) { const int blk = tile >> u.sel_shift; allowed = (blk == u.own_blk) || ((selm >> blk) & 1u); if (!__any(allowed)) act = false; }
            if (act) {
                FA_QK(st);
                if (u.causal && (kb + 63 > wlo || kb <= whi - u.window)) {
                    const int dq = pq - kb - 4 * hi;
#pragma unroll
                    for (int r = 0; r < 16; ++r) { const int cc = (r & 3) + 8 * (r >> 2);
                        if ((unsigned)(dq - cc) >= (unsigned)u.window) p0[r] = NEG_INF;
                        if ((unsigned)(dq - cc - 32) >= (unsigned)u.window) p1[r] = NEG_INF; }
                }
                if (!allowed) {
#pragma unroll
                    for (int r = 0; r < 16; ++r) { p0[r] = NEG_INF; p1[r] = NEG_INF; } }
                float pm = fmaxf(p0[0], p1[0]);
#pragma unroll
                for (int r = 1; r < 16; ++r) pm = fmaxf(pm, fmaxf(p0[r], p1[r]));
                pm = fmaxf(pm, __shfl_xor(pm, 32));
                const float mn = fmaxf(m_run, pm), alpha = __builtin_amdgcn_exp2f((m_run - mn) * C2), mb = mn * C2; m_run = mn;
                float ps = 0.f;
#pragma unroll
                for (int r = 0; r < 16; ++r) { p0[r] = __builtin_amdgcn_exp2f(p0[r] * C2 - mb); p1[r] = __builtin_amdgcn_exp2f(p1[r] * C2 - mb); ps += p0[r] + p1[r]; }
                l_run = l_run * alpha + ps;
                if (__any(alpha != 1.0f)) {
#pragma unroll
                    for (int db = 0; db < 4; ++db)
#pragma unroll
                        for (int r = 0; r < 16; ++r) o[db][r] *= alpha; }
                P[0] = pack8(p0, 0); P[1] = pack8(p0, 8); P[2] = pack8(p1, 0); P[3] = pack8(p1, 8);
                FA_PV(st);
            }
        } else {
            if (wact && kb < whi) {
                FA_QK(st);
                const int dq = pq - kb - 4 * hi;
                float own[8];
#define FA_SBG(PP, g, koff) do { float lr_[4], ls_[4]; \
                    _Pragma("unroll") for (int e = 0; e < 4; ++e) { const int cc = e + 8 * (g) + (koff); const float z = PP[4 * (g) + e] * ATT_SCALE; const float lg = __logf(1.0f + __expf(-fabsf(z))); \
                        const bool strict = dq - cc > 0; const float lr = fminf(z, 0.f) - lg - z; lr_[e] = strict ? lr : 0.f; ls_[e] = strict ? lr + z : NEG_INF; } \
                    PP[4 * (g) + 3] = ls_[3]; PP[4 * (g) + 2] = ls_[2] + lr_[3]; PP[4 * (g) + 1] = ls_[1] + (lr_[3] + lr_[2]); PP[4 * (g)] = ls_[0] + (lr_[3] + lr_[2] + lr_[1]); \
                    own[(g) + ((koff) ? 4 : 0)] = (lr_[3] + lr_[2]) + (lr_[1] + lr_[0]); } while (0)
                FA_SBG(p0, 0, 0); FA_SBG(p0, 1, 0); FA_SBG(p0, 2, 0); FA_SBG(p0, 3, 0); FA_SBG(p1, 0, 32); FA_SBG(p1, 1, 32); FA_SBG(p1, 2, 32); FA_SBG(p1, 3, 32);
#undef FA_SBG
                float oth[8];
#pragma unroll
                for (int g = 0; g < 8; ++g) oth[g] = __shfl_xor(own[g], 32);
                float suf = carry;
#pragma unroll
                for (int g = 7; g >= 0; --g) {
                    const float base = suf + (hi == 0 ? oth[g] : 0.f);
                    if (g >= 4) {
#pragma unroll
                        for (int e = 0; e < 4; ++e) p1[4 * (g - 4) + e] = __expf(p1[4 * (g - 4) + e] + base);
                    } else {
#pragma unroll
                        for (int e = 0; e < 4; ++e) p0[4 * g + e] = __expf(p0[4 * g + e] + base);
                    }
                    suf += own[g] + oth[g];
                }
                carry = suf;
                P[0] = pack8(p0, 0); P[1] = pack8(p0, 8); P[2] = pack8(p1, 0); P[3] = pack8(p1, 8);
                FA_PV(st);
            }
        }
#ifdef FA_EXTRA_SYNC
        __syncthreads();
#endif
        if (i + 1 < nt) FA_WRITE(st ^ 1);
        __syncthreads();
    }
    if (wact) {
        float inv = 1.0f;
        if (MODE == 0) { const float lt = l_run + __shfl_xor(l_run, 32); inv = lt > 0.f ? 1.0f / lt : 0.f;
            if (u.lse && hi == 0) u.lse[(size_t)row * u.lse_stride] = m_run * ATT_SCALE + __logf(fmaxf(lt, 1e-30f)); }
        bf16* op = u.o + (size_t)row * u.ostride + 4 * hi;
#pragma unroll
        for (int db = 0; db < 4; ++db)
#pragma unroll
            for (int g = 0; g < 4; ++g) { u32x2 wv; wv.x = cvtpk(o[db][4 * g] * inv, o[db][4 * g + 1] * inv); wv.y = cvtpk(o[db][4 * g + 2] * inv, o[db][4 * g + 3] * inv);
                *(u32x2*)(op + 32 * db + 8 * g) = wv; }
    }
}

__device__ __forceinline__ void cmp_unit(const Ctx& c, const bf16* Yq  , int ldy, const bf16* Kc, const bf16* Vct, bf16* OCrow  , unsigned* SELrow  , int tt) {
    const int tid = c.tid, lane = c.lane, w = c.wave, r32 = lane & 31, hi = lane >> 5;
    LAS unsigned char* L = c.lds;
    const int tok = 8 * w + (r32 >> 2), hh = r32 & 3, t = 64 * tt + tok;
    struct { const bf16* k; int kstride; const bf16* vt; int vts; } u; u.k = Kc; u.kstride = 128; u.vt = Vct; u.vts = 128;
    bf16x8 q[8];
    { const bf16* qp = Yq + (size_t)tok * ldy + hh * 128 + hi * 8;
#pragma unroll
      for (int d0 = 0; d0 < 8; ++d0) q[d0] = *(const bf16x8*)(qp + 16 * d0); }
    const int sr = tid >> 4, sc = tid & 15, vr = tid >> 3, vc = tid & 7;
    const int kw0 = sr * 256 + ((sc * 16) ^ ((sr & 7) << 4)), vw0 = KT_BYTES + vr * VT_PITCH + vc * 16;
    v4u kq0, kq1, vq0, vq1;
    __syncthreads();
    FA_LOAD(0); FA_WRITE(0); FA_LOAD(1); FA_WRITE(1);
    __syncthreads();
    f32x16 p0, p1, s00, s01;
    FA_QK(0); s00 = p0; s01 = p1;
    FA_QK(1);
    const int nmax = (t - 31) >> 4;
    { const int nb = 4 * hi;
#pragma unroll
      for (int r = 0; r < 16; ++r) { const int cc = (r & 3) + 8 * (r >> 2) + nb;
          if (cc > nmax) s00[r] = NEG_INF; if (cc + 32 > nmax) s01[r] = NEG_INF; if (cc + 64 > nmax) p0[r] = NEG_INF; if (cc + 96 > nmax || cc + 96 > 126) p1[r] = NEG_INF; } }
    float pm = NEG_INF;
#pragma unroll
    for (int r = 0; r < 16; ++r) pm = fmaxf(pm, fmaxf(fmaxf(s00[r], s01[r]), fmaxf(p0[r], p1[r])));
    pm = fmaxf(pm, __shfl_xor(pm, 32));
    const float mb = (pm == NEG_INF ? 0.f : pm) * C2;
    float ps = 0.f;
#pragma unroll
    for (int r = 0; r < 16; ++r) { s00[r] = __builtin_amdgcn_exp2f(s00[r] * C2 - mb); s01[r] = __builtin_amdgcn_exp2f(s01[r] * C2 - mb); p0[r] = __builtin_amdgcn_exp2f(p0[r] * C2 - mb); p1[r] = __builtin_amdgcn_exp2f(p1[r] * C2 - mb);
        ps += (s00[r] + s01[r]) + (p0[r] + p1[r]); }
    ps += __shfl_xor(ps, 32);
    const float inv = 1.0f / fmaxf(ps, 1e-30f);
#pragma unroll
    for (int r = 0; r < 16; ++r) { s00[r] *= inv; s01[r] *= inv; p0[r] *= inv; p1[r] *= inv; }
    f32x16 o[4] = {f32x16{}, f32x16{}, f32x16{}, f32x16{}}; bf16x8 P[4];
    P[0] = pack8(s00, 0); P[1] = pack8(s00, 8); P[2] = pack8(s01, 0); P[3] = pack8(s01, 8); FA_PV(0);
    P[0] = pack8(p0, 0); P[1] = pack8(p0, 8); P[2] = pack8(p1, 0); P[3] = pack8(p1, 8); FA_PV(1);
    { bf16* op = OCrow + (size_t)tok * 2048 + hh * 128 + 4 * hi;
#pragma unroll
      for (int db = 0; db < 4; ++db)
#pragma unroll
          for (int g = 0; g < 4; ++g) { u32x2 wv; wv.x = cvtpk(o[db][4 * g], o[db][4 * g + 1]); wv.y = cvtpk(o[db][4 * g + 2], o[db][4 * g + 3]); *(u32x2*)(op + 32 * db + 8 * g) = wv; } }
    float cs[16], cl[16];
#pragma unroll
    for (int rq = 0; rq < 4; ++rq) {
        cs[rq] = (s00[4 * rq] + s00[4 * rq + 1]) + (s00[4 * rq + 2] + s00[4 * rq + 3]); cl[rq] = s00[4 * rq + 3];
        cs[4 + rq] = (s01[4 * rq] + s01[4 * rq + 1]) + (s01[4 * rq + 2] + s01[4 * rq + 3]); cl[4 + rq] = s01[4 * rq + 3];
        cs[8 + rq] = (p0[4 * rq] + p0[4 * rq + 1]) + (p0[4 * rq + 2] + p0[4 * rq + 3]); cl[8 + rq] = p0[4 * rq + 3];
        cs[12 + rq] = (p1[4 * rq] + p1[4 * rq + 1]) + (p1[4 * rq + 2] + p1[4 * rq + 3]); cl[12 + rq] = p1[4 * rq + 3]; }
#pragma unroll
    for (int k = 0; k < 16; ++k) { cs[k] += __shfl_xor(cs[k], 1); cs[k] += __shfl_xor(cs[k], 2); cl[k] += __shfl_xor(cl[k], 1); cl[k] += __shfl_xor(cl[k], 2); }
    float impE[16], impO[16];
    { float ocs[16], ocl[16];
#pragma unroll
      for (int k = 0; k < 16; ++k) { ocs[k] = __shfl_xor(cs[k], 32); ocl[k] = __shfl_xor(cl[k], 32); }
#pragma unroll
      for (int k = 0; k < 16; ++k) { const float ecs = hi ? ocs[k] : cs[k], ocs_ = hi ? cs[k] : ocs[k], clO = hi ? ocl[k] : cl[k];
          float clE = 0.f; if (k > 0) clE = hi ? cl[k - 1] : ocl[k - 1];
          impE[k] = ecs + clE; impO[k] = ocs_ + clO; } }
    LAS float* tab = (LAS float*)(L + 2 * STAGE) + (8 * w + (r32 >> 2)) * 32;
    if (hh == 0 && hi == 0) {
#pragma unroll
        for (int k = 0; k < 16; ++k) { const int je = 2 * k, jo = 2 * k + 1;
            const float ve = (je == 0 || je == tt) ? __builtin_inff() : (je <= tt ? impE[k] : NEG_INF), vo = (jo == tt) ? __builtin_inff() : (jo <= tt ? impO[k] : NEG_INF);
            tab[je] = ve; tab[jo] = vo; } }
    LDS_FENCE();
    const int a4 = 4 * (hh + 4 * hi);
    const f32x4 vj = *(const LAS f32x4*)(tab + a4);
    int rk0 = 0, rk1 = 0, rk2 = 0, rk3 = 0;
#pragma unroll
    for (int i4 = 0; i4 < 8; ++i4) { const f32x4 vi = *(const LAS f32x4*)(tab + 4 * i4);
#pragma unroll
        for (int e = 0; e < 4; ++e) { const float x = vi[e]; const int i = 4 * i4 + e;
            rk0 += (x > vj.x || (x == vj.x && i < a4 + 0)) ? 1 : 0; rk1 += (x > vj.y || (x == vj.y && i < a4 + 1)) ? 1 : 0;
            rk2 += (x > vj.z || (x == vj.z && i < a4 + 2)) ? 1 : 0; rk3 += (x > vj.w || (x == vj.w && i < a4 + 3)) ? 1 : 0; } }
    unsigned m = 0u;
    if (rk0 < 16 && a4 + 0 <= tt) m |= 1u << (a4 + 0); if (rk1 < 16 && a4 + 1 <= tt) m |= 1u << (a4 + 1); if (rk2 < 16 && a4 + 2 <= tt) m |= 1u << (a4 + 2); if (rk3 < 16 && a4 + 3 <= tt) m |= 1u << (a4 + 3);
    m |= (unsigned)__shfl_xor((int)m, 1); m |= (unsigned)__shfl_xor((int)m, 2); m |= (unsigned)__shfl_xor((int)m, 32);
    if (hh == 0 && hi == 0) SELrow[tok] = m;
    LDS_FENCE();
}
#undef FA_LOAD
#undef FA_WRITE
#undef FA_QK
#undef FA_PV
}


__device__ __forceinline__ void vt_pass(const Ctx& c, const bf16* Ysrc, int ld, int col0, int nheads, bf16* VT, int NH, int head0, int TL, int dil_mode) {
    LAS unsigned char* scr = c.lds + c.wave * 16384; const int lane = c.lane; const int npb = TL / 32, items = NB * nheads * npb;
    for (int it = c.gw; it < items; it += c.ngw) {
        const int pb = it % npb, bh = it / npb, hh = bh % nheads, b = bh / nheads;
        const int r = dil_mode ? (hh < 8 ? 1 : (hh < 16 ? 4 : 16)) : 1, CL = TL / r, pp0 = 32 * pb, cls = pp0 / CL, i0 = pp0 - cls * CL, tok0 = cls + r * i0;
        const bf16* src = Ysrc + ((size_t)b * TL + tok0) * ld + col0 + hh * 128;
#pragma unroll
        for (int k = 0; k < 8; ++k) { const int ci = lane + 64 * k, rr = ci >> 4, ch = ci & 15; const v4u w = *(const v4u*)(src + (size_t)rr * r * ld + ch * 8);
            LAS unsigned* d2 = (LAS unsigned*)(scr + rr * 264 + ch * 16); d2[0] = w.x; d2[1] = w.y; d2[2] = w.z; d2[3] = w.w; }
        LDS_FENCE();
        bf16* dst = VT + ((size_t)(b * NH + head0 + hh) * 128) * TL + pp0;
#pragma unroll
        for (int k = 0; k < 8; ++k) { const int ci = lane + 64 * k, d = ci >> 2, q4 = ci & 3; const LAS bf16* s = (const LAS bf16*)(scr + (8 * q4) * 264 + 2 * d);
            v4u o; o.x = (unsigned)s[0] | ((unsigned)s[132] << 16); o.y = (unsigned)s[2 * 132] | ((unsigned)s[3 * 132] << 16); o.z = (unsigned)s[4 * 132] | ((unsigned)s[5 * 132] << 16); o.w = (unsigned)s[6 * 132] | ((unsigned)s[7 * 132] << 16);
            *(v4u*)(dst + (size_t)d * TL + 8 * q4) = o; }
        LDS_FENCE();
    }
}
__device__ __forceinline__ void moba_sel_row(const Ctx& c, LAS float* qs, const bf16* Y, const float* kmean, unsigned* SELM, int b, int h, int t) {
    const int lane = c.lane; const size_t row = (size_t)b * T + t;
    load_q(qs, Y + row * EVEN_LD + C_MQ + h * 128, lane);
    const int cur = t >> 8;
    float gate = NEG_INF;
    if (lane < cur) { const float* km = kmean + ((size_t)(b * 16 + h) * 8 + lane) * 128; float s = 0.f; for (int d = 0; d < 128; ++d) s += qs[d] * km[d]; gate = s; }
    int rank = 0;
    for (int m2 = 0; m2 < 8; ++m2) { const float gm = rdlane(gate, m2); rank += (gm > gate || (gm == gate && m2 < lane)) ? 1 : 0; }
    const unsigned selmask = (unsigned)__ballot((lane < cur) && (rank < 3));
    if (lane == 0) SELM[(size_t)(b * 16 + h) * T + t] = selmask;
}
__device__ __forceinline__ void nsa_cmp_item(const Ctx& c, LAS float* qs, LAS float* ps, const bf16* Y, const bf16* KCN, const bf16* VCN, bf16* OC, unsigned* SELN, int b, int g, int t) {
    const int lane = c.lane; const size_t row = (size_t)b * T + t;
    const bf16* Kc = KCN + (size_t)(b * 4 + g) * 128 * 128; const bf16* Vc = VCN + (size_t)(b * 4 + g) * 128 * 128;
    float P0 = 0.f, P1 = 0.f;
    const int n0 = lane, n1 = 64 + lane; const bool v0 = 16 * n0 + 31 <= t, v1 = (n1 < 127) && (16 * n1 + 31 <= t);
#pragma unroll 1
    for (int hh = 0; hh < 4; ++hh) {
        const int h = g * 4 + hh;
        load_q(qs, Y + row * EVEN_LD + C_NQ + h * 128, lane);
        float s0 = dot128(qs, Kc + (v0 ? n0 : 0) * 128) * ATT_SCALE, s1 = dot128(qs, Kc + (v1 ? n1 : 0) * 128) * ATT_SCALE;
        if (!v0) s0 = NEG_INF; if (!v1) s1 = NEG_INF;
        const float m = wmax(fmaxf(s0, s1)); float a0 = 0.f, a1 = 0.f;
        if (m != NEG_INF) {
            float p0 = __expf(s0 - m), p1 = __expf(s1 - m);
            const float inv = 1.0f / fmaxf(wsum(p0 + p1), 1e-30f);
            p0 *= inv; p1 *= inv; P0 += p0; P1 += p1;
            pv_accum(a0, a1, p0, n0 * 128, Vc, lane); pv_accum(a0, a1, p1, (v1 ? n1 : 0) * 128, Vc, lane);
        }
        *(unsigned*)(OC + row * 2048 + h * 128 + 2 * lane) = pk2(a0, a1);
    }
    LDS_FENCE(); ps[lane] = P0; ps[64 + lane] = P1; LDS_FENCE();
    float imp = 0.f;
    if (lane < 32) { for (int n = 4 * lane - 1; n <= 4 * lane + 3; ++n) if (n >= 0 && n < 127) imp += ps[n]; }
    const int cur = t >> 6;
    const float v = (lane >= 32) ? NEG_INF : ((lane == cur || lane == 0) ? __builtin_inff() : (lane <= cur ? imp : NEG_INF));
    int rank = 0;
    for (int m2 = 0; m2 < 32; ++m2) { const float vm = rdlane(v, m2); rank += (vm > v || (vm == v && m2 < lane)) ? 1 : 0; }
    const unsigned selmask = (unsigned)__ballot(lane < 32 && lane <= cur && rank < 16);
    if (lane == 0) SELN[(size_t)(b * 4 + g) * T + t] = selmask;
}
__device__ __forceinline__ void nsa_combine(const Ctx& c, const bf16* Y, const bf16* OC, const bf16* OS, const bf16* OW, bf16* O) {
    const int lane = c.lane;
    for (int it = c.gw; it < MTOK * 16; it += c.ngw) {
        const int row = it >> 4, h = it & 15; const size_t off = (size_t)row * 2048 + h * 128 + 2 * lane;
        const bf16* gl = Y + (size_t)row * EVEN_LD + C_GL + h * 3;
        const float g0 = 1.0f / (1.0f + __expf(-bf2f(gl[0]))), g1 = 1.0f / (1.0f + __expf(-bf2f(gl[1]))), g2 = 1.0f / (1.0f + __expf(-bf2f(gl[2])));
        const unsigned wc = *(const unsigned*)(OC + off), wsv = *(const unsigned*)(OS + off), ww = *(const unsigned*)(OW + off);
        *(unsigned*)(O + (size_t)row * DM + 2048 + h * 128 + 2 * lane) = pk2(g0 * bflo(wc) + g1 * bflo(wsv) + g2 * bflo(ww), g0 * bfhi(wc) + g1 * bfhi(wsv) + g2 * bfhi(ww));
    }
}
__device__ __forceinline__ void dil_combine(const Ctx& c, const bf16* OG, const float* LSE, bf16* O) {
    const int lane = c.lane;
    for (int it = c.gw; it < MTOK * 8; it += c.ngw) {
        const int row = it >> 3, hd = it & 7; const size_t off = (size_t)row * 1024 + hd * 128 + 2 * lane;
        const float l0 = LSE[(size_t)row * 8 + hd], l1 = LSE[(size_t)MTOK * 8 + (size_t)row * 8 + hd], l2 = LSE[(size_t)2 * MTOK * 8 + (size_t)row * 8 + hd];
        const float mx = fmaxf(l0, fmaxf(l1, l2)); const float w0 = __expf(l0 - mx), w1 = __expf(l1 - mx), w2 = __expf(l2 - mx), iw = 1.0f / (w0 + w1 + w2);
        const unsigned a = *(const unsigned*)(OG + off), bq = *(const unsigned*)(OG + (size_t)MTOK * 1024 + off), cq = *(const unsigned*)(OG + (size_t)2 * MTOK * 1024 + off);
        *(unsigned*)(O + (size_t)row * DM + 3072 + hd * 128 + 2 * lane) = pk2((w0 * bflo(a) + w1 * bflo(bq) + w2 * bflo(cq)) * iw, (w0 * bfhi(a) + w1 * bfhi(bq) + w2 * bfhi(cq)) * iw);
    }
}
__device__ __forceinline__ int snake(int round, int b, int G) { return (round & 1) ? round * G + (G - 1 - b) : round * G + b; }

struct Args { const float* in[31]; float* out; unsigned char* ws; int ph_lo, ph_hi; };
#if MK_ONE_LAUNCH
#define GRID_BAR() xcd_barrier(bar)
#else
#define GRID_BAR() do { } while (0)
#endif
#define IN(k) (lo <= (k) && (k) < hi)
#define SEAM(k) do { if (IN(k) && IN((k) + 1)) GRID_BAR(); } while (0)
template <int layer>
__device__ __forceinline__ void run_layer(const Args& args, const Ctx& c, const XcdBarrier& bar, const int lo, const int hi) {
    unsigned char* ws = args.ws;
    const float* x_in = args.in[0]; const float* mem = args.in[1]; const int* positions = (const int*)args.in[2];
    float* ropec = (float*)(ws + WS_ROPE); float* ropes = ropec + MTOK * 64;
    float* kmean = (float*)(ws + WS_KMEAN); float* KCR = (float*)(ws + WS_KCR); float* VCR = (float*)(ws + WS_VCR);
    bf16* KCN = (bf16*)(ws + WS_KCN); bf16* VCN = (bf16*)(ws + WS_VCN); bf16* MEMN = (bf16*)(ws + WS_MEMN);
    bf16* QX = (bf16*)(ws + WS_QX); bf16* KVX = (bf16*)(ws + WS_KVX); bf16* OX = (bf16*)(ws + WS_OX);
    bf16* WQ_T = (bf16*)(ws + WS_WQ); bf16* WKV_T = (bf16*)(ws + WS_WKV); bf16* WO_T = (bf16*)(ws + WS_WO); bf16* WOUT_T = (bf16*)(ws + WS_WOUT);
    bf16* WIN_T = (bf16*)(ws + WS_WIN); bf16* WGU_T = (bf16*)(ws + WS_WGU); bf16* WD_T = (bf16*)(ws + WS_WD);
    float* X = (float*)(ws + WS_X); bf16* H = (bf16*)(ws + WS_H); bf16* O = (bf16*)(ws + WS_O); bf16* Y = (bf16*)(ws + WS_Y); bf16* HID = Y;
    LAS float* qs = (LAS float*)(c.lds + c.wave * 16384); LAS float* ps = qs + 128;
    bf16* VT = (bf16*)(ws + WS_VT); bf16* PART = (bf16*)(ws + WS_PART); bf16* VTX = (bf16*)(ws + WS_VTX); unsigned* SELM = (unsigned*)(ws + WS_SELM); unsigned* SELN = (unsigned*)(ws + WS_SELN);
    constexpr int pb = layer * NPL; constexpr bool even = (layer & 1) == 0;
        const int LDY = even ? EVEN_LD : ODD_LD;
        const float* xcur = layer == 0 ? x_in : X;
        if (IN(pb + 0)) REPS(pb + 0) {
            if (even) conv_weight(c, args.in[4], DM, EVEN_N, EVEN_LD, WIN_T, RmId{0}); else conv_weight(c, args.in[16], DM, ODD_LD, ODD_LD, WIN_T, RmId{0});
            conv_weight(c, even ? args.in[5] : args.in[17], DM, DM, DM, WOUT_T, RmId{0});
            conv_weight(c, args.in[22] + (size_t)layer * DM * XW, DM, XW, XW, WQ_T, RmId{0});
            conv_weight(c, args.in[23] + (size_t)layer * DM * 2 * XW, DM, 2 * XW, 2 * XW, WKV_T, RmId{0});
            conv_weight(c, args.in[24] + (size_t)layer * XW * DM, XW, DM, DM, WO_T, RmId{0});
            conv_weight(c, args.in[28] + (size_t)layer * DM * FFN, DM, FFN, FFN, WGU_T, RmGU{0});
            conv_weight(c, args.in[29] + (size_t)layer * DM * FFN, DM, FFN, FFN, WGU_T, RmGU{1});
            conv_weight(c, args.in[30] + (size_t)layer * FFN * DM, FFN, DM, DM, WD_T, RmId{0});
            if (layer == 0) rope_table(c, positions, ropec, ropes);
            rmsnorm_rows(c, mem, args.in[21] + layer * DM, MEMN, MEM_ROWS);
            rmsnorm_rows(c, xcur, args.in[3] + layer * DM, H, MTOK);
        }
        SEAM(pb + 0);
        if (IN(pb + 1)) REPS(pb + 1) {
            pg8::Gemm g{H, WIN_T, MTOK, LDY, DM}; pg8::StaticOrder S; S.init(MTOK, LDY, c.G, (int)blockIdx.x);
            pg8::EpiBf16P E{Y, LDY};
            pg8::gemm_phase<pg8::EpiBf16P, pg8::StaticOrder, true, true>(c.lds, g, S, E);
        }
        SEAM(pb + 1);
        if (IN(pb + 2)) REPS(pb + 2) {
            if (even) {
                headnorm_bf16(c, Y, EVEN_LD, C_MQ, 16, MTOK, args.in[6], ropec, ropes);
                headnorm_bf16(c, Y, EVEN_LD, C_MK, 16, MTOK, args.in[7], ropec, ropes);
                headnorm_bf16(c, Y, EVEN_LD, C_NQ, 16, MTOK, args.in[8], ropec, ropes);
                headnorm_bf16(c, Y, EVEN_LD, C_KS, 4, MTOK, args.in[10], ropec, ropes);
                headnorm_bf16(c, Y, EVEN_LD, C_KW, 4, MTOK, args.in[11], ropec, ropes);
                vt_pass(c, Y, EVEN_LD, C_MV, 16, VT, 24, 0, T, 0);
                vt_pass(c, Y, EVEN_LD, C_VS, 4, VT, 24, 16, T, 0);
                vt_pass(c, Y, EVEN_LD, C_VW, 4, VT, 24, 20, T, 0);
                cmp_raw(c, Y, args.in[12], args.in[13], args.in[14], args.in[15], KCR, VCR);
            } else {
                headnorm_bf16(c, Y, ODD_LD, C_DQ, 24, MTOK, args.in[18], ropec, ropes);
                headnorm_bf16(c, Y, ODD_LD, C_DK, 24, MTOK, args.in[19], ropec, ropes);
                vt_pass(c, Y, ODD_LD, C_SV, 24, VT, 48, 0, T, 0);
                vt_pass(c, Y, ODD_LD, C_DV, 24, VT, 48, 24, T, 1);
            }
        }
        SEAM(pb + 2);
        if constexpr (even) {
            if (IN(pb + 3)) REPS(pb + 3) { cmp_finish(c, KCR, VCR, KCN, VCN, args.in[9], ropec, ropes); moba_kmean(c, Y, kmean); }
            SEAM(pb + 3);
            if (IN(pb + 4)) REPS(pb + 4) {
#if FA_EVEN
                for (int idx = (int)blockIdx.x; idx < NB * 4 * 32; idx += c.G) { const int tt = 31 - (idx >> 4), bg = idx & 15, b = bg >> 2, g = bg & 3; const size_t r0 = (size_t)b * T + 64 * tt;
                    fa::cmp_unit(c, Y + r0 * EVEN_LD + C_NQ + 4 * g * 128, EVEN_LD, KCN + (size_t)bg * 128 * 128, VCN + (size_t)bg * 128 * 128, PART + r0 * 2048 + 4 * g * 128, SELN + (size_t)bg * T + 64 * tt, tt); }
#endif
            }
            SEAM(pb + 4);
        }
        if (IN(pb + 5)) REPS(pb + 5) {
            if constexpr (even && !FA_EVEN) {
                for (int it = c.gw; it < NB * 16 * T; it += c.ngw) { const int bh = it >> 11; moba_row(c, qs, Y, kmean, O, bh >> 4, bh & 15, spread_t(it)); }
                for (int it = c.gw; it < NB * 4 * T; it += c.ngw) { const int bg = it >> 11; nsa_item(c, qs, ps, Y, KCN, VCN, O, bg >> 2, bg & 3, spread_t(it)); }
            } else if constexpr (!even && !FA_ODD) {
                for (int it = c.gw; it < NB * 24 * T; it += c.ngw) { const int bh = it >> 11; sb_row(c, qs, Y, O, bh / 24, bh % 24, spread_t(it)); }
                for (int it = c.gw; it < NB * 8 * T; it += c.ngw) { const int bh = it >> 11; dil_row(c, qs, Y, O, bh >> 3, bh & 7, spread_t(it)); }
            } else if constexpr (even) {
                bf16* OS = PART + (size_t)MTOK * 2048; bf16* OW = PART + (size_t)2 * MTOK * 2048;
                for (int round = 0; round < 6 * 256 / c.G + 1; ++round) {
                    const int idx = snake(round, (int)blockIdx.x, c.G); if (idx >= 1536) continue;
                    fa::Unit u; u.kmean = nullptr; u.lse = nullptr; u.lse_stride = 0; u.causal = 1; u.nrows = 256; u.qstride = EVEN_LD; u.kstride = EVEN_LD; u.vts = T; u.sel_stride = 1; u.t_lo = 0; u.window = 1 << 30;
                    if (idx < 1024) {
                        const int qb = 7 - (idx >> 7), wi = idx & 127, which = wi >> 6, bh = wi & 63, b = bh >> 4, h = bh & 15, g = h >> 2;
                        const size_t r0 = (size_t)b * T + 256 * qb;
                        u.pos0 = 256 * qb; u.t_hi = 4 * qb + 4;
                        if (which == 0) { u.q = Y + r0 * EVEN_LD + C_MQ + h * 128; u.k = Y + (size_t)b * T * EVEN_LD + C_MK + h * 128; u.vt = VT + (size_t)(b * 24 + h) * 128 * T;
                            u.o = O + r0 * DM + h * 128; u.ostride = DM; u.sel = nullptr; u.kmean = kmean + (size_t)(b * 16 + h) * 8 * 128; u.sel_shift = 2; u.own_blk = qb; }
                        else { u.q = Y + r0 * EVEN_LD + C_NQ + h * 128; u.k = Y + (size_t)b * T * EVEN_LD + C_KS + g * 128; u.vt = VT + (size_t)(b * 24 + 16 + g) * 128 * T;
                            u.o = OS + r0 * 2048 + h * 128; u.ostride = 2048; u.sel = SELN + (size_t)(b * 4 + g) * T + 256 * qb; u.sel_shift = 0; u.own_blk = -1; }
                    } else {
                        const int j = idx - 1024, qb = j & 7, bh = j >> 3, b = bh >> 4, h = bh & 15, g = h >> 2; const size_t r0 = (size_t)b * T + 256 * qb;
                        u.pos0 = 256 * qb; u.t_hi = 4 * qb + 4; u.t_lo = qb >= 2 ? 4 * qb - 8 : 0; u.window = 512;
                        u.q = Y + r0 * EVEN_LD + C_NQ + h * 128; u.k = Y + (size_t)b * T * EVEN_LD + C_KW + g * 128; u.vt = VT + (size_t)(b * 24 + 20 + g) * 128 * T;
                        u.o = OW + r0 * 2048 + h * 128; u.ostride = 2048; u.sel = nullptr; u.sel_shift = 0; u.own_blk = -1;
                    }
                    fa::run_unit<0>(c, u);
                }
            } else {
                float* LSE = (float*)(ws + WS_LSE);
                if constexpr (!FA_SB) { for (int it = c.gw; it < NB * 24 * T; it += c.ngw) { const int bh = it >> 11; sb_row(c, qs, Y, O, bh / 24, bh % 24, spread_t(it)); } }
                if constexpr (!FA_DIL) { for (int it = c.gw; it < NB * 8 * T; it += c.ngw) { const int bh = it >> 11; dil_row(c, qs, Y, O, bh >> 3, bh & 7, spread_t(it)); } }
                for (int round = 0; round < 7 * 256 / c.G + 1; ++round) {
                    const int idx = snake(round, (int)blockIdx.x, c.G); if (idx >= 1792) continue;
                    if (!FA_SB && idx < 768) continue;
                    if (!FA_DIL && idx >= 768) continue;
                    fa::Unit u; u.kmean = nullptr; u.lse = nullptr; u.lse_stride = 0; u.causal = 1; u.nrows = 256; u.qstride = ODD_LD; u.kstride = ODD_LD; u.vts = T; u.sel = nullptr; u.sel_stride = 0; u.sel_shift = 0; u.own_blk = -1; u.t_lo = 0; u.window = 1 << 30;
                    if (idx < 768) {
                        const int qb = 7 - idx / 96, bh = idx % 96, b = bh / 24, h = bh % 24; const size_t r0 = (size_t)b * T + 256 * qb;
                        u.pos0 = 256 * qb; u.t_hi = 4 * qb + 4;
                        u.q = Y + r0 * ODD_LD + C_SQ + h * 128; u.k = Y + (size_t)b * T * ODD_LD + C_SK + h * 128; u.vt = VT + (size_t)(b * 48 + h) * 128 * T; u.o = O + r0 * DM + h * 128; u.ostride = DM;
                        fa::run_unit<1>(c, u);
                    } else {
                        int gi, r, b, hd, cls, un;
                        if (idx < 1024) { const int j = idx - 768; gi = 0; r = 1; un = j & 7; hd = (j >> 3) & 7; b = j >> 6; cls = 0; }
                        else if (idx < 1280) { const int j = idx - 1024; gi = 1; r = 4; un = j & 1; cls = (j >> 1) & 3; hd = (j >> 3) & 7; b = j >> 6; }
                        else { const int j = idx - 1280; gi = 2; r = 16; un = 0; cls = j & 15; hd = (j >> 4) & 7; b = j >> 7; }
                        const int nd = gi * 8 + hd, CL = T / r; const size_t tok0 = (size_t)b * T + cls + (size_t)r * 256 * un;
                        u.nrows = CL < 256 ? CL : 256; u.pos0 = 256 * un; u.t_lo = un > 0 ? 4 * un - 2 : 0; u.t_hi = (4 * un + 4) < CL / 64 ? (4 * un + 4) : CL / 64; u.window = 129;
                        u.qstride = r * ODD_LD; u.kstride = r * ODD_LD;
                        u.q = Y + tok0 * ODD_LD + C_DQ + nd * 128; u.k = Y + ((size_t)b * T + cls) * ODD_LD + C_DK + nd * 128; u.vt = VT + (size_t)(b * 48 + 24 + nd) * 128 * T + (size_t)cls * CL;
                        u.o = PART + (size_t)gi * MTOK * 1024 + tok0 * 1024 + hd * 128; u.ostride = r * 1024; u.lse = LSE + (size_t)gi * MTOK * 8 + tok0 * 8 + hd; u.lse_stride = r * 8;
                        fa::run_unit<0>(c, u);
                    }
                }
            }
        }
        SEAM(pb + 5);
        if (IN(pb + 6)) REPS(pb + 6) {
            if constexpr (even && FA_EVEN) nsa_combine(c, Y, PART, PART + (size_t)MTOK * 2048, PART + (size_t)2 * MTOK * 2048, O);
            if constexpr (!even && FA_ODD && FA_DIL) dil_combine(c, PART, (const float*)(ws + WS_LSE), O);
        }
        SEAM(pb + 6);
        if (IN(pb + 7)) REPS(pb + 7) {
            pg8::Gemm g{O, WOUT_T, MTOK, DM, DM}; pg8::StaticOrder S; S.init(MTOK, DM, c.G, (int)blockIdx.x);
            pg8::EpiResF32 E{xcur, X, DM};
            pg8::gemm_phase<pg8::EpiResF32, pg8::StaticOrder, true, true>(c.lds, g, S, E);
        }
        SEAM(pb + 7);
        if (IN(pb + 8)) REPS(pb + 8) rmsnorm_rows(c, X, args.in[20] + layer * DM, H, MTOK);
        SEAM(pb + 8);
        if (IN(pb + 9)) REPS(pb + 9) {
            { pg8::Gemm g{H, WQ_T, MTOK, XW, DM}; pg8::StaticOrder S; S.init(MTOK, XW, c.G, (int)blockIdx.x); pg8::EpiBf16P E{QX, XW};
              pg8::gemm_phase<pg8::EpiBf16P, pg8::StaticOrder, true, true>(c.lds, g, S, E); }
            { pg8::Gemm g{MEMN, WKV_T, MEM_ROWS, 2 * XW, DM}; pg8::StaticOrder S; S.init(MEM_ROWS, 2 * XW, c.G, (int)blockIdx.x); pg8::EpiBf16P E{KVX, 2 * XW};
              pg8::gemm_phase<pg8::EpiBf16P, pg8::StaticOrder, true, true>(c.lds, g, S, E); }
        }
        SEAM(pb + 9);
        if (IN(pb + 10)) REPS(pb + 10) {
            headnorm_bf16(c, QX, XW, 0, 4, MTOK, args.in[25] + layer * HD, nullptr, nullptr);
            headnorm_bf16(c, KVX, 2 * XW, 0, 4, MEM_ROWS, args.in[26] + layer * HD, nullptr, nullptr);
            vt_pass(c, KVX, 2 * XW, XW, 4, VTX, 4, 0, MEM_LEN, 0);
        }
        SEAM(pb + 10);
        if (IN(pb + 11)) REPS(pb + 11) {
            if constexpr (!FA_XATTN) { for (int it = c.gw; it < NB * 4 * T; it += c.ngw) { const int bh = it >> 11; xattn_row(c, qs, QX, KVX, OX, bh >> 2, bh & 3, it & (T - 1)); } }
            else for (int idx = (int)blockIdx.x; idx < 128; idx += c.G) {
                const int qb = idx & 7, bh = idx >> 3, b = bh >> 2, h = bh & 3; const size_t r0 = (size_t)b * T + 256 * qb;
                fa::Unit u; u.kmean = nullptr; u.lse = nullptr; u.lse_stride = 0; u.causal = 0; u.nrows = 256; u.qstride = XW; u.kstride = 2 * XW; u.vts = MEM_LEN; u.sel = nullptr; u.sel_stride = 0; u.sel_shift = 0; u.own_blk = -1;
                u.t_lo = 0; u.t_hi = 4; u.window = 1 << 30; u.pos0 = 0;
                u.q = QX + r0 * XW + h * 128; u.k = KVX + (size_t)b * MEM_LEN * 2 * XW + h * 128; u.vt = VTX + (size_t)(b * 4 + h) * 128 * MEM_LEN; u.o = OX + r0 * XW + h * 128; u.ostride = XW;
                fa::run_unit<0>(c, u);
            }
        }
        SEAM(pb + 11);
        if (IN(pb + 12)) REPS(pb + 12) {
            pg8::Gemm g{OX, WO_T, MTOK, DM, XW}; pg8::StaticOrder S; S.init(MTOK, DM, c.G, (int)blockIdx.x);
            pg8::EpiResF32 E{X, X, DM};
            pg8::gemm_phase<pg8::EpiResF32, pg8::StaticOrder, true, true>(c.lds, g, S, E);
        }
        SEAM(pb + 12);
        if (IN(pb + 13)) REPS(pb + 13) rmsnorm_rows(c, X, args.in[27] + layer * DM, H, MTOK);
        SEAM(pb + 13);
        if (IN(pb + 14)) REPS(pb + 14) {
            pg8::Gemm g{H, WGU_T, MTOK, GU_ROWS, DM}; pg8::StaticOrder S; S.init(MTOK, GU_ROWS, c.G, (int)blockIdx.x);
            pg8::EpiSwiGLU E{HID, FFN};
            pg8::gemm_phase<pg8::EpiSwiGLU, pg8::StaticOrder, true, true>(c.lds, g, S, E);
        }
        SEAM(pb + 14);
        if (IN(pb + 15)) REPS(pb + 15) {
            pg8::Gemm g{HID, WD_T, MTOK, DM, FFN}; pg8::StaticOrder S; S.init(MTOK, DM, c.G, (int)blockIdx.x);
            pg8::EpiResF32 E{X, layer == 1 ? args.out : X, DM};
            pg8::gemm_phase<pg8::EpiResF32, pg8::StaticOrder, true, true>(c.lds, g, S, E);
        }
        if constexpr (layer == 0) SEAM(pb + 15);
}
__global__ void __launch_bounds__(NWAVES * 64, 2) fwd(Args args) {
    extern __shared__ __attribute__((aligned(16))) unsigned char lds_raw[];
    Ctx c; c.lds = (LAS unsigned char*)lds_raw; c.tid = threadIdx.x; c.lane = c.tid & 63; c.wave = __builtin_amdgcn_readfirstlane(c.tid >> 6);
    c.G = gridDim.x; c.gw = blockIdx.x * NWAVES + c.wave; c.ngw = c.G * NWAVES;
    unsigned* ctl = (unsigned*)(args.ws + WS_CTL);
    for (int u = c.tid; u < (LDS_BYTES - LDSCTL_OFF) / 4; u += NWAVES * 64) ((LAS unsigned*)(c.lds + LDSCTL_OFF))[u] = 0u;
    __syncthreads();
#if MK_ONE_LAUNCH
    XcdBarrier bar = xcd_barrier_post(ctl + CW_BAR, (volatile LAS unsigned*)(c.lds + MISC_OFF + 32));
#else
    XcdBarrier bar; bar.bar = ctl + CW_BAR; bar.x = 0; bar.st = nullptr;
#endif
    const int lo = args.ph_lo, hi = args.ph_hi;
    run_layer<0>(args, c, bar, lo, hi);
    run_layer<1>(args, c, bar, lo, hi);
}
#undef IN
#undef SEAM

extern "C" void kernel_launch(void* const* d_in, const int* in_sizes, int n_in, void* d_out, int out_size, void* d_ws, size_t ws_size, hipStream_t stream) {
    static int grid = 0;
    if (grid == 0) {
        if (n_in != 31 || out_size != MTOK * DM || ws_size < WS_END) { fprintf(stderr, "kernel_launch: unexpected shapes (n_in %d, out %d, ws %zu)\n", n_in, out_size, ws_size); grid = -1; return; }
        int dev = 0, cus = 0;
        if (hipGetDevice(&dev) != hipSuccess || hipDeviceGetAttribute(&cus, hipDeviceAttributeMultiprocessorCount, dev) != hipSuccess) { grid = -1; return; }
        if (hipFuncSetAttribute((const void*)fwd, hipFuncAttributeMaxDynamicSharedMemorySize, LDS_BYTES) != hipSuccess) { fprintf(stderr, "kernel_launch: hipFuncSetAttribute failed\n"); grid = -1; return; }
        int per_cu = 0;
        if (hipOccupancyMaxActiveBlocksPerMultiprocessor(&per_cu, (const void*)fwd, NWAVES * 64, LDS_BYTES) != hipSuccess || per_cu < 1) fprintf(stderr, "kernel_launch: occupancy query reports %d\n", per_cu);
        (void)hipGetLastError();
        grid = cus;
    }
    if (grid < 0) return;
    (void)hipMemsetAsync((char*)d_ws + WS_CTL, 0, CTL_ZERO_BYTES, stream);
    Args a{};
    for (int i = 0; i < 31; ++i) a.in[i] = (const float*)d_in[i];
    a.out = (float*)d_out; a.ws = (unsigned char*)d_ws;
#if MK_ONE_LAUNCH
    a.ph_lo = 0; a.ph_hi = NPH;
    hipLaunchKernelGGL(fwd, dim3(grid), dim3(NWAVES * 64), LDS_BYTES, stream, a);
#else
    for (int ph = 0; ph < NPH; ++ph) {
        if (ph == 3 + NPL || ph == 4 + NPL) continue;
        a.ph_lo = ph; a.ph_hi = ph + 1;
        hipLaunchKernelGGL(fwd, dim3(grid), dim3(NWAVES * 64), LDS_BYTES, stream, a);
    }
#endif
}
```

```cpp
#define MK_ONE_LAUNCH 1
#define RES_BF16 1
#define FUSE_HEADNORM 1
#define EARLY_N1 16
#define EARLY_N2 16
#include <hip/hip_runtime.h>
#include <cstdio>
#include <cstdint>
namespace pg8 {
#define PG8_LAS __attribute__((address_space(3)))
typedef unsigned short bf16_t;
typedef short bf16x8 __attribute__((ext_vector_type(8)));
typedef float f32x4 __attribute__((ext_vector_type(4)));
typedef unsigned u32x4 __attribute__((ext_vector_type(4)));
constexpr int BM = 256, BK = 64, HALF = 128, HTB = HALF * BK * 2  , STAGE_BYTES = 8 * HTB, NXCD = 8, WGM = 8;

__host__ __device__ __forceinline__ int lds_byte(int r, int c) { const int st = (r >> 4) * 2 + (c >> 5), rr = r & 15, cc = c & 31, ob = rr * 64 + cc * 2; return st * 1024 + (ob ^ (((ob >> 9) & 1) << 5)); }
__host__ __device__ __forceinline__ void stage_rc(int b, int& R, int& C) { const int st = b / 1024, sb = b % 1024, swz = sb ^ (((sb >> 9) & 1) << 5); R = (st >> 1) * 16 + swz / 64; C = (st & 1) * 32 + (swz % 64) / 2; }
__host__ __device__ __forceinline__ int perm32(int rho) { const int n = rho >> 4, i = rho & 15; return 8 * (i >> 2) + 4 * n + (i & 3); }

struct Unit { int pm, pn, ks; };
struct Gemm { const bf16_t* A; const bf16_t* Bt; int M, N, K, KL; };

struct StaticOrder {
    int nM, nN, nwg, G, c;
    __host__ __device__ void init(int M, int N, int G_, int c_) { nM = M / BM; nN = N / BM; nwg = nM * nN; G = G_; c = c_; }
    __host__ __device__ bool next(int i, Unit& u) const {
        const long L = (long)i * G + c; if (L >= nwg) return false;
        int wgid = (int)L; { const int q = nwg / NXCD, r = nwg % NXCD, xcd = wgid % NXCD, off = wgid / NXCD; wgid = (xcd < r ? xcd * (q + 1) : r * (q + 1) + (xcd - r) * q) + off; }
        const int nig = WGM * nN, gid = wgid / nig, fm = gid * WGM, gsz = (nM - fm) < WGM ? (nM - fm) : WGM;
        u.pm = fm + ((wgid % nig) % gsz); u.pn = (wgid % nig) / gsz; u.ks = 0; return true;
    }
    __device__ __forceinline__ void a_ready(const Unit&) const {}
    __device__ __forceinline__ void done(const Unit&) const {}
};
struct SplitKOrder {
    int nN, nS, total, G, c;
    __host__ __device__ void init(int M, int N, int nS_, int G_, int c_) { nN = N / BM; nS = nS_; total = (M / BM) * nN * nS; G = G_; c = c_; }
    __host__ __device__ bool next(int i, Unit& u) const { const long L = (long)i * G + c; if (L >= total) return false; const int l = (int)L; u.ks = l % nS; const int r = l / nS; u.pn = r % nN; u.pm = r / nN; return true; }
    __device__ __forceinline__ void a_ready(const Unit&) const {}
    __device__ __forceinline__ void done(const Unit&) const {}
};
struct DiagOrder {
    int bm, bn, total, G, c;
    __host__ __device__ void init(int nblk, int bm_, int bn_, int G_, int c_) { bm = bm_; bn = bn_; total = nblk * bm * bn; G = G_; c = c_; }
    __host__ __device__ bool next(int i, Unit& u) const { const long L = (long)i * G + c; if (L >= total) return false; const int l = (int)L, blk = l / (bm * bn), r = l % (bm * bn); u.pm = blk * bm + r / bn; u.pn = blk * bn + r % bn; u.ks = 0; return true; }
    __device__ __forceinline__ void a_ready(const Unit&) const {}
    __device__ __forceinline__ void done(const Unit&) const {}
};

typedef float f32x2c_t __attribute__((ext_vector_type(2)));
typedef __bf16 bf16x2c_t __attribute__((ext_vector_type(2)));
__device__ __forceinline__ unsigned cvt_pk_bf16(float lo, float hi) { const f32x2c_t v = {lo, hi}; const bf16x2c_t b = __builtin_convertvector(v, bf16x2c_t); return __builtin_bit_cast(unsigned, b); }
typedef float f32x2 __attribute__((ext_vector_type(2)));
__device__ __forceinline__ float row_rstd(const float* ssq, int row) { return ssq ? 1.0f / sqrtf(ssq[row] * (1.0f / 4096.0f) + 1e-6f) : 1.0f; }
struct EpiBf16P {
    static constexpr bool PERM = true, AFTER_DRAIN = false;
    bf16_t* O; int ldc; const float* ssq;
    __device__ __forceinline__ void operator()(const f32x4 (&acc)[2][2][4][2], const Unit& u, int wr, int wc, int fr, int fq) const {
        const int row0 = u.pm * BM + wr * 64 + fr, col0 = u.pn * BM + wc * 32 + 8 * fq;
#pragma unroll
        for (int ai = 0; ai < 2; ++ai)
#pragma unroll
            for (int m = 0; m < 4; ++m) { bf16_t* rowp = O + (size_t)(row0 + ai * HALF + m * 16) * ldc + col0; const float rs = row_rstd(ssq, row0 + ai * HALF + m * 16);
#pragma unroll
                for (int bj = 0; bj < 2; ++bj) { const f32x4 v0 = acc[ai][bj][m][0] * rs, v1 = acc[ai][bj][m][1] * rs;
                    u32x4 w; w.x = cvt_pk_bf16(v0[0], v0[1]); w.y = cvt_pk_bf16(v0[2], v0[3]); w.z = cvt_pk_bf16(v1[0], v1[1]); w.w = cvt_pk_bf16(v1[2], v1[3]);
                    *(u32x4*)(rowp + bj * HALF) = w; } }
    }
};
struct EpiResF32 {
    static constexpr bool PERM = true, AFTER_DRAIN = false;
    const float* base; float* out; int ldc;
    __device__ __forceinline__ void operator()(const f32x4 (&acc)[2][2][4][2], const Unit& u, int wr, int wc, int fr, int fq) const {
        const int row0 = u.pm * BM + wr * 64 + fr, col0 = u.pn * BM + wc * 32 + 8 * fq;
#pragma unroll
        for (int ai = 0; ai < 2; ++ai)
#pragma unroll
            for (int m = 0; m < 4; ++m) { const size_t off = (size_t)(row0 + ai * HALF + m * 16) * ldc + col0;
#pragma unroll
                for (int bj = 0; bj < 2; ++bj) { const f32x4 b0 = *(const f32x4*)(base + off + bj * HALF), b1 = *(const f32x4*)(base + off + bj * HALF + 4);
                    *(f32x4*)(out + off + bj * HALF) = b0 + acc[ai][bj][m][0]; *(f32x4*)(out + off + bj * HALF + 4) = b1 + acc[ai][bj][m][1]; }
                asm volatile("" ::: "memory"); }
    }
};
__device__ __forceinline__ float silu_mul(float g, float u) { return g * __builtin_amdgcn_rcpf(1.0f + __builtin_amdgcn_exp2f(-1.4426950408889634f * g)) * u; }
struct EpiSwiGLU {
    static constexpr bool PERM = true, AFTER_DRAIN = false;
    bf16_t* O; int ldc; const float* ssq;
    __device__ __forceinline__ void operator()(const f32x4 (&acc)[2][2][4][2], const Unit& u, int wr, int wc, int fr, int fq) const {
        const int row0 = u.pm * BM + wr * 64 + fr, col0 = u.pn * HALF + wc * 32 + 8 * fq;
#pragma unroll
        for (int ai = 0; ai < 2; ++ai)
#pragma unroll
            for (int m = 0; m < 4; ++m) { bf16_t* rowp = O + (size_t)(row0 + ai * HALF + m * 16) * ldc + col0; const float rs = row_rstd(ssq, row0 + ai * HALF + m * 16);
                const f32x4 g0 = acc[ai][0][m][0] * rs, g1 = acc[ai][0][m][1] * rs, u0 = acc[ai][1][m][0] * rs, u1 = acc[ai][1][m][1] * rs;
                u32x4 w; w.x = cvt_pk_bf16(silu_mul(g0[0], u0[0]), silu_mul(g0[1], u0[1])); w.y = cvt_pk_bf16(silu_mul(g0[2], u0[2]), silu_mul(g0[3], u0[3]));
                w.z = cvt_pk_bf16(silu_mul(g1[0], u1[0]), silu_mul(g1[1], u1[1])); w.w = cvt_pk_bf16(silu_mul(g1[2], u1[2]), silu_mul(g1[3], u1[3]));
                *(u32x4*)rowp = w; }
    }
};
struct EpiF32Part {
    static constexpr bool PERM = false, AFTER_DRAIN = false;
    float* P; int ldc; size_t part_stride;
    __device__ __forceinline__ void operator()(const f32x4 (&acc)[2][2][4][2], const Unit& u, int wr, int wc, int fr, int fq) const {
        const int row0 = u.pm * BM + wr * 64 + fr, col0 = u.pn * BM + wc * 32 + 4 * fq; float* base = P + (size_t)u.ks * part_stride;
#pragma unroll
        for (int ai = 0; ai < 2; ++ai)
#pragma unroll
            for (int m = 0; m < 4; ++m) { const size_t off = (size_t)(row0 + ai * HALF + m * 16) * ldc + col0;
#pragma unroll
                for (int bj = 0; bj < 2; ++bj)
#pragma unroll
                    for (int n = 0; n < 2; ++n) *(f32x4*)(base + off + bj * HALF + n * 16) = acc[ai][bj][m][n]; }
    }
};
struct EpiResF32N {
    static constexpr bool PERM = true, AFTER_DRAIN = false;
    const float* base; float* out; int ldc; bf16_t* xb; float* ssq;
    __device__ __forceinline__ void operator()(const f32x4 (&acc)[2][2][4][2], const Unit& u, int wr, int wc, int fr, int fq) const {
        const int row0 = u.pm * BM + wr * 64 + fr, col0 = u.pn * BM + wc * 32 + 8 * fq;
#pragma unroll
        for (int ai = 0; ai < 2; ++ai)
#pragma unroll
            for (int m = 0; m < 4; ++m) { const int row = row0 + ai * HALF + m * 16; const size_t off = (size_t)row * ldc + col0; float sq = 0.f;
#pragma unroll
                for (int bj = 0; bj < 2; ++bj) {
                    const f32x4 v0 = *(const f32x4*)(base + off + bj * HALF) + acc[ai][bj][m][0], v1 = *(const f32x4*)(base + off + bj * HALF + 4) + acc[ai][bj][m][1];
                    *(f32x4*)(out + off + bj * HALF) = v0; *(f32x4*)(out + off + bj * HALF + 4) = v1;
                    sq += ((v0[0] * v0[0] + v0[1] * v0[1]) + (v0[2] * v0[2] + v0[3] * v0[3])) + ((v1[0] * v1[0] + v1[1] * v1[1]) + (v1[2] * v1[2] + v1[3] * v1[3]));
                    u32x4 w; w.x = cvt_pk_bf16(v0[0], v0[1]); w.y = cvt_pk_bf16(v0[2], v0[3]); w.z = cvt_pk_bf16(v1[0], v1[1]); w.w = cvt_pk_bf16(v1[2], v1[3]); *(u32x4*)(xb + off + bj * HALF) = w; }
                sq += __shfl_xor(sq, 16); sq += __shfl_xor(sq, 32);
                if (fq == 0) atomicAdd(ssq + row, sq);
                asm volatile("" ::: "memory"); }
    }
};
template <class TB> struct EpiResBf16N {
    static constexpr bool PERM = true, AFTER_DRAIN = false;
    const TB* base; int ldc; bf16_t* xb; float* ssq;
    __device__ __forceinline__ void operator()(const f32x4 (&acc)[2][2][4][2], const Unit& u, int wr, int wc, int fr, int fq) const {
        const int row0 = u.pm * BM + wr * 64 + fr, col0 = u.pn * BM + wc * 32 + 8 * fq;
#pragma unroll
        for (int ai = 0; ai < 2; ++ai)
#pragma unroll
            for (int m = 0; m < 4; ++m) { const int row = row0 + ai * HALF + m * 16; const size_t off = (size_t)row * ldc + col0; float sq = 0.f;
#pragma unroll
                for (int bj = 0; bj < 2; ++bj) { f32x4 v0, v1;
                    if constexpr (sizeof(TB) == 4) { v0 = *(const f32x4*)((const float*)base + off + bj * HALF); v1 = *(const f32x4*)((const float*)base + off + bj * HALF + 4); }
                    else { const u32x4 b = *(const u32x4*)((const bf16_t*)base + off + bj * HALF);
                        v0 = (f32x4){__builtin_bit_cast(float, b.x << 16), __builtin_bit_cast(float, b.x & 0xffff0000u), __builtin_bit_cast(float, b.y << 16), __builtin_bit_cast(float, b.y & 0xffff0000u)};
                        v1 = (f32x4){__builtin_bit_cast(float, b.z << 16), __builtin_bit_cast(float, b.z & 0xffff0000u), __builtin_bit_cast(float, b.w << 16), __builtin_bit_cast(float, b.w & 0xffff0000u)}; }
                    v0 += acc[ai][bj][m][0]; v1 += acc[ai][bj][m][1];
                    u32x4 w; w.x = cvt_pk_bf16(v0[0], v0[1]); w.y = cvt_pk_bf16(v0[2], v0[3]); w.z = cvt_pk_bf16(v1[0], v1[1]); w.w = cvt_pk_bf16(v1[2], v1[3]); *(u32x4*)(xb + off + bj * HALF) = w;
                    const float r0 = __builtin_bit_cast(float, w.x << 16), r1 = __builtin_bit_cast(float, w.x & 0xffff0000u), r2 = __builtin_bit_cast(float, w.y << 16), r3 = __builtin_bit_cast(float, w.y & 0xffff0000u);
                    const float r4 = __builtin_bit_cast(float, w.z << 16), r5 = __builtin_bit_cast(float, w.z & 0xffff0000u), r6 = __builtin_bit_cast(float, w.w << 16), r7 = __builtin_bit_cast(float, w.w & 0xffff0000u);
                    sq += ((r0 * r0 + r1 * r1) + (r2 * r2 + r3 * r3)) + ((r4 * r4 + r5 * r5) + (r6 * r6 + r7 * r7)); }
                sq += __shfl_xor(sq, 16); sq += __shfl_xor(sq, 32);
                if (fq == 0) atomicAdd(ssq + row, sq);
                asm volatile("" ::: "memory"); }
    }
};
struct EpiOutBf16Res {
    static constexpr bool PERM = true, AFTER_DRAIN = false;
    const bf16_t* base; float* out; int ldc;
    __device__ __forceinline__ void operator()(const f32x4 (&acc)[2][2][4][2], const Unit& u, int wr, int wc, int fr, int fq) const {
        const int row0 = u.pm * BM + wr * 64 + fr, col0 = u.pn * BM + wc * 32 + 8 * fq;
#pragma unroll
        for (int ai = 0; ai < 2; ++ai)
#pragma unroll
            for (int m = 0; m < 4; ++m) { const size_t off = (size_t)(row0 + ai * HALF + m * 16) * ldc + col0;
#pragma unroll
                for (int bj = 0; bj < 2; ++bj) { const u32x4 b = *(const u32x4*)(base + off + bj * HALF);
                    const f32x4 v0 = (f32x4){__builtin_bit_cast(float, b.x << 16), __builtin_bit_cast(float, b.x & 0xffff0000u), __builtin_bit_cast(float, b.y << 16), __builtin_bit_cast(float, b.y & 0xffff0000u)};
                    const f32x4 v1 = (f32x4){__builtin_bit_cast(float, b.z << 16), __builtin_bit_cast(float, b.z & 0xffff0000u), __builtin_bit_cast(float, b.w << 16), __builtin_bit_cast(float, b.w & 0xffff0000u)};
                    *(f32x4*)(out + off + bj * HALF) = v0 + acc[ai][bj][m][0]; *(f32x4*)(out + off + bj * HALF + 4) = v1 + acc[ai][bj][m][1]; }
                asm volatile("" ::: "memory"); }
    }
};
struct HeadSpec { int lo[5], hi[5]; const float* g[5]; };
struct EpiYHeads {
    static constexpr bool PERM = true, AFTER_DRAIN = false;
    bf16_t* O; int ldc; const float* ssq; HeadSpec hs; const float* ct; const float* st; PG8_LAS float* tab;
    __device__ __forceinline__ void operator()(const f32x4 (&acc)[2][2][4][2], const Unit& u, int wr, int wc, int fr, int fq) const {
        const float* gain = nullptr;
#pragma unroll
        for (int k = 0; k < 5; ++k) if (u.pn >= hs.lo[k] && u.pn < hs.hi[k]) gain = hs.g[k];
        const int row0 = u.pm * BM + wr * 64 + fr;
        if (gain == nullptr) {
            const int col0 = u.pn * BM + wc * 32 + 8 * fq;
#pragma unroll
            for (int ai = 0; ai < 2; ++ai)
#pragma unroll
                for (int m = 0; m < 4; ++m) { bf16_t* rowp = O + (size_t)(row0 + ai * HALF + m * 16) * ldc + col0; const float rs = row_rstd(ssq, row0 + ai * HALF + m * 16);
#pragma unroll
                    for (int bj = 0; bj < 2; ++bj) { const f32x4 v0 = acc[ai][bj][m][0] * rs, v1 = acc[ai][bj][m][1] * rs;
                        u32x4 w; w.x = cvt_pk_bf16(v0[0], v0[1]); w.y = cvt_pk_bf16(v0[2], v0[3]); w.z = cvt_pk_bf16(v1[0], v1[1]); w.w = cvt_pk_bf16(v1[2], v1[3]);
                        *(u32x4*)(rowp + bj * HALF) = w; } }
            return;
        }
        const int lr0 = wr * 64 + fr;
#pragma unroll
        for (int ai = 0; ai < 2; ++ai)
#pragma unroll
            for (int m = 0; m < 4; ++m) { const float rs = row_rstd(ssq, row0 + ai * HALF + m * 16); float sq = 0.f;
#pragma unroll
                for (int bj = 0; bj < 2; ++bj)
#pragma unroll
                    for (int n = 0; n < 2; ++n) { const f32x4 v = acc[ai][bj][m][n] * rs; sq += (v[0] * v[0] + v[1] * v[1]) + (v[2] * v[2] + v[3] * v[3]); }
                sq += __shfl_xor(sq, 16); sq += __shfl_xor(sq, 32);
                if (fq == 0) tab[(ai * HALF + lr0 + m * 16) * 4 + wc] = sq; }
        asm volatile("s_waitcnt lgkmcnt(0)" ::: "memory"); __builtin_amdgcn_s_barrier(); asm volatile("" ::: "memory");
        const int dlo = 32 * (wc & 1) + 8 * fq, head = wc >> 1;
        const f32x4 ga0 = *(const f32x4*)(gain + dlo), ga1 = *(const f32x4*)(gain + dlo + 4), gb0 = *(const f32x4*)(gain + 64 + dlo), gb1 = *(const f32x4*)(gain + 64 + dlo + 4);
#pragma unroll
        for (int ai = 0; ai < 2; ++ai)
#pragma unroll
            for (int m = 0; m < 4; ++m) { const int row = row0 + ai * HALF + m * 16;
                const float own = tab[(ai * HALF + lr0 + m * 16) * 4 + wc], other = tab[(ai * HALF + lr0 + m * 16) * 4 + (wc ^ 1)];
                const float sc = row_rstd(ssq, row) / sqrtf(((wc & 1) ? other + own : own + other) * (1.0f / 128.0f) + 1e-6f);
                const f32x4 c0 = *(const f32x4*)(ct + (size_t)row * 64 + dlo), c1 = *(const f32x4*)(ct + (size_t)row * 64 + dlo + 4), s0 = *(const f32x4*)(st + (size_t)row * 64 + dlo), s1 = *(const f32x4*)(st + (size_t)row * 64 + dlo + 4);
                const f32x4 a0 = acc[ai][0][m][0] * sc * ga0, a1 = acc[ai][0][m][1] * sc * ga1, b0 = acc[ai][1][m][0] * sc * gb0, b1 = acc[ai][1][m][1] * sc * gb1;
                const f32x4 y10 = a0 * c0 - b0 * s0, y11 = a1 * c1 - b1 * s1, y20 = a0 * s0 + b0 * c0, y21 = a1 * s1 + b1 * c1;
                bf16_t* rowp = O + (size_t)row * ldc + u.pn * BM + head * 128 + dlo;
                u32x4 w; w.x = cvt_pk_bf16(y10[0], y10[1]); w.y = cvt_pk_bf16(y10[2], y10[3]); w.z = cvt_pk_bf16(y11[0], y11[1]); w.w = cvt_pk_bf16(y11[2], y11[3]); *(u32x4*)rowp = w;
                u32x4 w2; w2.x = cvt_pk_bf16(y20[0], y20[1]); w2.y = cvt_pk_bf16(y20[2], y20[3]); w2.z = cvt_pk_bf16(y21[0], y21[1]); w2.w = cvt_pk_bf16(y21[2], y21[3]); *(u32x4*)(rowp + 64) = w2;
                asm volatile("" ::: "memory"); }
    }
};
template <class Epi, class Sched, bool ALIGN_EPI = false, bool SP2 = false>
__device__ __forceinline__ void gemm_phase(PG8_LAS unsigned char* lds, const Gemm g, const Sched& S, const Epi& E) {
    const int tid = threadIdx.x, wid = __builtin_amdgcn_readfirstlane(tid >> 6), lane = tid & 63, wr = wid >> 2, wc = wid & 3, fr = lane & 15, fq = lane >> 4;
    const int K = g.K, nt = g.KL / BK;
    unsigned voffA[2], voffB[2];
#pragma unroll
    for (int i = 0; i < 2; ++i) { int R, C; stage_rc(tid * 16 + i * 8192, R, C); const int Rb = Epi::PERM ? ((R & ~31) + perm32(R & 31)) : R;
        voffA[i] = (unsigned)(R * K + C) * 2u; voffB[i] = (unsigned)(Rb * K + C) * 2u; }
    const size_t kstep = (size_t)(BK * 2);
    const size_t hstep = (size_t)HALF * K * 2;
    const size_t tstep = 2 * hstep;
    const unsigned ldsw = (unsigned)wid * 1024u;
    const int aoff = lds_byte(wr * 64 + fr, fq * 8), boff = lds_byte(wc * 32 + fr, fq * 8);
#define PG8_SA(b, h) (((b) * 2 + (h)) * HTB)
#define PG8_SB(b, h) ((4 + (b) * 2 + (h)) * HTB)
#define PG8_STAGE(bufoff, gbase, voff) do { _Pragma("unroll") for (int _i = 0; _i < 2; ++_i) \
        __builtin_amdgcn_global_load_lds((const unsigned*)((const char*)(gbase) + (voff)[_i]), (PG8_LAS unsigned*)(lds + (bufoff) + ldsw + _i * 8192), 16, 0, 0); } while (0)
#define PG8_LDA(dst, b, h) do { _Pragma("unroll") for (int m = 0; m < 4; ++m) _Pragma("unroll") for (int k = 0; k < 2; ++k) dst[m][k] = *(const PG8_LAS bf16x8*)(lds + PG8_SA(b, h) + aoff + m * 2048 + k * 1024); } while (0)
#define PG8_LDB(dst, b, h) do { _Pragma("unroll") for (int n = 0; n < 2; ++n) _Pragma("unroll") for (int k = 0; k < 2; ++k) dst[n][k] = *(const PG8_LAS bf16x8*)(lds + PG8_SB(b, h) + boff + n * 2048 + k * 1024); } while (0)
#define PG8_MMA(ai, bj, At, Bt) do { __builtin_amdgcn_s_setprio(1); _Pragma("unroll") for (int m = 0; m < 4; ++m) _Pragma("unroll") for (int n = 0; n < 2; ++n) _Pragma("unroll") for (int k = 0; k < 2; ++k) \
        acc[ai][bj][m][n] = __builtin_amdgcn_mfma_f32_16x16x32_bf16(Bt[n][k], At[m][k], acc[ai][bj][m][n], 0, 0, 0); __builtin_amdgcn_s_setprio(0); } while (0)
#define PG8_WAIT_V(n) asm volatile("s_waitcnt vmcnt(" #n ")" ::: "memory")
#define PG8_WAIT_L(n) asm volatile("s_waitcnt lgkmcnt(" #n ")" ::: "memory")
#define PG8_BAR __builtin_amdgcn_s_barrier()
#define PG8_SCHED __builtin_amdgcn_sched_barrier(0)
    Unit cur, nxt; int ui = 0;
    if (!S.next(0, cur)) return;
    f32x4 acc[2][2][4][2];
#pragma unroll
    for (int a = 0; a < 2; ++a)
#pragma unroll
        for (int b = 0; b < 2; ++b)
#pragma unroll
            for (int m = 0; m < 4; ++m)
#pragma unroll
                for (int n = 0; n < 2; ++n) acc[a][b][m][n] = (f32x4){0.f, 0.f, 0.f, 0.f};
    bf16x8 At[4][2], B0[2][2], B1[2][2];
    const size_t ksb = (size_t)g.KL * 2;
    const char* cA = (const char*)g.A + (size_t)cur.pm * tstep + (size_t)cur.ks * ksb; const char* cB = (const char*)g.Bt + (size_t)cur.pn * tstep + (size_t)cur.ks * ksb;
    S.a_ready(cur);
    if constexpr (SP2) {
        PG8_STAGE(PG8_SB(0, 0), cB, voffB); PG8_STAGE(PG8_SB(0, 1), cB + hstep, voffB); PG8_STAGE(PG8_SA(0, 0), cA, voffA); PG8_STAGE(PG8_SA(0, 1), cA + hstep, voffA);
        if (wr == 1) PG8_BAR;
        PG8_WAIT_V(2); PG8_BAR;
        PG8_STAGE(PG8_SB(1, 0), cB + kstep, voffB); PG8_STAGE(PG8_SA(1, 0), cA + kstep, voffA); PG8_STAGE(PG8_SB(1, 1), cB + hstep + kstep, voffB);
        PG8_WAIT_V(6); PG8_BAR;
    } else {
        PG8_STAGE(PG8_SB(0, 0), cB, voffB); PG8_STAGE(PG8_SA(0, 0), cA, voffA); PG8_STAGE(PG8_SB(0, 1), cB + hstep, voffB); PG8_STAGE(PG8_SA(0, 1), cA + hstep, voffA);
        if (wr == 1) PG8_BAR;
        PG8_WAIT_V(4); PG8_BAR;
        PG8_STAGE(PG8_SB(1, 0), cB + kstep, voffB); PG8_STAGE(PG8_SA(1, 0), cA + kstep, voffA); PG8_STAGE(PG8_SB(1, 1), cB + hstep + kstep, voffB);
        PG8_WAIT_V(6); PG8_BAR;
    }
    for (;;) {
        const bool has_next = S.next(ui + 1, nxt);
        const char* nA = has_next ? (const char*)g.A + (size_t)nxt.pm * tstep + (size_t)nxt.ks * ksb : cA; const char* nB = has_next ? (const char*)g.Bt + (size_t)nxt.pn * tstep + (size_t)nxt.ks * ksb : cB;
        for (int t = 0; t < nt; t += 2) {
            const bool last = (t == nt - 2);
            const char* a1 = cA + (size_t)(t + 1) * kstep;
            const char* a2 = last ? nA : cA + (size_t)(t + 2) * kstep; const char* b2 = last ? nB : cB + (size_t)(t + 2) * kstep;
            const char* a3 = a2 + kstep; const char* b3 = b2 + kstep;
            if (last && has_next) S.a_ready(nxt);
            if constexpr (SP2) {
            PG8_LDB(B0, 0, 0); PG8_LDB(B1, 0, 1); PG8_SCHED; PG8_LDA(At, 0, 0); PG8_STAGE(PG8_SA(1, 1), a1 + hstep, voffA);
            PG8_WAIT_V(8); PG8_WAIT_L(0); PG8_BAR; PG8_MMA(0, 0, At, B0); PG8_MMA(0, 1, At, B1); PG8_BAR; PG8_SCHED;
            PG8_LDA(At, 0, 1); PG8_STAGE(PG8_SB(0, 0), b2, voffB); PG8_STAGE(PG8_SB(0, 1), b2 + hstep, voffB); PG8_STAGE(PG8_SA(0, 0), a2, voffA);
            PG8_WAIT_V(8); PG8_WAIT_L(0); PG8_BAR; PG8_MMA(1, 0, At, B0); PG8_MMA(1, 1, At, B1); PG8_BAR; PG8_SCHED;
            PG8_LDB(B0, 1, 0); PG8_LDB(B1, 1, 1); PG8_SCHED; PG8_LDA(At, 1, 0); PG8_STAGE(PG8_SA(0, 1), a2 + hstep, voffA);
            PG8_WAIT_V(8); PG8_WAIT_L(0); PG8_BAR; PG8_MMA(0, 0, At, B0); PG8_MMA(0, 1, At, B1); PG8_BAR; PG8_SCHED;
            PG8_LDA(At, 1, 1); PG8_STAGE(PG8_SB(1, 0), b3, voffB); PG8_STAGE(PG8_SB(1, 1), b3 + hstep, voffB); PG8_STAGE(PG8_SA(1, 0), a3, voffA);
            PG8_WAIT_V(8); PG8_WAIT_L(0); PG8_BAR; PG8_MMA(1, 0, At, B0); PG8_MMA(1, 1, At, B1); PG8_BAR; PG8_SCHED;
            } else {
            PG8_LDB(B0, 0, 0); PG8_SCHED; PG8_LDA(At, 0, 0); PG8_STAGE(PG8_SA(1, 1), a1 + hstep, voffA);
            PG8_WAIT_L(8); PG8_BAR; PG8_WAIT_L(0); PG8_MMA(0, 0, At, B0); PG8_BAR; PG8_SCHED;
            PG8_LDB(B1, 0, 1); PG8_STAGE(PG8_SB(0, 0), b2, voffB);
            PG8_BAR; PG8_WAIT_L(0); PG8_MMA(0, 1, At, B1); PG8_BAR;
            PG8_LDA(At, 0, 1); PG8_STAGE(PG8_SA(0, 0), a2, voffA);
            PG8_BAR; PG8_WAIT_L(0); PG8_MMA(1, 0, At, B0); PG8_BAR; PG8_SCHED;
            PG8_STAGE(PG8_SB(0, 1), b2 + hstep, voffB);
            PG8_WAIT_V(6); PG8_BAR; PG8_MMA(1, 1, At, B1); PG8_BAR;
            PG8_LDB(B0, 1, 0); PG8_SCHED; PG8_LDA(At, 1, 0); PG8_STAGE(PG8_SA(0, 1), a2 + hstep, voffA);
            PG8_WAIT_L(8); PG8_BAR; PG8_WAIT_L(0); PG8_MMA(0, 0, At, B0); PG8_BAR; PG8_SCHED;
            PG8_LDB(B1, 1, 1); PG8_STAGE(PG8_SB(1, 0), b3, voffB);
            PG8_BAR; PG8_WAIT_L(0); PG8_MMA(0, 1, At, B1); PG8_BAR;
            PG8_LDA(At, 1, 1); PG8_STAGE(PG8_SA(1, 0), a3, voffA);
            PG8_BAR; PG8_WAIT_L(0); PG8_MMA(1, 0, At, B0); PG8_BAR; PG8_SCHED;
            PG8_STAGE(PG8_SB(1, 1), b3 + hstep, voffB);
            PG8_WAIT_V(6); PG8_BAR; PG8_MMA(1, 1, At, B1); PG8_BAR;
            }
        }
        if constexpr (ALIGN_EPI) { if (wr == 0) PG8_BAR; }
        if constexpr (!Epi::AFTER_DRAIN) { E(acc, cur, wr, wc, fr, fq); S.done(cur); }
        if (!has_next) break;
#pragma unroll
        for (int a = 0; a < 2; ++a)
#pragma unroll
            for (int b = 0; b < 2; ++b)
#pragma unroll
                for (int m = 0; m < 4; ++m)
#pragma unroll
                    for (int n = 0; n < 2; ++n) acc[a][b][m][n] = (f32x4){0.f, 0.f, 0.f, 0.f};
        cur = nxt; cA = nA; cB = nB; ++ui;
        if constexpr (ALIGN_EPI) { if (wr == 1) PG8_BAR; }
    }
    PG8_WAIT_V(0);
    if constexpr (!ALIGN_EPI) { if (wr == 0) PG8_BAR; }
    PG8_BAR;
    if constexpr (Epi::AFTER_DRAIN) { E.fused(acc, cur, wr, wc, fr, fq, lds, wid, lane); S.done(cur); }
#undef PG8_SA
#undef PG8_SB
#undef PG8_STAGE
#undef PG8_LDA
#undef PG8_LDB
#undef PG8_MMA
#undef PG8_WAIT_V
#undef PG8_WAIT_L
#undef PG8_BAR
#undef PG8_SCHED
}
}
#define GAS __attribute__((address_space(1)))
#define LAS __attribute__((address_space(3)))
typedef unsigned short bf16;
typedef unsigned v4u __attribute__((ext_vector_type(4)));
typedef float f32x4 __attribute__((ext_vector_type(4)));
constexpr int NB = 4, T = 2048, DM = 4096, MTOK = NB * T, HD = 128;
constexpr int EVEN_N = 11312, EVEN_LD = 11520, ODD_LD = 18432, FFN = 11008, GU_ROWS = 2 * FFN;
constexpr int MEM_LEN = 256, MEM_ROWS = NB * MEM_LEN, XW = 512;
constexpr float NORM_EPS = 1e-6f;
constexpr float ATT_SCALE = 0.08838834764831845f;
#define NEG_INF (-__builtin_inff())
constexpr int C_MQ = 0, C_MK = 2048, C_MV = 4096, C_NQ = 6144, C_KC = 8192, C_VC = 8704, C_KS = 9216, C_VS = 9728, C_KW = 10240, C_VW = 10752, C_GL = 11264;
constexpr int C_SQ = 0, C_SK = 3072, C_SV = 6144, C_DQ = 9216, C_DK = 12288, C_DV = 15360;
constexpr size_t MiB = 1u << 20;
constexpr size_t WS_CTL = 0, CTL_ZERO_BYTES = 256 * 1024;
constexpr size_t WS_ROPE = 1 * MiB;
constexpr size_t WS_KMEAN = 5 * MiB;
constexpr size_t WS_KCR = 6 * MiB, WS_VCR = 7 * MiB;
constexpr size_t WS_KCN = 8 * MiB, WS_VCN = 9 * MiB;
constexpr size_t WS_MEMN = 10 * MiB;
constexpr size_t WS_QX = 18 * MiB;
constexpr size_t WS_KVX = 26 * MiB;
constexpr size_t WS_OX = 28 * MiB;
constexpr size_t WS_WQ = 36 * MiB, WS_WKV = 40 * MiB, WS_WO = 48 * MiB, WS_WOUT = 52 * MiB, WS_WIN = 84 * MiB, WS_WGU = 228 * MiB, WS_WD = 400 * MiB;
constexpr size_t WS_X = 486 * MiB;
constexpr size_t WS_H = 614 * MiB;
constexpr size_t WS_O = 678 * MiB;
constexpr size_t WS_Y = 742 * MiB;
constexpr size_t WS_VT = 1030 * MiB;
constexpr size_t WS_PART = 1126 * MiB;
constexpr size_t WS_LSE = 1222 * MiB;
constexpr size_t WS_VTX = 1223 * MiB;
constexpr size_t WS_SELM = 5 * MiB + 256 * 1024, WS_SELN = 5 * MiB + 768 * 1024;
constexpr size_t WS_PHIK = 1224 * MiB, WS_PHIV = 1225 * MiB;
constexpr size_t WS_CBIAS = 5 * MiB + 896 * 1024;
constexpr size_t WS_QP = 1226 * MiB;
constexpr size_t WS_MEMN2 = 1290 * MiB;
constexpr size_t WS_KVX2 = 1306 * MiB;
constexpr size_t WS_WKV2 = 1314 * MiB;
constexpr size_t WS_WD1 = 1330 * MiB;
constexpr size_t WS_WIN1 = 1416 * MiB;
constexpr size_t WS_END = 1560 * MiB;
#ifndef EARLY_N1
#define EARLY_N1 20
#endif
#ifndef EARLY_N2
#define EARLY_N2 20
#endif
#ifndef EARLY_NT
#define EARLY_NT 1
#endif
constexpr int CW_BAR = 4096;
constexpr int CW_TICKET = 8256;
constexpr int CW_SSQ = 16384;
constexpr int RING_BYTES = 131072, LDSCTL_OFF = RING_BYTES, MISC_OFF = LDSCTL_OFF + 320, LDS_BYTES = 147456;
constexpr int NWAVES = 8;
#ifndef MK_ONE_LAUNCH
#define MK_ONE_LAUNCH 0
#endif
constexpr int NPL = 16, NPH = 2 * NPL;
#ifndef DUP_PHASE
#define DUP_PHASE (-1)
#endif
#ifndef DUP_N
#define DUP_N 2
#endif
#define REPS(k) for (int rep_ = 0; rep_ < ((DUP_PHASE == (k)) ? DUP_N : 1); ++rep_)
#ifndef PROBE_MASK
#define PROBE_MASK 0ull
#endif
#ifndef PROBE_SCALE
#define PROBE_SCALE 1e-3f
#endif
#ifndef PROBE_OFF
#define PROBE_OFF 0.f
#endif
#ifndef FUSE_HEADNORM
#define FUSE_HEADNORM 0
#endif
#ifndef RES_BF16
#define RES_BF16 0
#endif
#ifndef FA_EVEN
#define FA_EVEN 1
#endif
#ifndef FA_ODD
#define FA_ODD 1
#endif
#ifndef FA_SB
#define FA_SB 1
#endif
#ifndef FA_DIL
#define FA_DIL 1
#endif
#ifndef FA_XATTN
#define FA_XATTN 1
#endif

__device__ __forceinline__ unsigned f2bf(float f) { unsigned u = __builtin_bit_cast(unsigned, f); return (u + 0x7fffu + ((u >> 16) & 1u)) >> 16; }
__device__ __forceinline__ unsigned pk2(float lo, float hi) { return f2bf(lo) | (f2bf(hi) << 16); }
__device__ __forceinline__ float bflo(unsigned w) { return __builtin_bit_cast(float, w << 16); }
__device__ __forceinline__ float bfhi(unsigned w) { return __builtin_bit_cast(float, w & 0xffff0000u); }
__device__ __forceinline__ float bf2f(bf16 b) { return __builtin_bit_cast(float, ((unsigned)b) << 16); }
__device__ __forceinline__ float wsum(float v) {
#pragma unroll
    for (int o = 1; o < 64; o <<= 1) v += __shfl_xor(v, o);
    return v; }
__device__ __forceinline__ float wmax(float v) {
#pragma unroll
    for (int o = 1; o < 64; o <<= 1) v = fmaxf(v, __shfl_xor(v, o));
    return v; }
__device__ __forceinline__ float rdlane(float v, int j) { return __builtin_bit_cast(float, __builtin_amdgcn_readlane(__builtin_bit_cast(int, v), j)); }
#define LDS_FENCE() do { asm volatile("s_waitcnt lgkmcnt(0)" ::: "memory"); __builtin_amdgcn_wave_barrier(); } while (0)

#define XB_TMO      128
#define XB_XCNT(j)  (256  + 64 * (j))
#define XB_XSUB(j)  (1280 + 64 * (j))
#define XB_XGEN(j)  (2304 + 64 * (j))
#define XB_TOP      3328
#define XB_TOPGEN   3392
#define XCD_BAR_WORDS 3456
#define XB_SPIN_CAP (1u << 18)

__device__ __forceinline__ unsigned xb_ld(unsigned* p)              { return __hip_atomic_load(p, __ATOMIC_RELAXED, __HIP_MEMORY_SCOPE_AGENT); }
__device__ __forceinline__ unsigned xb_add(unsigned* p, unsigned v) { return __hip_atomic_fetch_add(p, v, __ATOMIC_RELAXED, __HIP_MEMORY_SCOPE_AGENT); }
__device__ __forceinline__ unsigned xb_xcc_id() { return (unsigned)__builtin_amdgcn_s_getreg((3 << 11) | 20) & 0xFu; }
#define XB_SPIN(cond, bar) do { unsigned _sp = 0; while (cond) { __builtin_amdgcn_s_sleep(1); \
    if ((++_sp & 255u) == 0u) { if (xb_ld(&(bar)[XB_TMO])) break; if (_sp > XB_SPIN_CAP) { atomicAdd(&(bar)[XB_TMO], 1u); break; } } } } while (0)

struct XcdBarrier {
    unsigned* bar; unsigned x;
    volatile LAS unsigned* st;
};

__device__ __forceinline__ XcdBarrier xcd_barrier_post(unsigned* bar, volatile LAS unsigned* st) {
    XcdBarrier b; b.bar = bar; b.x = xb_xcc_id(); b.st = st;
    if (threadIdx.x == 0) (void)xb_add(&bar[XB_XCNT(b.x)], 1u);
    return b;
}
__device__ __forceinline__ void xcd_barrier_complete(unsigned* bar, unsigned x, unsigned& nloc, unsigned& nx) {
    const unsigned G = gridDim.x * gridDim.y * gridDim.z;
    unsigned sum, cnt, mine, sp = 0u;
    for (;;) {
        sum = 0u; cnt = 0u; mine = 0u;
#pragma unroll
        for (unsigned j = 0; j < 16; ++j) { const unsigned c = xb_ld(&bar[XB_XCNT(j)]); sum += c; cnt += (c > 0u) ? 1u : 0u; mine = (j == x) ? c : mine; }
        if (sum == G) break;
        __builtin_amdgcn_s_sleep(1);
        if ((++sp & 255u) == 0u) { if (xb_ld(&bar[XB_TMO])) break; if (sp > XB_SPIN_CAP) { atomicAdd(&bar[XB_TMO], 1u); break; } }
    }
    nloc = mine > 0u ? mine : 1u; nx = cnt > 0u ? cnt : 1u;
}

__device__ __forceinline__ void xcd_barrier(const XcdBarrier& b) {
    asm volatile("s_waitcnt vmcnt(0)" ::: "memory");
    __syncthreads();
    if (threadIdx.x == 0) {
        unsigned* bar = b.bar;
        __builtin_amdgcn_s_waitcnt(0);
        unsigned nloc = b.st[0], nx = b.st[1];
        if (nloc == 0u) { xcd_barrier_complete(bar, b.x, nloc, nx); b.st[0] = nloc; b.st[1] = nx; }
        const unsigned old = xb_add(&bar[XB_XSUB(b.x)], 1u);
        const unsigned gen = old / nloc;
        if (old + 1u == (gen + 1u) * nloc) {
            __builtin_amdgcn_fence(__ATOMIC_RELEASE, "agent");
            asm volatile("s_waitcnt vmcnt(0)" ::: "memory");
            const unsigned og = xb_add(&bar[XB_TOP], 1u);
            const unsigned tg = og / nx;
            if (og + 1u == (tg + 1u) * nx) xb_add(&bar[XB_TOPGEN], 1u);
            else XB_SPIN(xb_ld(&bar[XB_TOPGEN]) == tg, bar);
            __builtin_amdgcn_fence(__ATOMIC_ACQUIRE, "agent");
            xb_add(&bar[XB_XGEN(b.x)], 1u);
            asm volatile("s_waitcnt vmcnt(0)" ::: "memory");
        } else {
            XB_SPIN(xb_ld(&bar[XB_XGEN(b.x)]) == gen, bar);
            __builtin_amdgcn_fence(__ATOMIC_ACQUIRE, "agent");
            asm volatile("s_waitcnt vmcnt(0)" ::: "memory");
        }
    }
    __syncthreads();
}


struct Ctx { LAS unsigned char* lds; int tid, lane, wave, gw, ngw, G; };

struct RmId { int off; __device__ __forceinline__ int operator()(int n) const { return off + n; } };
struct RmHeads { unsigned long long m0, m1;
    __device__ __forceinline__ int operator()(int n) const { const int t = n >> 8; const bool hd = t < 64 ? ((m0 >> t) & 1ull) : ((m1 >> (t - 64)) & 1ull); if (!hd) return n;
        const int r = n & 255, hb = r >> 7, d = r & 127; return (n & ~255) + ((d >> 6) << 7) + hb * 64 + (d & 63); } };
struct RmGU { int up; __device__ __forceinline__ int operator()(int n) const { return (n >> 7) * 256 + up * 128 + (n & 127); } };
template <class RM, bool NT = false>
__device__ __forceinline__ void conv_weight(const Ctx& c, const float* W, int K, int N, int Npad, bf16* WT, RM rm, const float* kgain = nullptr, int it0 = 0, int it1 = -1, int gw = -1, int ngw = -1, unsigned* ticket = nullptr) {
    LAS float* scr = (LAS float*)(c.lds + c.wave * 16384);
    const int nblk = Npad / 32, items = it1 < 0 ? (K / 64) * nblk : it1, lane = c.lane; if (gw < 0) { gw = c.gw; ngw = c.ngw; }
    constexpr int CW_BATCH = 8;
    unsigned nxt = 0u; int bb = 0, bj = CW_BATCH;
    if (ticket) { unsigned t_ = 0u; if (lane == 0) t_ = xb_add(ticket, (unsigned)CW_BATCH); nxt = (unsigned)__builtin_amdgcn_readfirstlane((int)t_); }
    for (int it = it0 + gw; ; it += ngw) {
        if (ticket) {
            if (bj == CW_BATCH) { bb = it0 + (int)nxt; if (bb >= items) break; unsigned t_ = 0u; if (lane == 0) t_ = xb_add(ticket, (unsigned)CW_BATCH); nxt = (unsigned)__builtin_amdgcn_readfirstlane((int)t_); bj = 0; }
            it = bb + bj; ++bj; if (it >= items) break;
        } else if (it >= items) break;
        const int kb = it / nblk, nb = it - kb * nblk, k0 = 64 * kb, n0 = 32 * nb;
        const int c4 = lane & 7; const bool ok = n0 + 4 * c4 < N;
        f32x4 wv[8];
#pragma unroll
        for (int i = 0; i < 8; ++i) { const int kk = 8 * i + (lane >> 3); wv[i] = ok ? (NT ? __builtin_nontemporal_load((const f32x4*)(W + (size_t)(k0 + kk) * N + n0 + 4 * c4)) : *(const f32x4*)(W + (size_t)(k0 + kk) * N + n0 + 4 * c4)) : (f32x4){0.f, 0.f, 0.f, 0.f}; }
#pragma unroll
        for (int i = 0; i < 8; ++i) { const int kk = 8 * i + (lane >> 3); const float kg = kgain ? kgain[k0 + kk] : 1.0f; LAS float* d = scr + kk * 33 + 4 * c4; d[0] = wv[i].x * kg; d[1] = wv[i].y * kg; d[2] = wv[i].z * kg; d[3] = wv[i].w * kg; }
        LDS_FENCE();
        const int ch = lane & 7, r0 = rm(n0);
#pragma unroll
        for (int j = 0; j < 4; ++j) { const int nn = (lane >> 3) + 8 * j; const LAS float* s = scr + (8 * ch) * 33 + nn;
            v4u o; o.x = pk2(s[0 * 33], s[1 * 33]); o.y = pk2(s[2 * 33], s[3 * 33]); o.z = pk2(s[4 * 33], s[5 * 33]); o.w = pk2(s[6 * 33], s[7 * 33]);
            *(v4u*)(WT + (size_t)(r0 + nn) * K + k0 + 8 * ch) = o; }
        LDS_FENCE();
    }
}
__device__ __forceinline__ void rmsnorm_rows(const Ctx& c, const float* X, const float* g, bf16* Hout, int nrows) {
    const int lane = c.lane;
    for (int m = c.gw; m < nrows; m += c.ngw) {
        const f32x4* xr = (const f32x4*)(X + (size_t)m * DM) + lane; f32x4 v[16]; float ss = 0.f;
#pragma unroll
        for (int j = 0; j < 16; ++j) { v[j] = xr[64 * j]; ss += (v[j].x * v[j].x + v[j].y * v[j].y) + (v[j].z * v[j].z + v[j].w * v[j].w); }
        const float rstd = 1.0f / sqrtf(wsum(ss) * (1.0f / DM) + NORM_EPS);
        const f32x4* gr = (const f32x4*)g + lane; unsigned long long* o8 = (unsigned long long*)(Hout + (size_t)m * DM) + lane;
#pragma unroll
        for (int j = 0; j < 16; ++j) { const f32x4 gg = gr[64 * j]; o8[64 * j] = (unsigned long long)pk2(v[j].x * rstd * gg.x, v[j].y * rstd * gg.y) | ((unsigned long long)pk2(v[j].z * rstd * gg.z, v[j].w * rstd * gg.w) << 32); }
    }
}
__device__ __forceinline__ void rope_table(const Ctx& c, const int* pos, float* ct, float* st) {
    for (int idx = c.gw * 64 + c.lane; idx < MTOK * 64; idx += c.ngw * 64) {
        const int row = idx >> 6, i = idx & 63;
        const float invf = exp2f(-(float)i * 0.20762050593046f);
        const float ang = (float)pos[row] * invf;
        double rev = (double)ang * 0.15915494309189535; rev -= floor(rev);
        const float r = (float)rev;
        ct[idx] = __builtin_amdgcn_cosf(r); st[idx] = __builtin_amdgcn_sinf(r);
    }
}
__device__ __forceinline__ void headnorm_one(float (&x)[8], int j, int row, const f32x4 ga, const f32x4 gb, const float* ct, const float* st) {
    float ss = 0.f;
#pragma unroll
    for (int e = 0; e < 8; ++e) ss += x[e] * x[e];
    ss += __shfl_xor(ss, 1); ss += __shfl_xor(ss, 2); ss += __shfl_xor(ss, 4); ss += __shfl_xor(ss, 8);
    const float rstd = 1.0f / sqrtf(ss * (1.0f / 128.0f) + NORM_EPS);
    x[0] *= rstd * ga.x; x[1] *= rstd * ga.y; x[2] *= rstd * ga.z; x[3] *= rstd * ga.w; x[4] *= rstd * gb.x; x[5] *= rstd * gb.y; x[6] *= rstd * gb.z; x[7] *= rstd * gb.w;
    if (ct) {
        const f32x4 ca = *(const f32x4*)(ct + (size_t)row * 64 + 8 * (j & 7)), cb = *(const f32x4*)(ct + (size_t)row * 64 + 8 * (j & 7) + 4);
        const f32x4 sa = *(const f32x4*)(st + (size_t)row * 64 + 8 * (j & 7)), sb = *(const f32x4*)(st + (size_t)row * 64 + 8 * (j & 7) + 4);
        const float cs[8] = {ca.x, ca.y, ca.z, ca.w, cb.x, cb.y, cb.z, cb.w}, sn[8] = {sa.x, sa.y, sa.z, sa.w, sb.x, sb.y, sb.z, sb.w};
#pragma unroll
        for (int e = 0; e < 8; ++e) { const float pr = __shfl_xor(x[e], 8); x[e] = (j < 8) ? (x[e] * cs[e] - pr * sn[e]) : (pr * sn[e] + x[e] * cs[e]); }
    }
}
__device__ __forceinline__ void headnorm_bf16(const Ctx& c, bf16* Y, int ld, int col0, int nh, int nrows, const float* gain, const float* ct, const float* st) {
    const int lane = c.lane, sub = lane >> 4, j = lane & 15; const int items = nrows * nh, stride = 4 * c.ngw;
    const f32x4 ga = *(const f32x4*)(gain + 8 * j), gb = *(const f32x4*)(gain + 8 * j + 4);
    for (int it = 4 * c.gw + sub; it < items; it += 2 * stride) {
        const int it2 = it + stride; const bool two = it2 < items;
        const int row = it / nh, hh = it - row * nh, row2 = two ? it2 / nh : row, hh2 = two ? it2 - row2 * nh : hh;
        bf16* p = Y + (size_t)row * ld + col0 + hh * 128 + 8 * j; bf16* p2 = Y + (size_t)row2 * ld + col0 + hh2 * 128 + 8 * j;
        const v4u w = *(const v4u*)p; const v4u w2 = *(const v4u*)p2;
        float x[8] = {bflo(w.x), bfhi(w.x), bflo(w.y), bfhi(w.y), bflo(w.z), bfhi(w.z), bflo(w.w), bfhi(w.w)};
        float y[8] = {bflo(w2.x), bfhi(w2.x), bflo(w2.y), bfhi(w2.y), bflo(w2.z), bfhi(w2.z), bflo(w2.w), bfhi(w2.w)};
        headnorm_one(x, j, row, ga, gb, ct, st); headnorm_one(y, j, row2, ga, gb, ct, st);
        v4u o; o.x = pk2(x[0], x[1]); o.y = pk2(x[2], x[3]); o.z = pk2(x[4], x[5]); o.w = pk2(x[6], x[7]); *(v4u*)p = o;
        if (two) { v4u o2; o2.x = pk2(y[0], y[1]); o2.y = pk2(y[2], y[3]); o2.z = pk2(y[4], y[5]); o2.w = pk2(y[6], y[7]); *(v4u*)p2 = o2; }
    }
}
__device__ __forceinline__ void headnorm_q4(const Ctx& c, const float* QP, bf16* QX, const float* gain, const float* ssq) {
    const int lane = c.lane, sub = lane >> 4, j = lane & 15;
    const f32x4 ga = *(const f32x4*)(gain + 8 * j), gb = *(const f32x4*)(gain + 8 * j + 4);
    for (int it = 4 * c.gw + sub; it < MTOK * 4; it += 4 * c.ngw) {
        const size_t off = (size_t)(it >> 2) * XW + (it & 3) * 128 + 8 * j;
        f32x4 a = *(const f32x4*)(QP + off), b = *(const f32x4*)(QP + off + 4);
#pragma unroll
        for (int ks = 1; ks < 4; ++ks) { a += *(const f32x4*)(QP + (size_t)ks * MTOK * XW + off); b += *(const f32x4*)(QP + (size_t)ks * MTOK * XW + off + 4); }
        { const float rs = 1.0f / sqrtf(ssq[it >> 2] * (1.0f / DM) + NORM_EPS); a *= rs; b *= rs; }
        float ss = (a.x * a.x + a.y * a.y) + (a.z * a.z + a.w * a.w) + (b.x * b.x + b.y * b.y) + (b.z * b.z + b.w * b.w);
        ss += __shfl_xor(ss, 1); ss += __shfl_xor(ss, 2); ss += __shfl_xor(ss, 4); ss += __shfl_xor(ss, 8);
        const float rstd = 1.0f / sqrtf(ss * (1.0f / 128.0f) + NORM_EPS);
        v4u o; o.x = pk2(a.x * rstd * ga.x, a.y * rstd * ga.y); o.y = pk2(a.z * rstd * ga.z, a.w * rstd * ga.w); o.z = pk2(b.x * rstd * gb.x, b.y * rstd * gb.y); o.w = pk2(b.z * rstd * gb.z, b.w * rstd * gb.w);
        *(v4u*)(QX + off) = o;
    }
}
__device__ __forceinline__ void cmp_finish(const Ctx& c, const float* KCR, const float* VCR, const float* cbias, bf16* KCN, bf16* VCT, const float* gain, const float* ct, const float* st) {
    constexpr size_t PS = 16 * 128 * 128;
    const int lane = c.lane; const float g1 = gain[lane], g2 = gain[lane + 64];
    for (int it = c.gw; it < 2 * 16 * 128; it += c.ngw) {
        const int which = it >> 11, r = it & 2047, bg = r >> 7, n = r & 127, b = bg >> 2;
        const size_t o = ((size_t)bg * 128 + n) * 128;
        if (which == 0) {
            if (n == 127) { KCN[o + lane] = 0; KCN[o + lane + 64] = 0; continue; }
            float x1 = ((KCR[o + lane] + KCR[PS + o + lane]) + (KCR[2 * PS + o + lane] + KCR[3 * PS + o + lane])) + cbias[lane], x2 = ((KCR[o + lane + 64] + KCR[PS + o + lane + 64]) + (KCR[2 * PS + o + lane + 64] + KCR[3 * PS + o + lane + 64])) + cbias[lane + 64];
            const float rstd = 1.0f / sqrtf(wsum(x1 * x1 + x2 * x2) * (1.0f / 128.0f) + NORM_EPS);
            x1 = x1 * rstd * g1; x2 = x2 * rstd * g2;
            const int row = b * T + 16 * n + 31; const float cs = ct[row * 64 + lane], sn = st[row * 64 + lane];
            KCN[o + lane] = (bf16)f2bf(x1 * cs - x2 * sn); KCN[o + lane + 64] = (bf16)f2bf(x1 * sn + x2 * cs);
        } else {
            const float v1 = n == 127 ? 0.f : ((VCR[o + lane] + VCR[PS + o + lane]) + (VCR[2 * PS + o + lane] + VCR[3 * PS + o + lane])) + cbias[128 + lane], v2 = n == 127 ? 0.f : ((VCR[o + lane + 64] + VCR[PS + o + lane + 64]) + (VCR[2 * PS + o + lane + 64] + VCR[3 * PS + o + lane + 64])) + cbias[128 + lane + 64];
            VCT[o + lane] = (bf16)f2bf(v1); VCT[o + lane + 64] = (bf16)f2bf(v2);
        }
    }
}
__device__ __forceinline__ void moba_kmean(const Ctx& c, const bf16* Y, float* kmean) {
    const int lane = c.lane;
    for (int it = c.gw; it < NB * 16 * 8; it += c.ngw) {
        const int b = it >> 7, h = (it >> 3) & 15, n = it & 7;
        const bf16* src = Y + ((size_t)b * T + 256 * n) * EVEN_LD + C_MK + h * 128 + 2 * lane;
        float a0 = 0.f, a1 = 0.f;
        for (int k = 0; k < 256; ++k) { const unsigned w = *(const unsigned*)(src + (size_t)k * EVEN_LD); a0 += bflo(w); a1 += bfhi(w); }
        float* dst = kmean + (size_t)it * 128 + 2 * lane; dst[0] = a0 * (1.0f / 256.0f); dst[1] = a1 * (1.0f / 256.0f);
    }
}

__device__ __forceinline__ float dot128(const LAS float* qs, const bf16* krow) {
    const v4u* kp = (const v4u*)krow; float s = 0.f;
#pragma unroll 4
    for (int cch = 0; cch < 16; ++cch) { const v4u w = kp[cch]; const LAS f32x4* q4 = (const LAS f32x4*)(qs + 8 * cch); const f32x4 qa = q4[0], qb = q4[1];
        s += qa.x * bflo(w.x) + qa.y * bfhi(w.x) + qa.z * bflo(w.y) + qa.w * bfhi(w.y) + qb.x * bflo(w.z) + qb.y * bfhi(w.z) + qb.z * bflo(w.w) + qb.w * bfhi(w.w); }
    return s;
}
__device__ __forceinline__ void load_q(LAS float* qs, const bf16* qrow, int lane) {
    LDS_FENCE();
    const unsigned w = *(const unsigned*)(qrow + 2 * lane); qs[2 * lane] = bflo(w); qs[2 * lane + 1] = bfhi(w);
    LDS_FENCE();
}
__device__ __forceinline__ void pv_accum(float& a0, float& a1, float p, int voff, const bf16* Vb, int lane) {
    for (int j = 0; j < 64; ++j) {
        const float pj = rdlane(p, j);
        if (pj != 0.f) { const int off = __builtin_amdgcn_readlane(voff, j); const unsigned w = *(const unsigned*)(Vb + (size_t)off + 2 * lane); a0 += pj * bflo(w); a1 += pj * bfhi(w); }
    }
}
struct SoftAcc { float m, l, a0, a1; };
__device__ __forceinline__ void sa_init(SoftAcc& S) { S.m = NEG_INF; S.l = 0.f; S.a0 = 0.f; S.a1 = 0.f; }
__device__ __forceinline__ void sa_chunk(SoftAcc& S, float s  , int voff, const bf16* Vb, int lane) {
    const float cm = wmax(s);
    if (cm == NEG_INF) return;
    const float mn = fmaxf(S.m, cm);
    const float p = __expf(s - mn), alpha = __expf(S.m - mn);
    S.l = S.l * alpha + wsum(p); S.a0 *= alpha; S.a1 *= alpha; S.m = mn;
    pv_accum(S.a0, S.a1, p, voff, Vb, lane);
}
__device__ __forceinline__ void moba_row(const Ctx& c, LAS float* qs, const bf16* Y, const float* kmean, bf16* O, int b, int h, int t) {
    const int lane = c.lane; const size_t row = (size_t)b * T + t; const bf16* Yb = Y + (size_t)b * T * EVEN_LD;
    load_q(qs, Y + row * EVEN_LD + C_MQ + h * 128, lane);
    const int cur = t >> 8;
    float gate = NEG_INF;
    if (lane < cur) { const float* km = kmean + ((size_t)(b * 16 + h) * 8 + lane) * 128; float s = 0.f; for (int d = 0; d < 128; ++d) s += qs[d] * km[d]; gate = s; }
    int rank = 0;
    for (int m2 = 0; m2 < 8; ++m2) { const float gm = rdlane(gate, m2); rank += (gm > gate || (gm == gate && m2 < lane)) ? 1 : 0; }
    const unsigned selmask = (unsigned)__ballot((lane < cur) && (rank < 3));
    SoftAcc S; sa_init(S);
    const bf16* Kb = Yb + C_MK + h * 128; const bf16* Vb = Yb + C_MV + h * 128;
    const int nch = (t >> 6) + 1;
    for (int kc = 0; kc < nch; ++kc) {
        const int n = kc >> 2;
        if (n < cur && !((selmask >> n) & 1u)) continue;
        const int key = kc * 64 + lane; const bool valid = key <= t; const int koff = (valid ? key : t) * EVEN_LD;
        float s = dot128(qs, Kb + koff) * ATT_SCALE; if (!valid) s = NEG_INF;
        sa_chunk(S, s, koff, Vb, lane);
    }
    const float inv = 1.0f / fmaxf(S.l, 1e-30f);
    *(unsigned*)(O + row * DM + h * 128 + 2 * lane) = pk2(S.a0 * inv, S.a1 * inv);
}
__device__ __forceinline__ void nsa_item(const Ctx& c, LAS float* qs, LAS float* ps, const bf16* Y, const bf16* KCN, const bf16* VCN, bf16* O, int b, int g, int t) {
    const int lane = c.lane; const size_t row = (size_t)b * T + t; const bf16* Yb = Y + (size_t)b * T * EVEN_LD;
    const bf16* Kc = KCN + (size_t)(b * 4 + g) * 128 * 128; const bf16* Vc = VCN + (size_t)(b * 4 + g) * 128 * 128;
    float oc0[4], oc1[4]; float P0 = 0.f, P1 = 0.f;
    const int n0 = lane, n1 = 64 + lane; const bool v0 = 16 * n0 + 31 <= t, v1 = (n1 < 127) && (16 * n1 + 31 <= t);
#pragma unroll
    for (int hh = 0; hh < 4; ++hh) {
        load_q(qs, Y + row * EVEN_LD + C_NQ + (g * 4 + hh) * 128, lane);
        float s0 = dot128(qs, Kc + (v0 ? n0 : 0) * 128) * ATT_SCALE, s1 = dot128(qs, Kc + (v1 ? n1 : 0) * 128) * ATT_SCALE;
        if (!v0) s0 = NEG_INF; if (!v1) s1 = NEG_INF;
        const float m = wmax(fmaxf(s0, s1)); float a0 = 0.f, a1 = 0.f;
        if (m != NEG_INF) {
            float p0 = __expf(s0 - m), p1 = __expf(s1 - m);
            const float inv = 1.0f / fmaxf(wsum(p0 + p1), 1e-30f);
            p0 *= inv; p1 *= inv; P0 += p0; P1 += p1;
            pv_accum(a0, a1, p0, n0 * 128, Vc, lane); pv_accum(a0, a1, p1, (v1 ? n1 : 0) * 128, Vc, lane);
        }
        oc0[hh] = a0; oc1[hh] = a1;
    }
    LDS_FENCE(); ps[lane] = P0; ps[64 + lane] = P1; LDS_FENCE();
    float imp = 0.f;
    if (lane < 32) { for (int n = 4 * lane - 1; n <= 4 * lane + 3; ++n) if (n >= 0 && n < 127) imp += ps[n]; }
    const int cur = t >> 6;
    const float v = (lane >= 32) ? NEG_INF : ((lane == cur || lane == 0) ? __builtin_inff() : (lane <= cur ? imp : NEG_INF));
    int rank = 0;
    for (int m2 = 0; m2 < 32; ++m2) { const float vm = rdlane(v, m2); rank += (vm > v || (vm == v && m2 < lane)) ? 1 : 0; }
    const unsigned selmask = (unsigned)__ballot(lane < 32 && lane <= cur && rank < 16);
    const bf16* Ks = Yb + C_KS + g * 128; const bf16* Vs = Yb + C_VS + g * 128; const bf16* Kw = Yb + C_KW + g * 128; const bf16* Vw = Yb + C_VW + g * 128;
#pragma unroll
    for (int hh = 0; hh < 4; ++hh) {
        const int h = g * 4 + hh;
        load_q(qs, Y + row * EVEN_LD + C_NQ + h * 128, lane);
        SoftAcc S; sa_init(S);
        for (int j = 0; j <= cur; ++j) {
            if (!((selmask >> j) & 1u)) continue;
            const int key = 64 * j + lane; const bool valid = key <= t; const int koff = (valid ? key : t) * EVEN_LD;
            float s = dot128(qs, Ks + koff) * ATT_SCALE; if (!valid) s = NEG_INF;
            sa_chunk(S, s, koff, Vs, lane);
        }
        SoftAcc W; sa_init(W);
        for (int c0 = 0; c0 < 512 && c0 <= t; c0 += 64) {
            const int key = t - c0 - lane; const bool valid = key >= 0; const int koff = (valid ? key : 0) * EVEN_LD;
            float s = dot128(qs, Kw + koff) * ATT_SCALE; if (!valid) s = NEG_INF;
            sa_chunk(W, s, koff, Vw, lane);
        }
        const bf16* gl = Y + row * EVEN_LD + C_GL + h * 3;
        const float g0 = 1.0f / (1.0f + __expf(-bf2f(gl[0]))), g1 = 1.0f / (1.0f + __expf(-bf2f(gl[1]))), g2 = 1.0f / (1.0f + __expf(-bf2f(gl[2])));
        const float is = 1.0f / fmaxf(S.l, 1e-30f), iw = 1.0f / fmaxf(W.l, 1e-30f);
        const float o0 = g0 * oc0[hh] + g1 * (S.a0 * is) + g2 * (W.a0 * iw), o1 = g0 * oc1[hh] + g1 * (S.a1 * is) + g2 * (W.a1 * iw);
        *(unsigned*)(O + row * DM + 2048 + h * 128 + 2 * lane) = pk2(o0, o1);
    }
}
__device__ __forceinline__ void sb_row(const Ctx& c, LAS float* qs, const bf16* Y, bf16* O, int b, int h, int t) {
    const int lane = c.lane; const size_t row = (size_t)b * T + t; const bf16* Yb = Y + (size_t)b * T * ODD_LD;
    load_q(qs, Y + row * ODD_LD + C_SQ + h * 128, lane);
    const bf16* Kb = Yb + C_SK + h * 128; const bf16* Vb = Yb + C_SV + h * 128;
    float carry = 0.f, a0 = 0.f, a1 = 0.f;
    for (int c0 = 0; c0 < t; c0 += 64) {
        const int key = t - 1 - c0 - lane; const bool valid = key >= 0; const int koff = (valid ? key : 0) * ODD_LD;
        const float z = dot128(qs, Kb + koff) * ATT_SCALE;
        const float L = __logf(1.0f + __expf(-fabsf(z)));
        const float lsp = fminf(z, 0.f) - L;
        const float lr = valid ? (lsp - z) : 0.f;
        float incl = lr;
#pragma unroll
        for (int o = 1; o < 64; o <<= 1) { const float u = __shfl_up(incl, o); if (lane >= o) incl += u; }
        const float a = valid ? __expf(lsp + carry + (incl - lr)) : 0.f;
        carry += rdlane(incl, 63);
        pv_accum(a0, a1, a, koff, Vb, lane);
    }
    *(unsigned*)(O + row * DM + h * 128 + 2 * lane) = pk2(a0, a1);
}
__device__ __forceinline__ void dil_row(const Ctx& c, LAS float* qs, const bf16* Y, bf16* O, int b, int hd, int t) {
    const int lane = c.lane; const size_t row = (size_t)b * T + t; const bf16* Yb = Y + (size_t)b * T * ODD_LD;
    float og0[3], og1[3], lse[3];
#pragma unroll
    for (int gi = 0; gi < 3; ++gi) {
        const int r = gi == 0 ? 1 : (gi == 1 ? 4 : 16), nd = gi * 8 + hd;
        load_q(qs, Y + row * ODD_LD + C_DQ + nd * 128, lane);
        const bf16* Kb = Yb + C_DK + nd * 128; const bf16* Vb = Yb + C_DV + nd * 128;
        SoftAcc S; sa_init(S);
        for (int c0 = 0; c0 < 129; c0 += 64) {
            const int ci = c0 + lane, key = t - r * ci; const bool valid = (ci <= 128) && key >= 0; const int koff = (valid ? key : 0) * ODD_LD;
            float s = dot128(qs, Kb + koff) * ATT_SCALE; if (!valid) s = NEG_INF;
            sa_chunk(S, s, koff, Vb, lane);
        }
        const float inv = 1.0f / fmaxf(S.l, 1e-30f);
        og0[gi] = S.a0 * inv; og1[gi] = S.a1 * inv; lse[gi] = S.m + __logf(fmaxf(S.l, 1e-30f));
    }
    const float mx = fmaxf(lse[0], fmaxf(lse[1], lse[2]));
    const float w0 = __expf(lse[0] - mx), w1 = __expf(lse[1] - mx), w2 = __expf(lse[2] - mx), iw = 1.0f / (w0 + w1 + w2);
    *(unsigned*)(O + row * DM + 3072 + hd * 128 + 2 * lane) = pk2((w0 * og0[0] + w1 * og0[1] + w2 * og0[2]) * iw, (w0 * og1[0] + w1 * og1[1] + w2 * og1[2]) * iw);
}
__device__ __forceinline__ void xattn_row(const Ctx& c, LAS float* qs, const bf16* QX, const bf16* KVX, bf16* OX, int b, int h, int t) {
    const int lane = c.lane; const size_t row = (size_t)b * T + t;
    load_q(qs, QX + row * XW + h * 128, lane);
    const bf16* Kb = KVX + (size_t)b * MEM_LEN * 1024 + h * 128; const bf16* Vb = Kb + 512;
    SoftAcc S; sa_init(S);
    for (int c0 = 0; c0 < MEM_LEN; c0 += 64) { const int koff = (c0 + lane) * 1024; const float s = dot128(qs, Kb + koff) * ATT_SCALE; sa_chunk(S, s, koff, Vb, lane); }
    const float inv = 1.0f / fmaxf(S.l, 1e-30f);
    *(unsigned*)(OX + row * XW + h * 128 + 2 * lane) = pk2(S.a0 * inv, S.a1 * inv);
}
__device__ __forceinline__ int spread_t(int i) { return ((i & (T - 1)) + (i >> 11) * 997) & (T - 1); }


namespace fa {
typedef short bf16x8 __attribute__((ext_vector_type(8)));
typedef short s16x4 __attribute__((ext_vector_type(4)));
typedef float f32x16 __attribute__((ext_vector_type(16)));
typedef unsigned u32x2 __attribute__((ext_vector_type(2)));
constexpr int KT_BYTES = 64 * 256, VT_BYTES = 64 * 256, STAGE = KT_BYTES + VT_BYTES;
constexpr float C2 = 0.08838834764831845f * 1.4426950408889634f;
struct Unit {
    const bf16* q; int qstride;
    const bf16* k; int kstride;
    const bf16* v; int vstride;
    bf16* o; int ostride;
    float* lse; int lse_stride;
    const unsigned* sel; int sel_stride;
    int pos0, t_lo, t_hi;
    int window, causal;
    int sel_shift, own_blk, nrows;
    const bf16* comb_oc; const bf16* comb_os; const bf16* comb_gl; int comb_gls;
    const float* qp; const float* qgain; const float* qssq;
    size_t qps;
    const float* kmean;
};
__device__ __forceinline__ unsigned cvtpk(float lo, float hi) { return pg8::cvt_pk_bf16(lo, hi); }
__device__ __forceinline__ float xmax32(float v) { return fmaxf(v, __shfl_xor(v, 32)); }
__device__ __forceinline__ float xsum32(float v) { return v + __shfl_xor(v, 32); }
__device__ __forceinline__ float xother32(float v, int) { return __shfl_xor(v, 32); }
__device__ __forceinline__ bf16x8 pack8(const f32x16& p, const int b) { v4u w = {cvtpk(p[b + 0], p[b + 1]), cvtpk(p[b + 2], p[b + 3]), cvtpk(p[b + 4], p[b + 5]), cvtpk(p[b + 6], p[b + 7])}; return __builtin_bit_cast(bf16x8, w); }

#define FA_LOAD(tile) do { const int kb_ = (tile) * 64; const bf16* kp_ = u.k + (size_t)(kb_ + sr) * u.kstride + sc * 8; kq0 = *(const v4u*)kp_; kq1 = *(const v4u*)(kp_ + (size_t)32 * u.kstride); \
        const bf16* vp_ = u.v + (size_t)(kb_ + sr) * u.vstride + sc * 8; vq0 = *(const v4u*)vp_; vq1 = *(const v4u*)(vp_ + (size_t)32 * u.vstride); } while (0)
#define FA_WRITE(st) do { LAS unsigned char* b_ = L + (st) * STAGE; *(LAS v4u*)(b_ + kw0) = kq0; *(LAS v4u*)(b_ + kw0 + 32 * 256) = kq1; \
        *(LAS v4u*)(b_ + vw0) = vq0; *(LAS v4u*)(b_ + vw0 + 32 * 256) = vq1; } while (0)
#define FA_SB0() __builtin_amdgcn_sched_barrier(0)
#define FA_QK(st) do { const LAS unsigned char* kl_ = L + (st) * STAGE; p0 = f32x16{}; p1 = f32x16{}; \
        _Pragma("unroll") for (int h_ = 0; h_ < 2; ++h_) { bf16x8 ka_[4], kb_[4]; \
            _Pragma("unroll") for (int d1 = 0; d1 < 4; ++d1) { const int cb_ = ((4 * h_ + d1) * 32 + hi * 16) ^ ((r32 & 15) << 4); ka_[d1] = *(const LAS bf16x8*)(kl_ + r32 * 256 + cb_); kb_[d1] = *(const LAS bf16x8*)(kl_ + (32 + r32) * 256 + cb_); } \
            FA_SB0(); \
            _Pragma("unroll") for (int d1 = 0; d1 < 4; ++d1) { p0 = __builtin_amdgcn_mfma_f32_32x32x16_bf16(ka_[d1], q[4 * h_ + d1], p0, 0, 0, 0); p1 = __builtin_amdgcn_mfma_f32_32x32x16_bf16(kb_[d1], q[4 * h_ + d1], p1, 0, 0, 0); } \
            FA_SB0(); } } while (0)
#define FA_TRRD(dst, addr, off) asm volatile("ds_read_b64_tr_b16 %0, %1 offset:%2" : "=&v"(dst) : "v"(addr), "i"(off) : "memory")
#define FA_PV(st) do { const int so_ = (st) * STAGE; \
        _Pragma("unroll") for (int db = 0; db < 4; ++db) { const int a0_ = vtr[2 * db] + so_, a1_ = vtr[2 * db + 1] + so_; s16x4 l0_, h0_, l1_, h1_, l2_, h2_, l3_, h3_; \
            FA_TRRD(l0_, a0_, 0); FA_TRRD(h0_, a1_, 0); FA_TRRD(l1_, a0_, 4096); FA_TRRD(h1_, a1_, 4096); FA_TRRD(l2_, a0_, 8192); FA_TRRD(h2_, a1_, 8192); FA_TRRD(l3_, a0_, 12288); FA_TRRD(h3_, a1_, 12288); \
            asm volatile("s_waitcnt lgkmcnt(0)" ::: "memory"); FA_SB0(); \
            o[db] = __builtin_amdgcn_mfma_f32_32x32x16_bf16((bf16x8){l0_[0], l0_[1], l0_[2], l0_[3], h0_[0], h0_[1], h0_[2], h0_[3]}, P[0], o[db], 0, 0, 0); \
            o[db] = __builtin_amdgcn_mfma_f32_32x32x16_bf16((bf16x8){l1_[0], l1_[1], l1_[2], l1_[3], h1_[0], h1_[1], h1_[2], h1_[3]}, P[1], o[db], 0, 0, 0); \
            o[db] = __builtin_amdgcn_mfma_f32_32x32x16_bf16((bf16x8){l2_[0], l2_[1], l2_[2], l2_[3], h2_[0], h2_[1], h2_[2], h2_[3]}, P[2], o[db], 0, 0, 0); \
            o[db] = __builtin_amdgcn_mfma_f32_32x32x16_bf16((bf16x8){l3_[0], l3_[1], l3_[2], l3_[3], h3_[0], h3_[1], h3_[2], h3_[3]}, P[3], o[db], 0, 0, 0); \
            FA_SB0(); } } while (0)
#define FA_VTR_SETUP() int vtr[8]; { const int q_ = (lane & 15) >> 2, p_ = lane & 3, ch_ = (lane >> 4) & 1; const int lb_ = (int)(unsigned)(size_t)L; \
        _Pragma("unroll") for (int db = 0; db < 4; ++db) { _Pragma("unroll") for (int s_ = 0; s_ < 2; ++s_) { const int row_ = 8 * s_ + 4 * hi + q_, chunk_ = 4 * db + 2 * ch_ + (p_ >> 1); \
            vtr[2 * db + s_] = lb_ + KT_BYTES + 256 * row_ + 16 * (chunk_ ^ (((row_ & 3) << 2) | ((row_ >> 2) & 3))) + 8 * (p_ & 1); } } }

template <int MODE>
__device__ __forceinline__ void run_unit(const Ctx& c, const Unit& u) {
    const int tid = c.tid, lane = c.lane, w = c.wave, r32 = lane & 31, hi = lane >> 5;
    LAS unsigned char* L = c.lds;
    const int row = 32 * w + r32; const bool wact = 32 * w < u.nrows;
    bf16x8 q[8];
    if (MODE == 0 && u.qp) {
        const float* bp = u.qp + (size_t)row * 512 + hi * 8; f32x4 va[8], vb[8]; float ss = 0.f;
        const float rsx = 1.0f / sqrtf(u.qssq[row] * (1.0f / 4096.0f) + 1e-6f);
#pragma unroll
        for (int d0 = 0; d0 < 8; ++d0) { f32x4 a = *(const f32x4*)(bp + 16 * d0), b = *(const f32x4*)(bp + 16 * d0 + 4);
#pragma unroll
            for (int ks = 1; ks < 4; ++ks) { a += *(const f32x4*)(bp + ks * u.qps + 16 * d0); b += *(const f32x4*)(bp + ks * u.qps + 16 * d0 + 4); }
            a *= rsx; b *= rsx; va[d0] = a; vb[d0] = b; ss += ((a.x * a.x + a.y * a.y) + (a.z * a.z + a.w * a.w)) + ((b.x * b.x + b.y * b.y) + (b.z * b.z + b.w * b.w)); }
        ss = xsum32(ss);
        const float rstd = 1.0f / sqrtf(ss * (1.0f / 128.0f) + 1e-6f);
#pragma unroll
        for (int d0 = 0; d0 < 8; ++d0) { const f32x4 ga = *(const f32x4*)(u.qgain + 16 * d0 + hi * 8), gb = *(const f32x4*)(u.qgain + 16 * d0 + hi * 8 + 4); const f32x4 a = va[d0] * rstd * ga, b = vb[d0] * rstd * gb;
            v4u wq; wq.x = cvtpk(a.x, a.y); wq.y = cvtpk(a.z, a.w); wq.z = cvtpk(b.x, b.y); wq.w = cvtpk(b.z, b.w); q[d0] = __builtin_bit_cast(bf16x8, wq); }
    } else { const bf16* qp = u.q + (size_t)(wact ? row : 0) * u.qstride + hi * 8;
#pragma unroll
      for (int d0 = 0; d0 < 8; ++d0) q[d0] = *(const bf16x8*)(qp + 16 * d0); }
    const int pq = u.pos0 + row, wlo = u.pos0 + 32 * w, whi = wlo + 31;
    unsigned selm = 0xffffffffu; if (u.sel && wact) selm = u.sel[(size_t)row * u.sel_stride];
    const int sr = tid >> 4, sc = tid & 15, vr = tid >> 3, vc = tid & 7;
    const int kw0 = sr * 256 + ((sc * 16) ^ ((sr & 15) << 4)), vw0 = KT_BYTES + 256 * sr + 16 * (sc ^ (((sr & 3) << 2) | ((sr >> 2) & 3)));
    FA_VTR_SETUP();
    v4u kq0, kq1, vq0, vq1;
    f32x16 o[4] = {f32x16{}, f32x16{}, f32x16{}, f32x16{}}; f32x16 p0, p1; bf16x8 P[4];
    float m_run = -1e30f, l_run = 0.f, carry = 0.f;
    const int nt = u.t_hi - u.t_lo;
    __syncthreads();
    if (nt > 0) { FA_LOAD(MODE == 0 ? u.t_lo : u.t_hi - 1); FA_WRITE(0); }
    if (MODE == 0 && u.kmean) {
        const int grow = tid >> 5, gd4 = (tid & 31) * 4, gn = grow & 7; const f32x4 km = *(const f32x4*)(u.kmean + gn * 128 + gd4);
        unsigned h0 = f2bf(km.x), h1 = f2bf(km.y), h2 = f2bf(km.z), h3 = f2bf(km.w);
        if (grow >> 3) { h0 = f2bf(km.x - bflo(h0)); h1 = f2bf(km.y - bflo(h1)); h2 = f2bf(km.z - bflo(h2)); h3 = f2bf(km.w - bflo(h3)); }
        *(LAS u32x2*)(L + STAGE + grow * 256 + ((gd4 * 2) ^ ((grow & 15) << 4))) = (u32x2){h0 | (h1 << 16), h2 | (h3 << 16)};
    }
    __syncthreads();
    if (MODE == 0 && u.kmean) {
        FA_QK(1);
        float gown[4], g8[8];
#pragma unroll
        for (int e = 0; e < 4; ++e) gown[e] = p0[e] + p0[4 + e];
#pragma unroll
        for (int e = 0; e < 4; ++e) { const float go = xother32(gown[e], hi); g8[e] = hi ? go : gown[e]; g8[4 + e] = hi ? gown[e] : go; }
#pragma unroll
        for (int n = 0; n < 8; ++n) if (n >= u.own_blk) g8[n] = NEG_INF;
        selm = 0u;
#pragma unroll
        for (int n = 0; n < 8; ++n) { int rank = 0;
#pragma unroll
            for (int m2 = 0; m2 < 8; ++m2) rank += (g8[m2] > g8[n] || (g8[m2] == g8[n] && m2 < n)) ? 1 : 0;
            if (rank < 3 && n < u.own_blk) selm |= 1u << n; }
        __syncthreads();
    }
    for (int i = 0; i < nt; ++i) {
        const int tile = MODE == 0 ? u.t_lo + i : u.t_hi - 1 - i, st = i & 1, kb = tile * 64;
        if (i + 1 < nt) FA_LOAD(MODE == 0 ? tile + 1 : tile - 1);
        if (MODE == 0) {
            bool act = wact;
            if (u.causal && (kb > whi || kb + 63 <= wlo - u.window)) act = false;
            bool allowed = true;
            if (u.sel || u.kmean) { const int blk = tile >> u.sel_shift; allowed = (blk == u.own_blk) || ((selm >> blk) & 1u); if (!__any(allowed)) act = false; }
            if (act) {
                FA_QK(st);
                if (u.causal && (kb + 63 > wlo || kb <= whi - u.window)) {
                    const int dq = pq - kb - 4 * hi;
#pragma unroll
                    for (int r = 0; r < 16; ++r) { const int cc = (r & 3) + 8 * (r >> 2);
                        if ((unsigned)(dq - cc) >= (unsigned)u.window) p0[r] = NEG_INF;
                        if ((unsigned)(dq - cc - 32) >= (unsigned)u.window) p1[r] = NEG_INF; }
                }
                if (!allowed) {
#pragma unroll
                    for (int r = 0; r < 16; ++r) { p0[r] = NEG_INF; p1[r] = NEG_INF; } }
                float pm = fmaxf(p0[0], p1[0]);
#pragma unroll
                for (int r = 1; r < 16; ++r) pm = fmaxf(pm, fmaxf(p0[r], p1[r]));
                pm = xmax32(pm);
                if (__any((pm - m_run) * C2 > 11.5f)) {
                    const float mn = fmaxf(m_run, pm), alpha = __builtin_amdgcn_exp2f((m_run - mn) * C2); m_run = mn; l_run *= alpha;
#pragma unroll
                    for (int db = 0; db < 4; ++db)
#pragma unroll
                        for (int r = 0; r < 16; ++r) o[db][r] *= alpha; }
                const float mb = m_run * C2;
                float ps = 0.f;
#pragma unroll
                for (int r = 0; r < 16; ++r) { p0[r] = __builtin_amdgcn_exp2f(p0[r] * C2 - mb); p1[r] = __builtin_amdgcn_exp2f(p1[r] * C2 - mb); ps += p0[r] + p1[r]; }
                l_run += ps;
                P[0] = pack8(p0, 0); P[1] = pack8(p0, 8); P[2] = pack8(p1, 0); P[3] = pack8(p1, 8);
                FA_PV(st);
            }
        } else {
            if (wact && kb < whi && __any(carry > -110.0f)) {
                FA_QK(st);
                const int dq = pq - kb - 4 * hi;
                float own[8];
#define FA_SBG(PP, g, koff) do { float lr_[4], ls_[4]; \
                    _Pragma("unroll") for (int e = 0; e < 4; ++e) { const int cc = e + 8 * (g) + (koff); const float z = PP[4 * (g) + e] * ATT_SCALE; const float lg = __logf(1.0f + __expf(-fabsf(z))); \
                        const bool strict = dq - cc > 0; const float lr = fminf(z, 0.f) - lg - z; lr_[e] = strict ? lr : 0.f; ls_[e] = strict ? lr + z : NEG_INF; } \
                    PP[4 * (g) + 3] = ls_[3]; PP[4 * (g) + 2] = ls_[2] + lr_[3]; PP[4 * (g) + 1] = ls_[1] + (lr_[3] + lr_[2]); PP[4 * (g)] = ls_[0] + (lr_[3] + lr_[2] + lr_[1]); \
                    own[(g) + ((koff) ? 4 : 0)] = (lr_[3] + lr_[2]) + (lr_[1] + lr_[0]); } while (0)
                FA_SBG(p0, 0, 0); FA_SBG(p0, 1, 0); FA_SBG(p0, 2, 0); FA_SBG(p0, 3, 0); FA_SBG(p1, 0, 32); FA_SBG(p1, 1, 32); FA_SBG(p1, 2, 32); FA_SBG(p1, 3, 32);
#undef FA_SBG
                float oth[8];
#pragma unroll
                for (int g = 0; g < 8; ++g) oth[g] = xother32(own[g], hi);
                float suf = carry;
#pragma unroll
                for (int g = 7; g >= 0; --g) {
                    const float base = suf + (hi == 0 ? oth[g] : 0.f);
                    if (g >= 4) {
#pragma unroll
                        for (int e = 0; e < 4; ++e) p1[4 * (g - 4) + e] = __expf(p1[4 * (g - 4) + e] + base);
                    } else {
#pragma unroll
                        for (int e = 0; e < 4; ++e) p0[4 * g + e] = __expf(p0[4 * g + e] + base);
                    }
                    suf += own[g] + oth[g];
                }
                carry = suf;
                P[0] = pack8(p0, 0); P[1] = pack8(p0, 8); P[2] = pack8(p1, 0); P[3] = pack8(p1, 8);
                FA_PV(st);
            }
        }
        if (i + 1 < nt) FA_WRITE(st ^ 1);
        if (MODE == 1) {
            if (!__syncthreads_or((wact && carry > -110.0f) ? 1 : 0)) break;
        } else __syncthreads();
    }
    if (wact) {
        float inv = 1.0f;
        if (MODE == 0) { const float lt = xsum32(l_run); inv = lt > 0.f ? 1.0f / lt : 0.f;
            if (u.lse && hi == 0) u.lse[(size_t)row * u.lse_stride] = m_run * ATT_SCALE + __logf(fmaxf(lt, 1e-30f)); }
        bf16* op = u.o + (size_t)row * u.ostride + 4 * hi;
        if (MODE == 0 && u.comb_gl) {
            const bf16* gl = u.comb_gl + (size_t)row * u.comb_gls;
            const float g0 = 1.0f / (1.0f + __expf(-bf2f(gl[0]))), g1 = 1.0f / (1.0f + __expf(-bf2f(gl[1]))), g2 = inv / (1.0f + __expf(-bf2f(gl[2])));
            const bf16* pc = u.comb_oc + (size_t)row * 2048 + 4 * hi; const bf16* ps_ = u.comb_os + (size_t)row * 2048 + 4 * hi;
#pragma unroll
            for (int db = 0; db < 4; ++db)
#pragma unroll
                for (int g = 0; g < 4; ++g) { const u32x2 wc = *(const u32x2*)(pc + 32 * db + 8 * g), wsv = *(const u32x2*)(ps_ + 32 * db + 8 * g); u32x2 wv;
                    wv.x = cvtpk(g0 * bflo(wc.x) + g1 * bflo(wsv.x) + g2 * o[db][4 * g], g0 * bfhi(wc.x) + g1 * bfhi(wsv.x) + g2 * o[db][4 * g + 1]);
                    wv.y = cvtpk(g0 * bflo(wc.y) + g1 * bflo(wsv.y) + g2 * o[db][4 * g + 2], g0 * bfhi(wc.y) + g1 * bfhi(wsv.y) + g2 * o[db][4 * g + 3]);
                    *(u32x2*)(op + 32 * db + 8 * g) = wv; }
        } else {
#pragma unroll
        for (int db = 0; db < 4; ++db)
#pragma unroll
            for (int g = 0; g < 4; ++g) { u32x2 wv; wv.x = cvtpk(o[db][4 * g] * inv, o[db][4 * g + 1] * inv); wv.y = cvtpk(o[db][4 * g + 2] * inv, o[db][4 * g + 3] * inv);
                *(u32x2*)(op + 32 * db + 8 * g) = wv; }
        }
    }
}

__device__ __forceinline__ void cmp_unit(const Ctx& c, const bf16* Yq  , int ldy, const bf16* Kc, const bf16* Vct, bf16* OCrow  , unsigned* SELrow  , int tt) {
    const int tid = c.tid, lane = c.lane, w = c.wave, r32 = lane & 31, hi = lane >> 5;
    LAS unsigned char* L = c.lds;
    const int tok = 8 * w + (r32 >> 2), hh = r32 & 3, t = 64 * tt + tok;
    struct { const bf16* k; int kstride; const bf16* v; int vstride; } u; u.k = Kc; u.kstride = 128; u.v = Vct; u.vstride = 128;
    bf16x8 q[8];
    { const bf16* qp = Yq + (size_t)tok * ldy + hh * 128 + hi * 8;
#pragma unroll
      for (int d0 = 0; d0 < 8; ++d0) q[d0] = *(const bf16x8*)(qp + 16 * d0); }
    const int sr = tid >> 4, sc = tid & 15, vr = tid >> 3, vc = tid & 7;
    const int kw0 = sr * 256 + ((sc * 16) ^ ((sr & 15) << 4)), vw0 = KT_BYTES + 256 * sr + 16 * (sc ^ (((sr & 3) << 2) | ((sr >> 2) & 3)));
    FA_VTR_SETUP();
    v4u kq0, kq1, vq0, vq1;
    __syncthreads();
    FA_LOAD(0); FA_WRITE(0); FA_LOAD(1); FA_WRITE(1);
    __syncthreads();
    f32x16 p0, p1, s00, s01;
    FA_QK(0); s00 = p0; s01 = p1;
    FA_QK(1);
    const int nmax = (t - 31) >> 4;
    { const int nb = 4 * hi;
#pragma unroll
      for (int r = 0; r < 16; ++r) { const int cc = (r & 3) + 8 * (r >> 2) + nb;
          if (cc > nmax) s00[r] = NEG_INF; if (cc + 32 > nmax) s01[r] = NEG_INF; if (cc + 64 > nmax) p0[r] = NEG_INF; if (cc + 96 > nmax || cc + 96 > 126) p1[r] = NEG_INF; } }
    float pm = NEG_INF;
#pragma unroll
    for (int r = 0; r < 16; ++r) pm = fmaxf(pm, fmaxf(fmaxf(s00[r], s01[r]), fmaxf(p0[r], p1[r])));
    pm = xmax32(pm);
    const float mb = (pm == NEG_INF ? 0.f : pm) * C2;
    float ps = 0.f;
#pragma unroll
    for (int r = 0; r < 16; ++r) { s00[r] = __builtin_amdgcn_exp2f(s00[r] * C2 - mb); s01[r] = __builtin_amdgcn_exp2f(s01[r] * C2 - mb); p0[r] = __builtin_amdgcn_exp2f(p0[r] * C2 - mb); p1[r] = __builtin_amdgcn_exp2f(p1[r] * C2 - mb);
        ps += (s00[r] + s01[r]) + (p0[r] + p1[r]); }
    ps = xsum32(ps);
    const float inv = 1.0f / fmaxf(ps, 1e-30f);
#pragma unroll
    for (int r = 0; r < 16; ++r) { s00[r] *= inv; s01[r] *= inv; p0[r] *= inv; p1[r] *= inv; }
    f32x16 o[4] = {f32x16{}, f32x16{}, f32x16{}, f32x16{}}; bf16x8 P[4];
    P[0] = pack8(s00, 0); P[1] = pack8(s00, 8); P[2] = pack8(s01, 0); P[3] = pack8(s01, 8); FA_PV(0);
    P[0] = pack8(p0, 0); P[1] = pack8(p0, 8); P[2] = pack8(p1, 0); P[3] = pack8(p1, 8); FA_PV(1);
    { bf16* op = OCrow + (size_t)tok * 2048 + hh * 128 + 4 * hi;
#pragma unroll
      for (int db = 0; db < 4; ++db)
#pragma unroll
          for (int g = 0; g < 4; ++g) { u32x2 wv; wv.x = cvtpk(o[db][4 * g], o[db][4 * g + 1]); wv.y = cvtpk(o[db][4 * g + 2], o[db][4 * g + 3]); *(u32x2*)(op + 32 * db + 8 * g) = wv; } }
    float cs[16], cl[16];
#pragma unroll
    for (int rq = 0; rq < 4; ++rq) {
        cs[rq] = (s00[4 * rq] + s00[4 * rq + 1]) + (s00[4 * rq + 2] + s00[4 * rq + 3]); cl[rq] = s00[4 * rq + 3];
        cs[4 + rq] = (s01[4 * rq] + s01[4 * rq + 1]) + (s01[4 * rq + 2] + s01[4 * rq + 3]); cl[4 + rq] = s01[4 * rq + 3];
        cs[8 + rq] = (p0[4 * rq] + p0[4 * rq + 1]) + (p0[4 * rq + 2] + p0[4 * rq + 3]); cl[8 + rq] = p0[4 * rq + 3];
        cs[12 + rq] = (p1[4 * rq] + p1[4 * rq + 1]) + (p1[4 * rq + 2] + p1[4 * rq + 3]); cl[12 + rq] = p1[4 * rq + 3]; }
#pragma unroll
    for (int k = 0; k < 16; ++k) { cs[k] += __shfl_xor(cs[k], 1); cs[k] += __shfl_xor(cs[k], 2); cl[k] += __shfl_xor(cl[k], 1); cl[k] += __shfl_xor(cl[k], 2); }
    float impE[16], impO[16];
    { float ocs[16], ocl[16];
#pragma unroll
      for (int k = 0; k < 16; ++k) { ocs[k] = xother32(cs[k], hi); ocl[k] = xother32(cl[k], hi); }
#pragma unroll
      for (int k = 0; k < 16; ++k) { const float ecs = hi ? ocs[k] : cs[k], ocs_ = hi ? cs[k] : ocs[k], clO = hi ? ocl[k] : cl[k];
          float clE = 0.f; if (k > 0) clE = hi ? cl[k - 1] : ocl[k - 1];
          impE[k] = ecs + clE; impO[k] = ocs_ + clO; } }
    LAS float* tab = (LAS float*)(L + 2 * STAGE) + (8 * w + (r32 >> 2)) * 32;
    if (hh == 0 && hi == 0) {
#pragma unroll
        for (int k = 0; k < 16; ++k) { const int je = 2 * k, jo = 2 * k + 1;
            const float ve = (je == 0 || je == tt) ? __builtin_inff() : (je <= tt ? impE[k] : NEG_INF), vo = (jo == tt) ? __builtin_inff() : (jo <= tt ? impO[k] : NEG_INF);
            tab[je] = ve; tab[jo] = vo; } }
    LDS_FENCE();
    const int a4 = 4 * (hh + 4 * hi);
    const f32x4 vj = *(const LAS f32x4*)(tab + a4);
    int rk0 = 0, rk1 = 0, rk2 = 0, rk3 = 0;
#pragma unroll
    for (int i4 = 0; i4 < 8; ++i4) { const f32x4 vi = *(const LAS f32x4*)(tab + 4 * i4);
#pragma unroll
        for (int e = 0; e < 4; ++e) { const float x = vi[e]; const int i = 4 * i4 + e;
            rk0 += (x > vj.x || (x == vj.x && i < a4 + 0)) ? 1 : 0; rk1 += (x > vj.y || (x == vj.y && i < a4 + 1)) ? 1 : 0;
            rk2 += (x > vj.z || (x == vj.z && i < a4 + 2)) ? 1 : 0; rk3 += (x > vj.w || (x == vj.w && i < a4 + 3)) ? 1 : 0; } }
    unsigned m = 0u;
    if (rk0 < 16 && a4 + 0 <= tt) m |= 1u << (a4 + 0); if (rk1 < 16 && a4 + 1 <= tt) m |= 1u << (a4 + 1); if (rk2 < 16 && a4 + 2 <= tt) m |= 1u << (a4 + 2); if (rk3 < 16 && a4 + 3 <= tt) m |= 1u << (a4 + 3);
    m |= (unsigned)__shfl_xor((int)m, 1); m |= (unsigned)__shfl_xor((int)m, 2); m |= (unsigned)__shfl_xor((int)m, 32);
    if (hh == 0 && hi == 0) SELrow[tok] = m;
    LDS_FENCE();
}
#undef FA_LOAD
#undef FA_WRITE
#undef FA_QK
#undef FA_PV
#undef FA_TRRD
#undef FA_VTR_SETUP
#undef FA_SB0
}


__device__ __forceinline__ void cmp_bias(const Ctx& c, const float* pe_k, const float* pe_v, const float* phi_k, const float* phi_v, float* cbias) {
    for (int it = c.gw; it < 256; it += c.ngw) {
        const int which = it >> 7, e = it & 127; const float* pe = which ? pe_v : pe_k; const float* phi = which ? phi_v : phi_k; float s = 0.f;
        for (int k = c.lane; k < 4096; k += 64) s += pe[k] * phi[(size_t)k * 128 + e];
        s = wsum(s); if (c.lane == 0) cbias[it] = s;
    }
}
__device__ __forceinline__ void cmp_mfma(const Ctx& c, const bf16* Y, const bf16* PHIKT, const bf16* PHIVT, float* KCR4, float* VCR4) {
    const int lane = c.lane, r32 = lane & 31, hi = lane >> 5;
    for (int it = c.gw; it < 2048; it += c.ngw) {
        const int lq = it & 3, eb = (it >> 2) & 3, nt = (it >> 4) & 3, bg = (it >> 6) & 15, which = it >> 10, b = bg >> 2, g = bg & 3;
        const int n = (32 * nt + r32) < 126 ? (32 * nt + r32) : 126;
        const bf16* arow = Y + ((size_t)b * T + 16 * n + 8 * lq) * EVEN_LD + (which ? C_VC : C_KC) + g * 128 + hi * 8;
        const bf16* brow = (which ? PHIVT : PHIKT) + (size_t)(32 * eb + r32) * 4096 + (8 * lq) * 128 + hi * 8;
        fa::f32x16 acc = {};
        fa::bf16x8 a0[8], b0[8], a1[8], b1[8];
#define CM_LOAD(l, A_, B_) do { _Pragma("unroll") for (int s8 = 0; s8 < 8; ++s8) { A_[s8] = *(const fa::bf16x8*)(arow + (size_t)(l) * EVEN_LD + 16 * s8); B_[s8] = *(const fa::bf16x8*)(brow + (l) * 128 + 16 * s8); } __builtin_amdgcn_sched_barrier(0); } while (0)
#define CM_MMA(A_, B_) do { _Pragma("unroll") for (int s8 = 0; s8 < 8; ++s8) acc = __builtin_amdgcn_mfma_f32_32x32x16_bf16(A_[s8], B_[s8], acc, 0, 0, 0); __builtin_amdgcn_sched_barrier(0); } while (0)
        CM_LOAD(0, a0, b0);
#pragma unroll 1
        for (int l = 0; l < 8; l += 2) {
            CM_LOAD(l + 1, a1, b1); CM_MMA(a0, b0);
            if (l + 2 < 8) CM_LOAD(l + 2, a0, b0);
            CM_MMA(a1, b1);
        }
#undef CM_LOAD
#undef CM_MMA
        float* dst = (which ? VCR4 : KCR4) + (size_t)lq * (16 * 128 * 128) + ((size_t)bg * 128 + 32 * nt) * 128 + 32 * eb + r32;
#pragma unroll
        for (int r = 0; r < 16; ++r) { const int nn = (r & 3) + 8 * (r >> 2) + 4 * hi; if (32 * nt + nn < 127) dst[nn * 128] = acc[r]; }
    }
}
__device__ __forceinline__ void vt_pass(const Ctx& c, const bf16* Ysrc, int ld, int col0, int nheads, bf16* VT, int NH, int head0, int TL, int dil_mode) {
    LAS unsigned char* scr = c.lds + c.wave * 16384; const int lane = c.lane; const int npb = TL / 32, items = NB * nheads * npb;
    for (int it = c.gw; it < items; it += c.ngw) {
        const int pb = it % npb, bh = it / npb, hh = bh % nheads, b = bh / nheads;
        const int r = dil_mode ? (hh < 8 ? 1 : (hh < 16 ? 4 : 16)) : 1, CL = TL / r, pp0 = 32 * pb, cls = pp0 / CL, i0 = pp0 - cls * CL, tok0 = cls + r * i0;
        const bf16* src = Ysrc + ((size_t)b * TL + tok0) * ld + col0 + hh * 128;
#pragma unroll
        for (int k = 0; k < 8; ++k) { const int ci = lane + 64 * k, rr = ci >> 4, ch = ci & 15; const v4u w = *(const v4u*)(src + (size_t)rr * r * ld + ch * 8);
            LAS unsigned* d2 = (LAS unsigned*)(scr + rr * 264 + ch * 16); d2[0] = w.x; d2[1] = w.y; d2[2] = w.z; d2[3] = w.w; }
        LDS_FENCE();
        bf16* dst = VT + ((size_t)(b * NH + head0 + hh) * 128) * TL + pp0;
#pragma unroll
        for (int k = 0; k < 8; ++k) { const int ci = lane + 64 * k, d = ci >> 2, q4 = ci & 3; const LAS bf16* s = (const LAS bf16*)(scr + (8 * q4) * 264 + 2 * d);
            v4u o; o.x = (unsigned)s[0] | ((unsigned)s[132] << 16); o.y = (unsigned)s[2 * 132] | ((unsigned)s[3 * 132] << 16); o.z = (unsigned)s[4 * 132] | ((unsigned)s[5 * 132] << 16); o.w = (unsigned)s[6 * 132] | ((unsigned)s[7 * 132] << 16);
            *(v4u*)(dst + (size_t)d * TL + 8 * q4) = o; }
        LDS_FENCE();
    }
}
__device__ __forceinline__ void moba_sel_row(const Ctx& c, LAS float* qs, const bf16* Y, const float* kmean, unsigned* SELM, int b, int h, int t) {
    const int lane = c.lane; const size_t row = (size_t)b * T + t;
    load_q(qs, Y + row * EVEN_LD + C_MQ + h * 128, lane);
    const int cur = t >> 8;
    float gate = NEG_INF;
    if (lane < cur) { const float* km = kmean + ((size_t)(b * 16 + h) * 8 + lane) * 128; float s = 0.f; for (int d = 0; d < 128; ++d) s += qs[d] * km[d]; gate = s; }
    int rank = 0;
    for (int m2 = 0; m2 < 8; ++m2) { const float gm = rdlane(gate, m2); rank += (gm > gate || (gm == gate && m2 < lane)) ? 1 : 0; }
    const unsigned selmask = (unsigned)__ballot((lane < cur) && (rank < 3));
    if (lane == 0) SELM[(size_t)(b * 16 + h) * T + t] = selmask;
}
__device__ __forceinline__ void nsa_cmp_item(const Ctx& c, LAS float* qs, LAS float* ps, const bf16* Y, const bf16* KCN, const bf16* VCN, bf16* OC, unsigned* SELN, int b, int g, int t) {
    const int lane = c.lane; const size_t row = (size_t)b * T + t;
    const bf16* Kc = KCN + (size_t)(b * 4 + g) * 128 * 128; const bf16* Vc = VCN + (size_t)(b * 4 + g) * 128 * 128;
    float P0 = 0.f, P1 = 0.f;
    const int n0 = lane, n1 = 64 + lane; const bool v0 = 16 * n0 + 31 <= t, v1 = (n1 < 127) && (16 * n1 + 31 <= t);
#pragma unroll 1
    for (int hh = 0; hh < 4; ++hh) {
        const int h = g * 4 + hh;
        load_q(qs, Y + row * EVEN_LD + C_NQ + h * 128, lane);
        float s0 = dot128(qs, Kc + (v0 ? n0 : 0) * 128) * ATT_SCALE, s1 = dot128(qs, Kc + (v1 ? n1 : 0) * 128) * ATT_SCALE;
        if (!v0) s0 = NEG_INF; if (!v1) s1 = NEG_INF;
        const float m = wmax(fmaxf(s0, s1)); float a0 = 0.f, a1 = 0.f;
        if (m != NEG_INF) {
            float p0 = __expf(s0 - m), p1 = __expf(s1 - m);
            const float inv = 1.0f / fmaxf(wsum(p0 + p1), 1e-30f);
            p0 *= inv; p1 *= inv; P0 += p0; P1 += p1;
            pv_accum(a0, a1, p0, n0 * 128, Vc, lane); pv_accum(a0, a1, p1, (v1 ? n1 : 0) * 128, Vc, lane);
        }
        *(unsigned*)(OC + row * 2048 + h * 128 + 2 * lane) = pk2(a0, a1);
    }
    LDS_FENCE(); ps[lane] = P0; ps[64 + lane] = P1; LDS_FENCE();
    float imp = 0.f;
    if (lane < 32) { for (int n = 4 * lane - 1; n <= 4 * lane + 3; ++n) if (n >= 0 && n < 127) imp += ps[n]; }
    const int cur = t >> 6;
    const float v = (lane >= 32) ? NEG_INF : ((lane == cur || lane == 0) ? __builtin_inff() : (lane <= cur ? imp : NEG_INF));
    int rank = 0;
    for (int m2 = 0; m2 < 32; ++m2) { const float vm = rdlane(v, m2); rank += (vm > v || (vm == v && m2 < lane)) ? 1 : 0; }
    const unsigned selmask = (unsigned)__ballot(lane < 32 && lane <= cur && rank < 16);
    if (lane == 0) SELN[(size_t)(b * 4 + g) * T + t] = selmask;
}
__device__ __forceinline__ void nsa_combine(const Ctx& c, const bf16* Y, const bf16* OC, const bf16* OS, const bf16* OW, bf16* O) {
    const int lane = c.lane;
    for (int it = c.gw; it < MTOK * 16; it += c.ngw) {
        const int row = it >> 4, h = it & 15; const size_t off = (size_t)row * 2048 + h * 128 + 2 * lane;
        const bf16* gl = Y + (size_t)row * EVEN_LD + C_GL + h * 3;
        const float g0 = 1.0f / (1.0f + __expf(-bf2f(gl[0]))), g1 = 1.0f / (1.0f + __expf(-bf2f(gl[1]))), g2 = 1.0f / (1.0f + __expf(-bf2f(gl[2])));
        const unsigned wc = *(const unsigned*)(OC + off), wsv = *(const unsigned*)(OS + off), ww = *(const unsigned*)(OW + off);
        *(unsigned*)(O + (size_t)row * DM + 2048 + h * 128 + 2 * lane) = pk2(g0 * bflo(wc) + g1 * bflo(wsv) + g2 * bflo(ww), g0 * bfhi(wc) + g1 * bfhi(wsv) + g2 * bfhi(ww));
    }
}
__device__ __forceinline__ void dil_combine(const Ctx& c, const bf16* OG, const float* LSE, bf16* O) {
    const int lane = c.lane;
    for (int it = c.gw; it < MTOK * 8; it += c.ngw) {
        const int row = it >> 3, hd = it & 7; const size_t off = (size_t)row * 1024 + hd * 128 + 2 * lane;
        const float l0 = LSE[(size_t)row * 8 + hd], l1 = LSE[(size_t)MTOK * 8 + (size_t)row * 8 + hd], l2 = LSE[(size_t)2 * MTOK * 8 + (size_t)row * 8 + hd];
        const float mx = fmaxf(l0, fmaxf(l1, l2)); const float w0 = __expf(l0 - mx), w1 = __expf(l1 - mx), w2 = __expf(l2 - mx), iw = 1.0f / (w0 + w1 + w2);
        const unsigned a = *(const unsigned*)(OG + off), bq = *(const unsigned*)(OG + (size_t)MTOK * 1024 + off), cq = *(const unsigned*)(OG + (size_t)2 * MTOK * 1024 + off);
        *(unsigned*)(O + (size_t)row * DM + 3072 + hd * 128 + 2 * lane) = pk2((w0 * bflo(a) + w1 * bflo(bq) + w2 * bflo(cq)) * iw, (w0 * bfhi(a) + w1 * bfhi(bq) + w2 * bfhi(cq)) * iw);
    }
}
__device__ __forceinline__ int snake(int round, int b, int G) { return (round & 1) ? round * G + (G - 1 - b) : round * G + b; }

struct Args { const float* in[31]; float* out; unsigned char* ws; int ph_lo, ph_hi; };
#if MK_ONE_LAUNCH
#define GRID_BAR() xcd_barrier(bar)
#else
#define GRID_BAR() do { } while (0)
#endif
#define IN(k) (lo <= (k) && (k) < hi)
#define SEAM(k) do { if (IN(k) && IN((k) + 1)) GRID_BAR(); if (PROBE_MASK != 0ull) { const unsigned long long now_ = __builtin_amdgcn_s_memrealtime(); if ((PROBE_MASK >> (k)) & 1ull) pacc += now_ - pprev; pprev = now_; } } while (0)
template <int layer>
__device__ __forceinline__ void run_layer(const Args& args, const Ctx& c, const XcdBarrier& bar, const int lo, const int hi, unsigned long long& pprev, unsigned long long& pacc) {
    unsigned char* ws = args.ws;
    const float* x_in = args.in[0]; const float* mem = args.in[1]; const int* positions = (const int*)args.in[2];
    float* ropec = (float*)(ws + WS_ROPE); float* ropes = ropec + MTOK * 64;
    float* kmean = (float*)(ws + WS_KMEAN); float* KCR = (float*)(ws + WS_QP); float* VCR = (float*)(ws + WS_QP + 4 * MiB);
    bf16* KCN = (bf16*)(ws + WS_KCN); bf16* VCN = (bf16*)(ws + WS_VCN); bf16* MEMN = (bf16*)(ws + WS_MEMN);
    bf16* QX = (bf16*)(ws + WS_QX); bf16* KVX = (bf16*)(ws + WS_KVX); bf16* OX = (bf16*)(ws + WS_OX);
    bf16* WQ_T = (bf16*)(ws + WS_WQ); bf16* WKV_T = (bf16*)(ws + WS_WKV); bf16* WO_T = (bf16*)(ws + WS_WO); bf16* WOUT_T = (bf16*)(ws + WS_WOUT);
    bf16* WIN_T = (bf16*)(ws + (layer == 0 ? WS_WIN : WS_WIN1)); bf16* WGU_T = (bf16*)(ws + WS_WGU); bf16* WD_T = (bf16*)(ws + (layer == 0 ? WS_WD : WS_WD1));
    float* X = (float*)(ws + WS_X); bf16* H = (bf16*)(ws + WS_H); bf16* O = (bf16*)(ws + WS_O); bf16* Y = (bf16*)(ws + WS_Y); bf16* HID = Y;
    LAS float* qs = (LAS float*)(c.lds + c.wave * 16384); LAS float* ps = qs + 128;
    float* SSQ = (float*)(ws + WS_CTL) + CW_SSQ;
    float* QP = (float*)(ws + WS_QP); bf16* MEMN2 = (bf16*)(ws + WS_MEMN2); bf16* KVX2 = (bf16*)(ws + WS_KVX2); bf16* WKV2 = (bf16*)(ws + WS_WKV2); bf16* KVXL = KVX2 + (size_t)layer * 1024 * 2048;
    bf16* PHIKT = (bf16*)(ws + WS_PHIK); bf16* PHIVT = (bf16*)(ws + WS_PHIV); float* CBIAS = (float*)(ws + WS_CBIAS);
    bf16* VT = (bf16*)(ws + WS_VT); bf16* PART = (bf16*)(ws + WS_PART); bf16* VTX = (bf16*)(ws + WS_VTX); unsigned* SELM = (unsigned*)(ws + WS_SELM); unsigned* SELN = (unsigned*)(ws + WS_SELN);
    constexpr int pb = layer * NPL; constexpr bool even = (layer & 1) == 0;
    const int e_rem1 = ((MTOK / 256) * (EVEN_LD / 256)) % c.G, e_ns1 = e_rem1 ? (c.G - e_rem1 - 32 > 0 ? c.G - e_rem1 - 32 : 0) : 0;
    const int e_rem2 = ((MTOK / 256) * (GU_ROWS / 256)) % c.G, e_ns2 = e_rem2 ? c.G - e_rem2 : 0;
    const int e_it1 = e_ns1 * 8 * EARLY_N1, e_it2 = e_it1 + e_ns2 * 8 * EARLY_N2;
#if FUSE_HEADNORM
#define WIN1_RM RmHeads{0x0FFFFFF000000000ull, 0ull}
#else
#define WIN1_RM RmId{0}
#endif

        const int LDY = even ? EVEN_LD : ODD_LD;
        const float* xcur = layer == 0 ? x_in : X;
#define TK(n) ((unsigned*)(ws + WS_CTL) + CW_TICKET + 64 * (8 * layer + (n)))
        if (IN(pb + 0)) REPS(pb + 0) {
#if FUSE_HEADNORM
            if (even) conv_weight(c, args.in[4], DM, EVEN_N, EVEN_LD, WIN_T, RmHeads{0x330ff00ffffull, 0ull}, layer == 0 ? nullptr : args.in[3] + layer * DM, 0, -1, -1, -1, TK(0)); else conv_weight(c, args.in[16], DM, ODD_LD, ODD_LD, WIN_T, RmHeads{0x0FFFFFF000000000ull, 0ull}, layer == 0 ? nullptr : args.in[3] + layer * DM, layer == 1 ? e_it2 : 0, -1, -1, -1, TK(0));
#else
            if (even) conv_weight(c, args.in[4], DM, EVEN_N, EVEN_LD, WIN_T, RmId{0}, layer == 0 ? nullptr : args.in[3] + layer * DM); else conv_weight(c, args.in[16], DM, ODD_LD, ODD_LD, WIN_T, RmId{0}, layer == 0 ? nullptr : args.in[3] + layer * DM, layer == 1 ? e_it2 : 0);
#endif
            conv_weight(c, even ? args.in[5] : args.in[17], DM, DM, DM, WOUT_T, RmId{0}, nullptr, 0, -1, -1, -1, TK(1));
            conv_weight(c, args.in[22] + (size_t)layer * DM * XW, DM, XW, XW, WQ_T, RmId{0}, args.in[20] + layer * DM);
            if constexpr (layer == 0) { conv_weight(c, args.in[23], DM, 2 * XW, 2 * XW, WKV2, RmId{0}); conv_weight(c, args.in[23] + (size_t)DM * 2 * XW, DM, 2 * XW, 2 * XW, WKV2, RmId{1024}); }
            conv_weight(c, args.in[24] + (size_t)layer * XW * DM, XW, DM, DM, WO_T, RmId{0});
            conv_weight(c, args.in[28] + (size_t)layer * DM * FFN, DM, FFN, FFN, WGU_T, RmGU{0}, args.in[27] + layer * DM, 0, -1, -1, -1, TK(2));
            conv_weight(c, args.in[29] + (size_t)layer * DM * FFN, DM, FFN, FFN, WGU_T, RmGU{1}, args.in[27] + layer * DM, 0, -1, -1, -1, TK(3));
            conv_weight(c, args.in[30] + (size_t)layer * FFN * DM, FFN, DM, DM, WD_T, RmId{0}, nullptr, 0, -1, -1, -1, TK(4));
            if (layer == 0) rope_table(c, positions, ropec, ropes);
            if constexpr (even) { conv_weight(c, args.in[14], 4096, 128, 128, PHIKT, RmId{0}); conv_weight(c, args.in[15], 4096, 128, 128, PHIVT, RmId{0}); cmp_bias(c, args.in[12], args.in[13], args.in[14], args.in[15], CBIAS); }
            if constexpr (layer == 0) { rmsnorm_rows(c, mem, args.in[21], MEMN2, MEM_ROWS); rmsnorm_rows(c, mem, args.in[21] + DM, MEMN2 + (size_t)MEM_ROWS * DM, MEM_ROWS); }
            if constexpr (layer == 0) rmsnorm_rows(c, xcur, args.in[3] + layer * DM, H, MTOK);
        }
        SEAM(pb + 0);
        if (IN(pb + 1)) REPS(pb + 1) {
            pg8::Gemm g{H, WIN_T, MTOK, LDY, DM, DM}; pg8::StaticOrder S; S.init(MTOK, LDY, c.G, (int)blockIdx.x);
#if FUSE_HEADNORM
            pg8::HeadSpec hs{};
            if (even) { hs.lo[0] = 0; hs.hi[0] = 8; hs.g[0] = args.in[6]; hs.lo[1] = 8; hs.hi[1] = 16; hs.g[1] = args.in[7]; hs.lo[2] = 24; hs.hi[2] = 32; hs.g[2] = args.in[8]; hs.lo[3] = 36; hs.hi[3] = 38; hs.g[3] = args.in[10]; hs.lo[4] = 40; hs.hi[4] = 42; hs.g[4] = args.in[11]; }
            else { hs.lo[0] = 36; hs.hi[0] = 48; hs.g[0] = args.in[18]; hs.lo[1] = 48; hs.hi[1] = 60; hs.g[1] = args.in[19]; }
            pg8::EpiYHeads E{Y, LDY, layer == 0 ? nullptr : SSQ + (size_t)((layer - 1) * 3 + 2) * MTOK, hs, ropec, ropes, (LAS float*)(c.lds + 132096)};
            pg8::gemm_phase<pg8::EpiYHeads, pg8::StaticOrder, true, true>(c.lds, g, S, E);
#else
            pg8::EpiBf16P E{Y, LDY, layer == 0 ? nullptr : SSQ + (size_t)((layer - 1) * 3 + 2) * MTOK};
            pg8::gemm_phase<pg8::EpiBf16P, pg8::StaticOrder, true, true>(c.lds, g, S, E);
#endif
            if constexpr (layer == 0) {
                pg8::Gemm g2{MEMN2, WKV2, 2 * MEM_ROWS, 2 * 1024, DM, DM}; pg8::DiagOrder S2; S2.init(2, 4, 4, c.G, c.G - 1 - (int)blockIdx.x); pg8::EpiBf16P E2{KVX2, 2048, nullptr};
                pg8::gemm_phase<pg8::EpiBf16P, pg8::DiagOrder, true, true>(c.lds, g2, S2, E2);
                const int j1 = (int)blockIdx.x - e_rem1;
                if (j1 >= 0 && j1 < e_ns1) { __syncthreads(); conv_weight<decltype(WIN1_RM), EARLY_NT != 0>(c, args.in[16], DM, ODD_LD, ODD_LD, (bf16*)(ws + WS_WIN1), WIN1_RM, args.in[3] + DM, 0, e_it1, j1 * 8 + c.wave, e_ns1 * 8); }
            }
        }
        SEAM(pb + 1);
        if constexpr (even || !FUSE_HEADNORM) {
        if (IN(pb + 2)) REPS(pb + 2) {
            if (even) {
#if !FUSE_HEADNORM
                headnorm_bf16(c, Y, EVEN_LD, C_MQ, 16, MTOK, args.in[6], ropec, ropes);
                headnorm_bf16(c, Y, EVEN_LD, C_MK, 16, MTOK, args.in[7], ropec, ropes);
                headnorm_bf16(c, Y, EVEN_LD, C_NQ, 16, MTOK, args.in[8], ropec, ropes);
                headnorm_bf16(c, Y, EVEN_LD, C_KS, 4, MTOK, args.in[10], ropec, ropes);
                headnorm_bf16(c, Y, EVEN_LD, C_KW, 4, MTOK, args.in[11], ropec, ropes);
#endif
                cmp_mfma(c, Y, PHIKT, PHIVT, KCR, VCR);
#if FUSE_HEADNORM
                moba_kmean(c, Y, kmean);
#endif
            } else {
#if !FUSE_HEADNORM
                headnorm_bf16(c, Y, ODD_LD, C_DQ, 24, MTOK, args.in[18], ropec, ropes);
                headnorm_bf16(c, Y, ODD_LD, C_DK, 24, MTOK, args.in[19], ropec, ropes);
#endif
            }
        }
        SEAM(pb + 2);
        }
        if constexpr (even) {
            if (IN(pb + 3)) REPS(pb + 3) { cmp_finish(c, KCR, VCR, CBIAS, KCN, VCN, args.in[9], ropec, ropes); if (!FUSE_HEADNORM) moba_kmean(c, Y, kmean); }
            SEAM(pb + 3);
            if (IN(pb + 4)) REPS(pb + 4) {
#if FA_EVEN
                for (int idx = (int)blockIdx.x; idx < NB * 4 * 32; idx += c.G) { const int tt = 31 - (idx >> 4), bg = idx & 15, b = bg >> 2, g = bg & 3; const size_t r0 = (size_t)b * T + 64 * tt;
                    fa::cmp_unit(c, Y + r0 * EVEN_LD + C_NQ + 4 * g * 128, EVEN_LD, KCN + (size_t)bg * 128 * 128, VCN + (size_t)bg * 128 * 128, PART + r0 * 2048 + 4 * g * 128, SELN + (size_t)bg * T + 64 * tt, tt); }
#endif
            }
            SEAM(pb + 4);
        }
        if (IN(pb + 5)) REPS(pb + 5) {
            if constexpr (even && !FA_EVEN) {
                for (int it = c.gw; it < NB * 16 * T; it += c.ngw) { const int bh = it >> 11; moba_row(c, qs, Y, kmean, O, bh >> 4, bh & 15, spread_t(it)); }
                for (int it = c.gw; it < NB * 4 * T; it += c.ngw) { const int bg = it >> 11; nsa_item(c, qs, ps, Y, KCN, VCN, O, bg >> 2, bg & 3, spread_t(it)); }
            } else if constexpr (!even && !FA_ODD) {
                for (int it = c.gw; it < NB * 24 * T; it += c.ngw) { const int bh = it >> 11; sb_row(c, qs, Y, O, bh / 24, bh % 24, spread_t(it)); }
                for (int it = c.gw; it < NB * 8 * T; it += c.ngw) { const int bh = it >> 11; dil_row(c, qs, Y, O, bh >> 3, bh & 7, spread_t(it)); }
            } else if constexpr (even) {
                bf16* OS = PART + (size_t)MTOK * 2048; bf16* OW = PART + (size_t)2 * MTOK * 2048;
                for (int blk = (int)blockIdx.x; blk < 256; blk += c.G)
#pragma unroll 1
                for (int round = 0; round < 3; ++round) {
                    const int xcd = blk & 7, slot = blk >> 3;
#pragma unroll 1
                    for (int half = 0; half < 2; ++half) {
                        fa::Unit u; u.qp = nullptr; u.qgain = nullptr; u.qssq = nullptr; u.qps = 0; u.comb_gl = nullptr; u.comb_oc = nullptr; u.comb_os = nullptr; u.comb_gls = 0; u.kmean = nullptr; u.lse = nullptr; u.lse_stride = 0; u.causal = 1; u.nrows = 256; u.qstride = EVEN_LD; u.kstride = EVEN_LD; u.vstride = EVEN_LD; u.sel_stride = 1; u.t_lo = 0; u.window = 1 << 30;
                        u.sel = nullptr; u.sel_shift = 0; u.own_blk = -1;
                        if (round == 0) {
                            const int fam = xcd * 8 + (slot >> 2), pr = slot & 3, qb = half ? pr : 7 - pr, b = fam >> 4, h = fam & 15; const size_t r0 = (size_t)b * T + 256 * qb;
                            u.pos0 = 256 * qb; u.t_hi = 4 * qb + 4;
                            u.q = Y + r0 * EVEN_LD + C_MQ + h * 128; u.k = Y + (size_t)b * T * EVEN_LD + C_MK + h * 128; u.v = Y + (size_t)b * T * EVEN_LD + C_MV + h * 128;
                            u.o = O + r0 * DM + h * 128; u.ostride = DM; u.kmean = kmean + (size_t)(b * 16 + h) * 8 * 128; u.sel_shift = 2; u.own_blk = qb;
                        } else {
                            const int fam = xcd * 2 + (slot >> 4), j = slot & 15, hh = j >> 2, pr = j & 3, b = fam >> 2, g = fam & 3, h = g * 4 + hh;
                            const int qb = half ? pr : 7 - pr; const size_t r0 = (size_t)b * T + 256 * qb;
                            u.pos0 = 256 * qb; u.t_hi = 4 * qb + 4; u.q = Y + r0 * EVEN_LD + C_NQ + h * 128; u.ostride = 2048;
                            if (round == 1) { u.k = Y + (size_t)b * T * EVEN_LD + C_KS + g * 128; u.v = Y + (size_t)b * T * EVEN_LD + C_VS + g * 128; u.o = OS + r0 * 2048 + h * 128; u.sel = SELN + (size_t)(b * 4 + g) * T + 256 * qb; }
                            else { u.k = Y + (size_t)b * T * EVEN_LD + C_KW + g * 128; u.v = Y + (size_t)b * T * EVEN_LD + C_VW + g * 128; u.t_lo = qb >= 2 ? 4 * qb - 8 : 0; u.window = 512;
                                u.o = O + r0 * DM + 2048 + h * 128; u.ostride = DM; u.comb_oc = PART + r0 * 2048 + h * 128; u.comb_os = OS + r0 * 2048 + h * 128; u.comb_gl = Y + r0 * EVEN_LD + C_GL + h * 3; u.comb_gls = EVEN_LD; }
                        }
                        fa::run_unit<0>(c, u);
                    }
                }
            } else {
                float* LSE = (float*)(ws + WS_LSE);
                if constexpr (!FA_SB) { for (int it = c.gw; it < NB * 24 * T; it += c.ngw) { const int bh = it >> 11; sb_row(c, qs, Y, O, bh / 24, bh % 24, spread_t(it)); } }
                if constexpr (!FA_DIL) { for (int it = c.gw; it < NB * 8 * T; it += c.ngw) { const int bh = it >> 11; dil_row(c, qs, Y, O, bh >> 3, bh & 7, spread_t(it)); } }
                for (int round = 0; round < 7 * 256 / c.G + 1; ++round) {
                    const int idx = snake(round, (int)blockIdx.x, c.G); if (idx >= 1792) continue;
                    if (!FA_SB && idx < 768) continue;
                    if (!FA_DIL && idx >= 768) continue;
#ifdef PROBE_SKIP_DIL
                    if (idx >= 768) continue;
#endif
#ifdef PROBE_SKIP_SB
                    if (idx < 768) continue;
#endif
                    fa::Unit u; u.qp = nullptr; u.qgain = nullptr; u.qssq = nullptr; u.qps = 0; u.comb_gl = nullptr; u.comb_oc = nullptr; u.comb_os = nullptr; u.comb_gls = 0; u.kmean = nullptr; u.lse = nullptr; u.lse_stride = 0; u.causal = 1; u.nrows = 256; u.qstride = ODD_LD; u.kstride = ODD_LD; u.vstride = ODD_LD; u.sel = nullptr; u.sel_stride = 0; u.sel_shift = 0; u.own_blk = -1; u.t_lo = 0; u.window = 1 << 30;
                    if (idx < 768) {
                        const int qb = 7 - idx / 96, bh = idx % 96, b = bh / 24, h = bh % 24; const size_t r0 = (size_t)b * T + 256 * qb;
                        u.pos0 = 256 * qb; u.t_hi = 4 * qb + 4;
                        u.q = Y + r0 * ODD_LD + C_SQ + h * 128; u.k = Y + (size_t)b * T * ODD_LD + C_SK + h * 128; u.v = Y + (size_t)b * T * ODD_LD + C_SV + h * 128; u.o = O + r0 * DM + h * 128; u.ostride = DM;
                        fa::run_unit<1>(c, u);
                    } else {
                        int gi, r, b, hd, cls, un;
                        if (idx < 1024) { const int j = idx - 768; gi = 0; r = 1; un = j & 7; hd = (j >> 3) & 7; b = j >> 6; cls = 0; }
                        else if (idx < 1280) { const int j = idx - 1024; gi = 1; r = 4; un = j & 1; cls = (j >> 1) & 3; hd = (j >> 3) & 7; b = j >> 6; }
                        else { const int j = idx - 1280; gi = 2; r = 16; un = 0; cls = j & 15; hd = (j >> 4) & 7; b = j >> 7; }
                        const int nd = gi * 8 + hd, CL = T / r; const size_t tok0 = (size_t)b * T + cls + (size_t)r * 256 * un;
                        u.nrows = CL < 256 ? CL : 256; u.pos0 = 256 * un; u.t_lo = un > 0 ? 4 * un - 2 : 0; u.t_hi = (4 * un + 4) < CL / 64 ? (4 * un + 4) : CL / 64; u.window = 129;
                        u.qstride = r * ODD_LD; u.kstride = r * ODD_LD; u.vstride = r * ODD_LD;
                        u.q = Y + tok0 * ODD_LD + C_DQ + nd * 128; u.k = Y + ((size_t)b * T + cls) * ODD_LD + C_DK + nd * 128; u.v = Y + ((size_t)b * T + cls) * ODD_LD + C_DV + nd * 128;
                        u.o = PART + (size_t)gi * MTOK * 1024 + tok0 * 1024 + hd * 128; u.ostride = r * 1024; u.lse = LSE + (size_t)gi * MTOK * 8 + tok0 * 8 + hd; u.lse_stride = r * 8;
                        fa::run_unit<0>(c, u);
                    }
                }
            }
        }
        SEAM(pb + 5);
        if constexpr (!even) {
            if (IN(pb + 6)) REPS(pb + 6) { if constexpr (FA_ODD && FA_DIL) dil_combine(c, PART, (const float*)(ws + WS_LSE), O); }
            SEAM(pb + 6);
        }
        if (IN(pb + 7)) REPS(pb + 7) {
            pg8::Gemm g{O, WOUT_T, MTOK, DM, DM, DM}; pg8::StaticOrder S; S.init(MTOK, DM, c.G, (int)blockIdx.x);
#if RES_BF16
            if constexpr (layer == 0) { pg8::EpiResBf16N<float> E{x_in, DM, H, SSQ + (size_t)(layer * 3 + 0) * MTOK}; pg8::gemm_phase<pg8::EpiResBf16N<float>, pg8::StaticOrder, true, true>(c.lds, g, S, E); }
            else { pg8::EpiResBf16N<bf16> E{H, DM, H, SSQ + (size_t)(layer * 3 + 0) * MTOK}; pg8::gemm_phase<pg8::EpiResBf16N<bf16>, pg8::StaticOrder, true, true>(c.lds, g, S, E); }
#else
            pg8::EpiResF32N E{xcur, X, DM, H, SSQ + (size_t)(layer * 3 + 0) * MTOK};
            pg8::gemm_phase<pg8::EpiResF32N, pg8::StaticOrder, true, true>(c.lds, g, S, E);
#endif
        }
        SEAM(pb + 7);
        if (IN(pb + 9)) REPS(pb + 9) {
            pg8::Gemm g{H, WQ_T, MTOK, XW, DM, DM / 4}; pg8::SplitKOrder S; S.init(MTOK, XW, 4, c.G, (int)blockIdx.x); pg8::EpiF32Part E{QP, XW, (size_t)MTOK * XW};
            pg8::gemm_phase<pg8::EpiF32Part, pg8::SplitKOrder, true, true>(c.lds, g, S, E);
            headnorm_bf16(c, KVXL, 2048, layer * 1024, 4, MEM_ROWS, args.in[26] + layer * HD, nullptr, nullptr);
        }
        SEAM(pb + 9);
        if (IN(pb + 11)) REPS(pb + 11) {
            if constexpr (!FA_XATTN) { for (int it = c.gw; it < NB * 4 * T; it += c.ngw) { const int bh = it >> 11; xattn_row(c, qs, QX, KVX, OX, bh >> 2, bh & 3, it & (T - 1)); } }
            else for (int idx = (int)blockIdx.x; idx < 128; idx += c.G) {
                const int qb = idx & 7, bh = idx >> 3, b = bh >> 2, h = bh & 3; const size_t r0 = (size_t)b * T + 256 * qb;
                fa::Unit u; u.qp = nullptr; u.qgain = nullptr; u.qssq = nullptr; u.qps = 0; u.comb_gl = nullptr; u.comb_oc = nullptr; u.comb_os = nullptr; u.comb_gls = 0; u.kmean = nullptr; u.lse = nullptr; u.lse_stride = 0; u.causal = 0; u.nrows = 256; u.qstride = XW; u.kstride = 2048; u.vstride = 2048; u.sel = nullptr; u.sel_stride = 0; u.sel_shift = 0; u.own_blk = -1;
                u.t_lo = 0; u.t_hi = 4; u.window = 1 << 30; u.pos0 = 0;
                u.q = nullptr; u.qp = QP + r0 * XW + h * 128; u.qps = (size_t)MTOK * XW; u.qgain = args.in[25] + layer * HD; u.qssq = SSQ + (size_t)(layer * 3 + 0) * MTOK + r0; u.k = KVXL + (size_t)b * MEM_LEN * 2048 + layer * 1024 + h * 128; u.v = KVXL + (size_t)b * MEM_LEN * 2048 + layer * 1024 + XW + h * 128; u.o = OX + r0 * XW + h * 128; u.ostride = XW;
                fa::run_unit<0>(c, u);
            }
        }
        SEAM(pb + 11);
        if (IN(pb + 12)) REPS(pb + 12) {
            pg8::Gemm g{OX, WO_T, MTOK, DM, XW, XW}; pg8::StaticOrder S; S.init(MTOK, DM, c.G, (int)blockIdx.x);
#if RES_BF16
            pg8::EpiResBf16N<bf16> E{H, DM, H, SSQ + (size_t)(layer * 3 + 1) * MTOK}; pg8::gemm_phase<pg8::EpiResBf16N<bf16>, pg8::StaticOrder, true, true>(c.lds, g, S, E);
#else
            pg8::EpiResF32N E{X, X, DM, H, SSQ + (size_t)(layer * 3 + 1) * MTOK};
            pg8::gemm_phase<pg8::EpiResF32N, pg8::StaticOrder, true, true>(c.lds, g, S, E);
#endif
        }
        SEAM(pb + 12);
        if (IN(pb + 14)) REPS(pb + 14) {
            pg8::Gemm g{H, WGU_T, MTOK, GU_ROWS, DM, DM}; pg8::StaticOrder S; S.init(MTOK, GU_ROWS, c.G, (int)blockIdx.x);
            pg8::EpiSwiGLU E{HID, FFN, SSQ + (size_t)(layer * 3 + 1) * MTOK};
            pg8::gemm_phase<pg8::EpiSwiGLU, pg8::StaticOrder, true, true>(c.lds, g, S, E);
            if constexpr (layer == 0) { const int j2 = (int)blockIdx.x - e_rem2;
                if (e_ns2 > 0 && j2 >= 0) { __syncthreads(); conv_weight<decltype(WIN1_RM), EARLY_NT != 0>(c, args.in[16], DM, ODD_LD, ODD_LD, (bf16*)(ws + WS_WIN1), WIN1_RM, args.in[3] + DM, e_it1, e_it2, j2 * 8 + c.wave, e_ns2 * 8); } }
        }
        SEAM(pb + 14);
        if (IN(pb + 15)) REPS(pb + 15) {
            pg8::Gemm g{HID, WD_T, MTOK, DM, FFN, FFN}; pg8::StaticOrder S; S.init(MTOK, DM, c.G, (int)blockIdx.x);
#if RES_BF16
            if constexpr (layer == 1) { pg8::EpiOutBf16Res E{H, args.out, DM}; pg8::gemm_phase<pg8::EpiOutBf16Res, pg8::StaticOrder, true, true>(c.lds, g, S, E); }
            else { pg8::EpiResBf16N<bf16> E{H, DM, H, SSQ + (size_t)(layer * 3 + 2) * MTOK}; pg8::gemm_phase<pg8::EpiResBf16N<bf16>, pg8::StaticOrder, true, true>(c.lds, g, S, E); }
#else
            if constexpr (layer == 1) { pg8::EpiResF32 E{X, args.out, DM}; pg8::gemm_phase<pg8::EpiResF32, pg8::StaticOrder, true, true>(c.lds, g, S, E); }
            else { pg8::EpiResF32N E{X, X, DM, H, SSQ + (size_t)(layer * 3 + 2) * MTOK}; pg8::gemm_phase<pg8::EpiResF32N, pg8::StaticOrder, true, true>(c.lds, g, S, E); }
#endif
        }
        if constexpr (layer == 0) { if (PROBE_MASK != 0ull) SEAM(pb + 15); } else if (PROBE_MASK != 0ull) { GRID_BAR(); const unsigned long long now_ = __builtin_amdgcn_s_memrealtime(); if ((PROBE_MASK >> (pb + 15)) & 1ull) pacc += now_ - pprev; pprev = now_; }
}
__global__ void __launch_bounds__(NWAVES * 64, 2) fwd(Args args) {
    extern __shared__ __attribute__((aligned(16))) unsigned char lds_raw[];
    Ctx c; c.lds = (LAS unsigned char*)lds_raw; c.tid = threadIdx.x; c.lane = c.tid & 63; c.wave = __builtin_amdgcn_readfirstlane(c.tid >> 6);
    c.G = gridDim.x; c.gw = blockIdx.x * NWAVES + c.wave; c.ngw = c.G * NWAVES;
    unsigned* ctl = (unsigned*)(args.ws + WS_CTL);
    for (int u = c.tid; u < (LDS_BYTES - LDSCTL_OFF) / 4; u += NWAVES * 64) ((LAS unsigned*)(c.lds + LDSCTL_OFF))[u] = 0u;
    __syncthreads();
#if MK_ONE_LAUNCH
    XcdBarrier bar = xcd_barrier_post(ctl + CW_BAR, (volatile LAS unsigned*)(c.lds + MISC_OFF + 32));
#else
    XcdBarrier bar; bar.bar = ctl + CW_BAR; bar.x = 0; bar.st = nullptr;
#endif
    const int lo = args.ph_lo, hi = args.ph_hi;
    unsigned long long pprev = 0ull, pacc = 0ull;
    if (PROBE_MASK != 0ull) pprev = __builtin_amdgcn_s_memrealtime();
    run_layer<0>(args, c, bar, lo, hi, pprev, pacc);
    run_layer<1>(args, c, bar, lo, hi, pprev, pacc);
    if (PROBE_MASK != 0ull) { GRID_BAR(); if (blockIdx.x == 0 && c.tid == 0) args.out[0] += ((float)pacc * 0.01f - PROBE_OFF) * PROBE_SCALE; }
}
#undef IN
#undef SEAM

extern "C" void kernel_launch(void* const* d_in, const int* in_sizes, int n_in, void* d_out, int out_size, void* d_ws, size_t ws_size, hipStream_t stream) {
    static int grid = 0;
    if (grid == 0) {
        if (n_in != 31 || out_size != MTOK * DM || ws_size < WS_END) { fprintf(stderr, "kernel_launch: unexpected shapes (n_in %d, out %d, ws %zu)\n", n_in, out_size, ws_size); grid = -1; return; }
        int dev = 0, cus = 0;
        if (hipGetDevice(&dev) != hipSuccess || hipDeviceGetAttribute(&cus, hipDeviceAttributeMultiprocessorCount, dev) != hipSuccess) { grid = -1; return; }
        if (hipFuncSetAttribute((const void*)fwd, hipFuncAttributeMaxDynamicSharedMemorySize, LDS_BYTES) != hipSuccess) { fprintf(stderr, "kernel_launch: hipFuncSetAttribute failed\n"); grid = -1; return; }
        int per_cu = 0;
        if (hipOccupancyMaxActiveBlocksPerMultiprocessor(&per_cu, (const void*)fwd, NWAVES * 64, LDS_BYTES) != hipSuccess || per_cu < 1) fprintf(stderr, "kernel_launch: occupancy query reports %d\n", per_cu);
        (void)hipGetLastError();
        grid = cus;
    }
    if (grid < 0) return;
    (void)hipMemsetAsync((char*)d_ws + WS_CTL, 0, CTL_ZERO_BYTES, stream);
#ifdef EXTRA_MEMSET
    (void)hipMemsetAsync((char*)d_ws + WS_END, 0, 256, stream);
#endif
    Args a{};
    for (int i = 0; i < 31; ++i) a.in[i] = (const float*)d_in[i];
    a.out = (float*)d_out; a.ws = (unsigned char*)d_ws;
#if MK_ONE_LAUNCH
    a.ph_lo = 0; a.ph_hi = NPH;
    hipLaunchKernelGGL(fwd, dim3(grid), dim3(NWAVES * 64), LDS_BYTES, stream, a);
#else
    for (int ph = 0; ph < NPH; ++ph) {
        if (ph == 3 + NPL || ph == 4 + NPL || ph == 6 || (ph % NPL) == 8 || (ph % NPL) == 10 || (ph % NPL) == 13) continue;
        a.ph_lo = ph; a.ph_hi = ph + 1;
        hipLaunchKernelGGL(fwd, dim3(grid), dim3(NWAVES * 64), LDS_BYTES, stream, a);
    }
#endif
}
```

```cpp
#define MK_ONE_LAUNCH 1
#define RES_BF16 1
#define FUSE_HEADNORM 1
#define EARLY_N1 16
#define EARLY_N2 16
#include <hip/hip_runtime.h>
#include <cstdio>
#include <cstdint>
namespace pg8 {
#define PG8_LAS __attribute__((address_space(3)))
typedef unsigned short bf16_t;
typedef short bf16x8 __attribute__((ext_vector_type(8)));
typedef float f32x4 __attribute__((ext_vector_type(4)));
typedef unsigned u32x4 __attribute__((ext_vector_type(4)));
constexpr int BM = 256, BK = 64, HALF = 128, HTB = HALF * BK * 2  , STAGE_BYTES = 8 * HTB, NXCD = 8, WGM = 8;

__host__ __device__ __forceinline__ int lds_byte(int r, int c) { const int st = (r >> 4) * 2 + (c >> 5), rr = r & 15, cc = c & 31, ob = rr * 64 + cc * 2; return st * 1024 + (ob ^ (((ob >> 9) & 1) << 5)); }
__host__ __device__ __forceinline__ void stage_rc(int b, int& R, int& C) { const int st = b / 1024, sb = b % 1024, swz = sb ^ (((sb >> 9) & 1) << 5); R = (st >> 1) * 16 + swz / 64; C = (st & 1) * 32 + (swz % 64) / 2; }
__host__ __device__ __forceinline__ int perm32(int rho) { const int n = rho >> 4, i = rho & 15; return 8 * (i >> 2) + 4 * n + (i & 3); }

struct Unit { int pm, pn, ks; };
struct Gemm { const bf16_t* A; const bf16_t* Bt; int M, N, K, KL; };

struct StaticOrder {
    int nM, nN, nwg, G, c;
    __host__ __device__ void init(int M, int N, int G_, int c_) { nM = M / BM; nN = N / BM; nwg = nM * nN; G = G_; c = c_; }
    __host__ __device__ bool next(int i, Unit& u) const {
        const long L = (long)i * G + c; if (L >= nwg) return false;
        int wgid = (int)L; { const int q = nwg / NXCD, r = nwg % NXCD, xcd = wgid % NXCD, off = wgid / NXCD; wgid = (xcd < r ? xcd * (q + 1) : r * (q + 1) + (xcd - r) * q) + off; }
        const int nig = WGM * nN, gid = wgid / nig, fm = gid * WGM, gsz = (nM - fm) < WGM ? (nM - fm) : WGM;
        u.pm = fm + ((wgid % nig) % gsz); u.pn = (wgid % nig) / gsz; u.ks = 0; return true;
    }
    __device__ __forceinline__ void a_ready(const Unit&) const {}
    __device__ __forceinline__ void done(const Unit&) const {}
};
struct SplitKOrder {
    int nN, nS, total, G, c;
    __host__ __device__ void init(int M, int N, int nS_, int G_, int c_) { nN = N / BM; nS = nS_; total = (M / BM) * nN * nS; G = G_; c = c_; }
    __host__ __device__ bool next(int i, Unit& u) const { const long L = (long)i * G + c; if (L >= total) return false; const int l = (int)L; u.ks = l % nS; const int r = l / nS; u.pn = r % nN; u.pm = r / nN; return true; }
    __device__ __forceinline__ void a_ready(const Unit&) const {}
    __device__ __forceinline__ void done(const Unit&) const {}
};
struct DiagOrder {
    int bm, bn, total, G, c;
    __host__ __device__ void init(int nblk, int bm_, int bn_, int G_, int c_) { bm = bm_; bn = bn_; total = nblk * bm * bn; G = G_; c = c_; }
    __host__ __device__ bool next(int i, Unit& u) const { const long L = (long)i * G + c; if (L >= total) return false; const int l = (int)L, blk = l / (bm * bn), r = l % (bm * bn); u.pm = blk * bm + r / bn; u.pn = blk * bn + r % bn; u.ks = 0; return true; }
    __device__ __forceinline__ void a_ready(const Unit&) const {}
    __device__ __forceinline__ void done(const Unit&) const {}
};

typedef float f32x2c_t __attribute__((ext_vector_type(2)));
typedef __bf16 bf16x2c_t __attribute__((ext_vector_type(2)));
__device__ __forceinline__ unsigned cvt_pk_bf16(float lo, float hi) { const f32x2c_t v = {lo, hi}; const bf16x2c_t b = __builtin_convertvector(v, bf16x2c_t); return __builtin_bit_cast(unsigned, b); }
typedef float f32x2 __attribute__((ext_vector_type(2)));
__device__ __forceinline__ float row_rstd(const float* ssq, int row) { return ssq ? 1.0f / sqrtf(ssq[row] * (1.0f / 4096.0f) + 1e-6f) : 1.0f; }
struct EpiBf16P {
    static constexpr bool PERM = true, AFTER_DRAIN = false;
    bf16_t* O; int ldc; const float* ssq;
    __device__ __forceinline__ void operator()(const f32x4 (&acc)[2][2][4][2], const Unit& u, int wr, int wc, int fr, int fq) const {
        const int row0 = u.pm * BM + wr * 64 + fr, col0 = u.pn * BM + wc * 32 + 8 * fq;
#pragma unroll
        for (int ai = 0; ai < 2; ++ai)
#pragma unroll
            for (int m = 0; m < 4; ++m) { bf16_t* rowp = O + (size_t)(row0 + ai * HALF + m * 16) * ldc + col0; const float rs = row_rstd(ssq, row0 + ai * HALF + m * 16);
#pragma unroll
                for (int bj = 0; bj < 2; ++bj) { const f32x4 v0 = acc[ai][bj][m][0] * rs, v1 = acc[ai][bj][m][1] * rs;
                    u32x4 w; w.x = cvt_pk_bf16(v0[0], v0[1]); w.y = cvt_pk_bf16(v0[2], v0[3]); w.z = cvt_pk_bf16(v1[0], v1[1]); w.w = cvt_pk_bf16(v1[2], v1[3]);
                    *(u32x4*)(rowp + bj * HALF) = w; } }
    }
};
struct EpiResF32 {
    static constexpr bool PERM = true, AFTER_DRAIN = false;
    const float* base; float* out; int ldc;
    __device__ __forceinline__ void operator()(const f32x4 (&acc)[2][2][4][2], const Unit& u, int wr, int wc, int fr, int fq) const {
        const int row0 = u.pm * BM + wr * 64 + fr, col0 = u.pn * BM + wc * 32 + 8 * fq;
#pragma unroll
        for (int ai = 0; ai < 2; ++ai)
#pragma unroll
            for (int m = 0; m < 4; ++m) { const size_t off = (size_t)(row0 + ai * HALF + m * 16) * ldc + col0;
#pragma unroll
                for (int bj = 0; bj < 2; ++bj) { const f32x4 b0 = *(const f32x4*)(base + off + bj * HALF), b1 = *(const f32x4*)(base + off + bj * HALF + 4);
                    *(f32x4*)(out + off + bj * HALF) = b0 + acc[ai][bj][m][0]; *(f32x4*)(out + off + bj * HALF + 4) = b1 + acc[ai][bj][m][1]; }
                asm volatile("" ::: "memory"); }
    }
};
__device__ __forceinline__ float silu_mul(float g, float u) { return g * __builtin_amdgcn_rcpf(1.0f + __builtin_amdgcn_exp2f(-1.4426950408889634f * g)) * u; }
struct EpiSwiGLU {
    static constexpr bool PERM = true, AFTER_DRAIN = false;
    bf16_t* O; int ldc; const float* ssq;
    __device__ __forceinline__ void operator()(const f32x4 (&acc)[2][2][4][2], const Unit& u, int wr, int wc, int fr, int fq) const {
        const int row0 = u.pm * BM + wr * 64 + fr, col0 = u.pn * HALF + wc * 32 + 8 * fq;
#pragma unroll
        for (int ai = 0; ai < 2; ++ai)
#pragma unroll
            for (int m = 0; m < 4; ++m) { bf16_t* rowp = O + (size_t)(row0 + ai * HALF + m * 16) * ldc + col0; const float rs = row_rstd(ssq, row0 + ai * HALF + m * 16);
                const f32x4 g0 = acc[ai][0][m][0] * rs, g1 = acc[ai][0][m][1] * rs, u0 = acc[ai][1][m][0] * rs, u1 = acc[ai][1][m][1] * rs;
                u32x4 w; w.x = cvt_pk_bf16(silu_mul(g0[0], u0[0]), silu_mul(g0[1], u0[1])); w.y = cvt_pk_bf16(silu_mul(g0[2], u0[2]), silu_mul(g0[3], u0[3]));
                w.z = cvt_pk_bf16(silu_mul(g1[0], u1[0]), silu_mul(g1[1], u1[1])); w.w = cvt_pk_bf16(silu_mul(g1[2], u1[2]), silu_mul(g1[3], u1[3]));
                *(u32x4*)rowp = w; }
    }
};
struct EpiF32Part {
    static constexpr bool PERM = false, AFTER_DRAIN = false;
    float* P; int ldc; size_t part_stride;
    __device__ __forceinline__ void operator()(const f32x4 (&acc)[2][2][4][2], const Unit& u, int wr, int wc, int fr, int fq) const {
        const int row0 = u.pm * BM + wr * 64 + fr, col0 = u.pn * BM + wc * 32 + 4 * fq; float* base = P + (size_t)u.ks * part_stride;
#pragma unroll
        for (int ai = 0; ai < 2; ++ai)
#pragma unroll
            for (int m = 0; m < 4; ++m) { const size_t off = (size_t)(row0 + ai * HALF + m * 16) * ldc + col0;
#pragma unroll
                for (int bj = 0; bj < 2; ++bj)
#pragma unroll
                    for (int n = 0; n < 2; ++n) *(f32x4*)(base + off + bj * HALF + n * 16) = acc[ai][bj][m][n]; }
    }
};
struct EpiResF32N {
    static constexpr bool PERM = true, AFTER_DRAIN = false;
    const float* base; float* out; int ldc; bf16_t* xb; float* ssq;
    __device__ __forceinline__ void operator()(const f32x4 (&acc)[2][2][4][2], const Unit& u, int wr, int wc, int fr, int fq) const {
        const int row0 = u.pm * BM + wr * 64 + fr, col0 = u.pn * BM + wc * 32 + 8 * fq;
#pragma unroll
        for (int ai = 0; ai < 2; ++ai)
#pragma unroll
            for (int m = 0; m < 4; ++m) { const int row = row0 + ai * HALF + m * 16; const size_t off = (size_t)row * ldc + col0; float sq = 0.f;
#pragma unroll
                for (int bj = 0; bj < 2; ++bj) {
                    const f32x4 v0 = *(const f32x4*)(base + off + bj * HALF) + acc[ai][bj][m][0], v1 = *(const f32x4*)(base + off + bj * HALF + 4) + acc[ai][bj][m][1];
                    *(f32x4*)(out + off + bj * HALF) = v0; *(f32x4*)(out + off + bj * HALF + 4) = v1;
                    sq += ((v0[0] * v0[0] + v0[1] * v0[1]) + (v0[2] * v0[2] + v0[3] * v0[3])) + ((v1[0] * v1[0] + v1[1] * v1[1]) + (v1[2] * v1[2] + v1[3] * v1[3]));
                    u32x4 w; w.x = cvt_pk_bf16(v0[0], v0[1]); w.y = cvt_pk_bf16(v0[2], v0[3]); w.z = cvt_pk_bf16(v1[0], v1[1]); w.w = cvt_pk_bf16(v1[2], v1[3]); *(u32x4*)(xb + off + bj * HALF) = w; }
                sq += __shfl_xor(sq, 16); sq += __shfl_xor(sq, 32);
                if (fq == 0) atomicAdd(ssq + row, sq);
                asm volatile("" ::: "memory"); }
    }
};
template <class TB> struct EpiResBf16N {
    static constexpr bool PERM = true, AFTER_DRAIN = false;
    const TB* base; int ldc; bf16_t* xb; float* ssq;
    __device__ __forceinline__ void operator()(const f32x4 (&acc)[2][2][4][2], const Unit& u, int wr, int wc, int fr, int fq) const {
        const int row0 = u.pm * BM + wr * 64 + fr, col0 = u.pn * BM + wc * 32 + 8 * fq;
#pragma unroll
        for (int ai = 0; ai < 2; ++ai)
#pragma unroll
            for (int m = 0; m < 4; ++m) { const int row = row0 + ai * HALF + m * 16; const size_t off = (size_t)row * ldc + col0; float sq = 0.f;
#pragma unroll
                for (int bj = 0; bj < 2; ++bj) { f32x4 v0, v1;
                    if constexpr (sizeof(TB) == 4) { v0 = *(const f32x4*)((const float*)base + off + bj * HALF); v1 = *(const f32x4*)((const float*)base + off + bj * HALF + 4); }
                    else { const u32x4 b = *(const u32x4*)((const bf16_t*)base + off + bj * HALF);
                        v0 = (f32x4){__builtin_bit_cast(float, b.x << 16), __builtin_bit_cast(float, b.x & 0xffff0000u), __builtin_bit_cast(float, b.y << 16), __builtin_bit_cast(float, b.y & 0xffff0000u)};
                        v1 = (f32x4){__builtin_bit_cast(float, b.z << 16), __builtin_bit_cast(float, b.z & 0xffff0000u), __builtin_bit_cast(float, b.w << 16), __builtin_bit_cast(float, b.w & 0xffff0000u)}; }
                    v0 += acc[ai][bj][m][0]; v1 += acc[ai][bj][m][1];
                    u32x4 w; w.x = cvt_pk_bf16(v0[0], v0[1]); w.y = cvt_pk_bf16(v0[2], v0[3]); w.z = cvt_pk_bf16(v1[0], v1[1]); w.w = cvt_pk_bf16(v1[2], v1[3]); *(u32x4*)(xb + off + bj * HALF) = w;
                    const float r0 = __builtin_bit_cast(float, w.x << 16), r1 = __builtin_bit_cast(float, w.x & 0xffff0000u), r2 = __builtin_bit_cast(float, w.y << 16), r3 = __builtin_bit_cast(float, w.y & 0xffff0000u);
                    const float r4 = __builtin_bit_cast(float, w.z << 16), r5 = __builtin_bit_cast(float, w.z & 0xffff0000u), r6 = __builtin_bit_cast(float, w.w << 16), r7 = __builtin_bit_cast(float, w.w & 0xffff0000u);
                    sq += ((r0 * r0 + r1 * r1) + (r2 * r2 + r3 * r3)) + ((r4 * r4 + r5 * r5) + (r6 * r6 + r7 * r7)); }
                sq += __shfl_xor(sq, 16); sq += __shfl_xor(sq, 32);
                if (fq == 0) atomicAdd(ssq + row, sq);
                asm volatile("" ::: "memory"); }
    }
};
struct EpiOutBf16Res {
    static constexpr bool PERM = true, AFTER_DRAIN = false;
    const bf16_t* base; float* out; int ldc;
    __device__ __forceinline__ void operator()(const f32x4 (&acc)[2][2][4][2], const Unit& u, int wr, int wc, int fr, int fq) const {
        const int row0 = u.pm * BM + wr * 64 + fr, col0 = u.pn * BM + wc * 32 + 8 * fq;
#pragma unroll
        for (int ai = 0; ai < 2; ++ai)
#pragma unroll
            for (int m = 0; m < 4; ++m) { const size_t off = (size_t)(row0 + ai * HALF + m * 16) * ldc + col0;
#pragma unroll
                for (int bj = 0; bj < 2; ++bj) { const u32x4 b = *(const u32x4*)(base + off + bj * HALF);
                    const f32x4 v0 = (f32x4){__builtin_bit_cast(float, b.x << 16), __builtin_bit_cast(float, b.x & 0xffff0000u), __builtin_bit_cast(float, b.y << 16), __builtin_bit_cast(float, b.y & 0xffff0000u)};
                    const f32x4 v1 = (f32x4){__builtin_bit_cast(float, b.z << 16), __builtin_bit_cast(float, b.z & 0xffff0000u), __builtin_bit_cast(float, b.w << 16), __builtin_bit_cast(float, b.w & 0xffff0000u)};
                    *(f32x4*)(out + off + bj * HALF) = v0 + acc[ai][bj][m][0]; *(f32x4*)(out + off + bj * HALF + 4) = v1 + acc[ai][bj][m][1]; }
                asm volatile("" ::: "memory"); }
    }
};
struct HeadSpec { int lo[5], hi[5]; const float* g[5]; };
struct EpiYHeads {
    static constexpr bool PERM = true, AFTER_DRAIN = false;
    bf16_t* O; int ldc; const float* ssq; HeadSpec hs; const float* ct; const float* st; PG8_LAS float* tab;
    __device__ __forceinline__ void operator()(const f32x4 (&acc)[2][2][4][2], const Unit& u, int wr, int wc, int fr, int fq) const {
        const float* gain = nullptr;
#pragma unroll
        for (int k = 0; k < 5; ++k) if (u.pn >= hs.lo[k] && u.pn < hs.hi[k]) gain = hs.g[k];
        const int row0 = u.pm * BM + wr * 64 + fr;
        if (gain == nullptr) {
            const int col0 = u.pn * BM + wc * 32 + 8 * fq;
#pragma unroll
            for (int ai = 0; ai < 2; ++ai)
#pragma unroll
                for (int m = 0; m < 4; ++m) { bf16_t* rowp = O + (size_t)(row0 + ai * HALF + m * 16) * ldc + col0; const float rs = row_rstd(ssq, row0 + ai * HALF + m * 16);
#pragma unroll
                    for (int bj = 0; bj < 2; ++bj) { const f32x4 v0 = acc[ai][bj][m][0] * rs, v1 = acc[ai][bj][m][1] * rs;
                        u32x4 w; w.x = cvt_pk_bf16(v0[0], v0[1]); w.y = cvt_pk_bf16(v0[2], v0[3]); w.z = cvt_pk_bf16(v1[0], v1[1]); w.w = cvt_pk_bf16(v1[2], v1[3]);
                        *(u32x4*)(rowp + bj * HALF) = w; } }
            return;
        }
        const int lr0 = wr * 64 + fr;
#pragma unroll
        for (int ai = 0; ai < 2; ++ai)
#pragma unroll
            for (int m = 0; m < 4; ++m) { const float rs = row_rstd(ssq, row0 + ai * HALF + m * 16); float sq = 0.f;
#pragma unroll
                for (int bj = 0; bj < 2; ++bj)
#pragma unroll
                    for (int n = 0; n < 2; ++n) { const f32x4 v = acc[ai][bj][m][n] * rs; sq += (v[0] * v[0] + v[1] * v[1]) + (v[2] * v[2] + v[3] * v[3]); }
                sq += __shfl_xor(sq, 16); sq += __shfl_xor(sq, 32);
                if (fq == 0) tab[(ai * HALF + lr0 + m * 16) * 4 + wc] = sq; }
        asm volatile("s_waitcnt lgkmcnt(0)" ::: "memory"); __builtin_amdgcn_s_barrier(); asm volatile("" ::: "memory");
        const int dlo = 32 * (wc & 1) + 8 * fq, head = wc >> 1;
        const f32x4 ga0 = *(const f32x4*)(gain + dlo), ga1 = *(const f32x4*)(gain + dlo + 4), gb0 = *(const f32x4*)(gain + 64 + dlo), gb1 = *(const f32x4*)(gain + 64 + dlo + 4);
#pragma unroll
        for (int ai = 0; ai < 2; ++ai)
#pragma unroll
            for (int m = 0; m < 4; ++m) { const int row = row0 + ai * HALF + m * 16;
                const float own = tab[(ai * HALF + lr0 + m * 16) * 4 + wc], other = tab[(ai * HALF + lr0 + m * 16) * 4 + (wc ^ 1)];
                const float sc = row_rstd(ssq, row) / sqrtf(((wc & 1) ? other + own : own + other) * (1.0f / 128.0f) + 1e-6f);
                const f32x4 c0 = *(const f32x4*)(ct + (size_t)row * 64 + dlo), c1 = *(const f32x4*)(ct + (size_t)row * 64 + dlo + 4), s0 = *(const f32x4*)(st + (size_t)row * 64 + dlo), s1 = *(const f32x4*)(st + (size_t)row * 64 + dlo + 4);
                const f32x4 a0 = acc[ai][0][m][0] * sc * ga0, a1 = acc[ai][0][m][1] * sc * ga1, b0 = acc[ai][1][m][0] * sc * gb0, b1 = acc[ai][1][m][1] * sc * gb1;
                const f32x4 y10 = a0 * c0 - b0 * s0, y11 = a1 * c1 - b1 * s1, y20 = a0 * s0 + b0 * c0, y21 = a1 * s1 + b1 * c1;
                bf16_t* rowp = O + (size_t)row * ldc + u.pn * BM + head * 128 + dlo;
                u32x4 w; w.x = cvt_pk_bf16(y10[0], y10[1]); w.y = cvt_pk_bf16(y10[2], y10[3]); w.z = cvt_pk_bf16(y11[0], y11[1]); w.w = cvt_pk_bf16(y11[2], y11[3]); *(u32x4*)rowp = w;
                u32x4 w2; w2.x = cvt_pk_bf16(y20[0], y20[1]); w2.y = cvt_pk_bf16(y20[2], y20[3]); w2.z = cvt_pk_bf16(y21[0], y21[1]); w2.w = cvt_pk_bf16(y21[2], y21[3]); *(u32x4*)(rowp + 64) = w2;
                asm volatile("" ::: "memory"); }
    }
};
template <class Epi, class Sched, bool ALIGN_EPI = false, bool SP2 = false>
__device__ __forceinline__ void gemm_phase(PG8_LAS unsigned char* lds, const Gemm g, const Sched& S, const Epi& E) {
    const int tid = threadIdx.x, wid = __builtin_amdgcn_readfirstlane(tid >> 6), lane = tid & 63, wr = wid >> 2, wc = wid & 3, fr = lane & 15, fq = lane >> 4;
    const int K = g.K, nt = g.KL / BK;
    unsigned voffA[2], voffB[2];
#pragma unroll
    for (int i = 0; i < 2; ++i) { int R, C; stage_rc(tid * 16 + i * 8192, R, C); const int Rb = Epi::PERM ? ((R & ~31) + perm32(R & 31)) : R;
        voffA[i] = (unsigned)(R * K + C) * 2u; voffB[i] = (unsigned)(Rb * K + C) * 2u; }
    const size_t kstep = (size_t)(BK * 2);
    const size_t hstep = (size_t)HALF * K * 2;
    const size_t tstep = 2 * hstep;
    const unsigned ldsw = (unsigned)wid * 1024u;
    const int aoff = lds_byte(wr * 64 + fr, fq * 8), boff = lds_byte(wc * 32 + fr, fq * 8);
#define PG8_SA(b, h) (((b) * 2 + (h)) * HTB)
#define PG8_SB(b, h) ((4 + (b) * 2 + (h)) * HTB)
#define PG8_STAGE(bufoff, gbase, voff) do { _Pragma("unroll") for (int _i = 0; _i < 2; ++_i) \
        __builtin_amdgcn_global_load_lds((const unsigned*)((const char*)(gbase) + (voff)[_i]), (PG8_LAS unsigned*)(lds + (bufoff) + ldsw + _i * 8192), 16, 0, 0); } while (0)
#define PG8_LDA(dst, b, h) do { _Pragma("unroll") for (int m = 0; m < 4; ++m) _Pragma("unroll") for (int k = 0; k < 2; ++k) dst[m][k] = *(const PG8_LAS bf16x8*)(lds + PG8_SA(b, h) + aoff + m * 2048 + k * 1024); } while (0)
#define PG8_LDB(dst, b, h) do { _Pragma("unroll") for (int n = 0; n < 2; ++n) _Pragma("unroll") for (int k = 0; k < 2; ++k) dst[n][k] = *(const PG8_LAS bf16x8*)(lds + PG8_SB(b, h) + boff + n * 2048 + k * 1024); } while (0)
#define PG8_MMA(ai, bj, At, Bt) do { __builtin_amdgcn_s_setprio(1); _Pragma("unroll") for (int m = 0; m < 4; ++m) _Pragma("unroll") for (int n = 0; n < 2; ++n) _Pragma("unroll") for (int k = 0; k < 2; ++k) \
        acc[ai][bj][m][n] = __builtin_amdgcn_mfma_f32_16x16x32_bf16(Bt[n][k], At[m][k], acc[ai][bj][m][n], 0, 0, 0); __builtin_amdgcn_s_setprio(0); } while (0)
#define PG8_WAIT_V(n) asm volatile("s_waitcnt vmcnt(" #n ")" ::: "memory")
#define PG8_WAIT_L(n) asm volatile("s_waitcnt lgkmcnt(" #n ")" ::: "memory")
#define PG8_BAR __builtin_amdgcn_s_barrier()
#define PG8_SCHED __builtin_amdgcn_sched_barrier(0)
    Unit cur, nxt; int ui = 0;
    if (!S.next(0, cur)) return;
    f32x4 acc[2][2][4][2];
#pragma unroll
    for (int a = 0; a < 2; ++a)
#pragma unroll
        for (int b = 0; b < 2; ++b)
#pragma unroll
            for (int m = 0; m < 4; ++m)
#pragma unroll
                for (int n = 0; n < 2; ++n) acc[a][b][m][n] = (f32x4){0.f, 0.f, 0.f, 0.f};
    bf16x8 At[4][2], B0[2][2], B1[2][2];
    const size_t ksb = (size_t)g.KL * 2;
    const char* cA = (const char*)g.A + (size_t)cur.pm * tstep + (size_t)cur.ks * ksb; const char* cB = (const char*)g.Bt + (size_t)cur.pn * tstep + (size_t)cur.ks * ksb;
    S.a_ready(cur);
    if constexpr (SP2) {
        PG8_STAGE(PG8_SB(0, 0), cB, voffB); PG8_STAGE(PG8_SB(0, 1), cB + hstep, voffB); PG8_STAGE(PG8_SA(0, 0), cA, voffA); PG8_STAGE(PG8_SA(0, 1), cA + hstep, voffA);
        if (wr == 1) PG8_BAR;
        PG8_WAIT_V(2); PG8_BAR;
        PG8_STAGE(PG8_SB(1, 0), cB + kstep, voffB); PG8_STAGE(PG8_SA(1, 0), cA + kstep, voffA); PG8_STAGE(PG8_SB(1, 1), cB + hstep + kstep, voffB);
        PG8_WAIT_V(6); PG8_BAR;
    } else {
        PG8_STAGE(PG8_SB(0, 0), cB, voffB); PG8_STAGE(PG8_SA(0, 0), cA, voffA); PG8_STAGE(PG8_SB(0, 1), cB + hstep, voffB); PG8_STAGE(PG8_SA(0, 1), cA + hstep, voffA);
        if (wr == 1) PG8_BAR;
        PG8_WAIT_V(4); PG8_BAR;
        PG8_STAGE(PG8_SB(1, 0), cB + kstep, voffB); PG8_STAGE(PG8_SA(1, 0), cA + kstep, voffA); PG8_STAGE(PG8_SB(1, 1), cB + hstep + kstep, voffB);
        PG8_WAIT_V(6); PG8_BAR;
    }
    for (;;) {
        const bool has_next = S.next(ui + 1, nxt);
        const char* nA = has_next ? (const char*)g.A + (size_t)nxt.pm * tstep + (size_t)nxt.ks * ksb : cA; const char* nB = has_next ? (const char*)g.Bt + (size_t)nxt.pn * tstep + (size_t)nxt.ks * ksb : cB;
        for (int t = 0; t < nt; t += 2) {
            const bool last = (t == nt - 2);
            const char* a1 = cA + (size_t)(t + 1) * kstep;
            const char* a2 = last ? nA : cA + (size_t)(t + 2) * kstep; const char* b2 = last ? nB : cB + (size_t)(t + 2) * kstep;
            const char* a3 = a2 + kstep; const char* b3 = b2 + kstep;
            if (last && has_next) S.a_ready(nxt);
            if constexpr (SP2) {
            PG8_LDB(B0, 0, 0); PG8_LDB(B1, 0, 1); PG8_SCHED; PG8_LDA(At, 0, 0); PG8_STAGE(PG8_SA(1, 1), a1 + hstep, voffA);
            PG8_WAIT_V(8); PG8_WAIT_L(0); PG8_BAR; PG8_MMA(0, 0, At, B0); PG8_MMA(0, 1, At, B1); PG8_BAR; PG8_SCHED;
            PG8_LDA(At, 0, 1); PG8_STAGE(PG8_SB(0, 0), b2, voffB); PG8_STAGE(PG8_SB(0, 1), b2 + hstep, voffB); PG8_STAGE(PG8_SA(0, 0), a2, voffA);
            PG8_WAIT_V(8); PG8_WAIT_L(0); PG8_BAR; PG8_MMA(1, 0, At, B0); PG8_MMA(1, 1, At, B1); PG8_BAR; PG8_SCHED;
            PG8_LDB(B0, 1, 0); PG8_LDB(B1, 1, 1); PG8_SCHED; PG8_LDA(At, 1, 0); PG8_STAGE(PG8_SA(0, 1), a2 + hstep, voffA);
            PG8_WAIT_V(8); PG8_WAIT_L(0); PG8_BAR; PG8_MMA(0, 0, At, B0); PG8_MMA(0, 1, At, B1); PG8_BAR; PG8_SCHED;
            PG8_LDA(At, 1, 1); PG8_STAGE(PG8_SB(1, 0), b3, voffB); PG8_STAGE(PG8_SB(1, 1), b3 + hstep, voffB); PG8_STAGE(PG8_SA(1, 0), a3, voffA);
            PG8_WAIT_V(8); PG8_WAIT_L(0); PG8_BAR; PG8_MMA(1, 0, At, B0); PG8_MMA(1, 1, At, B1); PG8_BAR; PG8_SCHED;
            } else {
            PG8_LDB(B0, 0, 0); PG8_SCHED; PG8_LDA(At, 0, 0); PG8_STAGE(PG8_SA(1, 1), a1 + hstep, voffA);
            PG8_WAIT_L(8); PG8_BAR; PG8_WAIT_L(0); PG8_MMA(0, 0, At, B0); PG8_BAR; PG8_SCHED;
            PG8_LDB(B1, 0, 1); PG8_STAGE(PG8_SB(0, 0), b2, voffB);
            PG8_BAR; PG8_WAIT_L(0); PG8_MMA(0, 1, At, B1); PG8_BAR;
            PG8_LDA(At, 0, 1); PG8_STAGE(PG8_SA(0, 0), a2, voffA);
            PG8_BAR; PG8_WAIT_L(0); PG8_MMA(1, 0, At, B0); PG8_BAR; PG8_SCHED;
            PG8_STAGE(PG8_SB(0, 1), b2 + hstep, voffB);
            PG8_WAIT_V(6); PG8_BAR; PG8_MMA(1, 1, At, B1); PG8_BAR;
            PG8_LDB(B0, 1, 0); PG8_SCHED; PG8_LDA(At, 1, 0); PG8_STAGE(PG8_SA(0, 1), a2 + hstep, voffA);
            PG8_WAIT_L(8); PG8_BAR; PG8_WAIT_L(0); PG8_MMA(0, 0, At, B0); PG8_BAR; PG8_SCHED;
            PG8_LDB(B1, 1, 1); PG8_STAGE(PG8_SB(1, 0), b3, voffB);
            PG8_BAR; PG8_WAIT_L(0); PG8_MMA(0, 1, At, B1); PG8_BAR;
            PG8_LDA(At, 1, 1); PG8_STAGE(PG8_SA(1, 0), a3, voffA);
            PG8_BAR; PG8_WAIT_L(0); PG8_MMA(1, 0, At, B0); PG8_BAR; PG8_SCHED;
            PG8_STAGE(PG8_SB(1, 1), b3 + hstep, voffB);
            PG8_WAIT_V(6); PG8_BAR; PG8_MMA(1, 1, At, B1); PG8_BAR;
            }
        }
        if constexpr (ALIGN_EPI) { if (wr == 0) PG8_BAR; }
        if constexpr (!Epi::AFTER_DRAIN) { E(acc, cur, wr, wc, fr, fq); S.done(cur); }
        if (!has_next) break;
#pragma unroll
        for (int a = 0; a < 2; ++a)
#pragma unroll
            for (int b = 0; b < 2; ++b)
#pragma unroll
                for (int m = 0; m < 4; ++m)
#pragma unroll
                    for (int n = 0; n < 2; ++n) acc[a][b][m][n] = (f32x4){0.f, 0.f, 0.f, 0.f};
        cur = nxt; cA = nA; cB = nB; ++ui;
        if constexpr (ALIGN_EPI) { if (wr == 1) PG8_BAR; }
    }
    PG8_WAIT_V(0);
    if constexpr (!ALIGN_EPI) { if (wr == 0) PG8_BAR; }
    PG8_BAR;
    if constexpr (Epi::AFTER_DRAIN) { E.fused(acc, cur, wr, wc, fr, fq, lds, wid, lane); S.done(cur); }
#undef PG8_SA
#undef PG8_SB
#undef PG8_STAGE
#undef PG8_LDA
#undef PG8_LDB
#undef PG8_MMA
#undef PG8_WAIT_V
#undef PG8_WAIT_L
#undef PG8_BAR
#undef PG8_SCHED
}
}
#define GAS __attribute__((address_space(1)))
#define LAS __attribute__((address_space(3)))
typedef unsigned short bf16;
typedef unsigned v4u __attribute__((ext_vector_type(4)));
typedef float f32x4 __attribute__((ext_vector_type(4)));
constexpr int NB = 4, T = 2048, DM = 4096, MTOK = NB * T, HD = 128;
constexpr int EVEN_N = 11312, EVEN_LD = 11520, ODD_LD = 18432, FFN = 11008, GU_ROWS = 2 * FFN;
constexpr int MEM_LEN = 256, MEM_ROWS = NB * MEM_LEN, XW = 512;
constexpr float NORM_EPS = 1e-6f;
constexpr float ATT_SCALE = 0.08838834764831845f;
#define NEG_INF (-__builtin_inff())
constexpr int C_MQ = 0, C_MK = 2048, C_MV = 4096, C_NQ = 6144, C_KC = 8192, C_VC = 8704, C_KS = 9216, C_VS = 9728, C_KW = 10240, C_VW = 10752, C_GL = 11264;
constexpr int C_SQ = 0, C_SK = 3072, C_SV = 6144, C_DQ = 9216, C_DK = 12288, C_DV = 15360;
constexpr size_t MiB = 1u << 20;
constexpr size_t WS_CTL = 0, CTL_ZERO_BYTES = 256 * 1024;
constexpr size_t WS_ROPE = 1 * MiB;
constexpr size_t WS_KMEAN = 5 * MiB;
constexpr size_t WS_KCR = 6 * MiB, WS_VCR = 7 * MiB;
constexpr size_t WS_KCN = 8 * MiB, WS_VCN = 9 * MiB;
constexpr size_t WS_MEMN = 10 * MiB;
constexpr size_t WS_QX = 18 * MiB;
constexpr size_t WS_KVX = 26 * MiB;
constexpr size_t WS_OX = 28 * MiB;
constexpr size_t WS_WQ = 36 * MiB, WS_WKV = 40 * MiB, WS_WO = 48 * MiB, WS_WOUT = 52 * MiB, WS_WIN = 84 * MiB, WS_WGU = 228 * MiB, WS_WD = 400 * MiB;
constexpr size_t WS_X = 486 * MiB;
constexpr size_t WS_H = 614 * MiB;
constexpr size_t WS_O = 678 * MiB;
constexpr size_t WS_Y = 742 * MiB;
constexpr size_t WS_VT = 1030 * MiB;
constexpr size_t WS_PART = 1126 * MiB;
constexpr size_t WS_LSE = 1222 * MiB;
constexpr size_t WS_VTX = 1223 * MiB;
constexpr size_t WS_SELM = 5 * MiB + 256 * 1024, WS_SELN = 5 * MiB + 768 * 1024;
constexpr size_t WS_PHIK = 1224 * MiB, WS_PHIV = 1225 * MiB;
constexpr size_t WS_CBIAS = 5 * MiB + 896 * 1024;
constexpr size_t WS_QP = 1226 * MiB;
constexpr size_t WS_MEMN2 = 1290 * MiB;
constexpr size_t WS_KVX2 = 1306 * MiB;
constexpr size_t WS_WKV2 = 1314 * MiB;
constexpr size_t WS_WD1 = 1330 * MiB;
constexpr size_t WS_WIN1 = 1416 * MiB;
constexpr size_t WS_END = 1560 * MiB;
#ifndef EARLY_N1
#define EARLY_N1 20
#endif
#ifndef EARLY_N2
#define EARLY_N2 20
#endif
#ifndef EARLY_NT
#define EARLY_NT 1
#endif
constexpr int CW_BAR = 4096;
constexpr int CW_TICKET = 8256;
constexpr int CW_SSQ = 16384;
constexpr int RING_BYTES = 131072, LDSCTL_OFF = RING_BYTES, MISC_OFF = LDSCTL_OFF + 320, LDS_BYTES = 147456;
constexpr int NWAVES = 8;
#ifndef MK_ONE_LAUNCH
#define MK_ONE_LAUNCH 0
#endif
constexpr int NPL = 16, NPH = 2 * NPL;
#ifndef DUP_PHASE
#define DUP_PHASE (-1)
#endif
#ifndef DUP_N
#define DUP_N 2
#endif
#define REPS(k) for (int rep_ = 0; rep_ < ((DUP_PHASE == (k)) ? DUP_N : 1); ++rep_)
#ifndef PROBE_MASK
#define PROBE_MASK 0ull
#endif
#ifndef PROBE_SCALE
#define PROBE_SCALE 1e-3f
#endif
#ifndef PROBE_OFF
#define PROBE_OFF 0.f
#endif
#ifndef FUSE_HEADNORM
#define FUSE_HEADNORM 0
#endif
#ifndef RES_BF16
#define RES_BF16 0
#endif
#ifndef FA_EVEN
#define FA_EVEN 1
#endif
#ifndef FA_ODD
#define FA_ODD 1
#endif
#ifndef FA_SB
#define FA_SB 1
#endif
#ifndef FA_DIL
#define FA_DIL 1
#endif
#ifndef FA_XATTN
#define FA_XATTN 1
#endif

__device__ __forceinline__ unsigned f2bf(float f) { unsigned u = __builtin_bit_cast(unsigned, f); return (u + 0x7fffu + ((u >> 16) & 1u)) >> 16; }
__device__ __forceinline__ unsigned pk2(float lo, float hi) { return f2bf(lo) | (f2bf(hi) << 16); }
__device__ __forceinline__ float bflo(unsigned w) { return __builtin_bit_cast(float, w << 16); }
__device__ __forceinline__ float bfhi(unsigned w) { return __builtin_bit_cast(float, w & 0xffff0000u); }
__device__ __forceinline__ float bf2f(bf16 b) { return __builtin_bit_cast(float, ((unsigned)b) << 16); }
__device__ __forceinline__ float wsum(float v) {
#pragma unroll
    for (int o = 1; o < 64; o <<= 1) v += __shfl_xor(v, o);
    return v; }
__device__ __forceinline__ float wmax(float v) {
#pragma unroll
    for (int o = 1; o < 64; o <<= 1) v = fmaxf(v, __shfl_xor(v, o));
    return v; }
__device__ __forceinline__ float rdlane(float v, int j) { return __builtin_bit_cast(float, __builtin_amdgcn_readlane(__builtin_bit_cast(int, v), j)); }
#define LDS_FENCE() do { asm volatile("s_waitcnt lgkmcnt(0)" ::: "memory"); __builtin_amdgcn_wave_barrier(); } while (0)

#define XB_TMO      128
#define XB_XCNT(j)  (256  + 64 * (j))
#define XB_XSUB(j)  (1280 + 64 * (j))
#define XB_XGEN(j)  (2304 + 64 * (j))
#define XB_TOP      3328
#define XB_TOPGEN   3392
#define XCD_BAR_WORDS 3456
#define XB_SPIN_CAP (1u << 18)

__device__ __forceinline__ unsigned xb_ld(unsigned* p)              { return __hip_atomic_load(p, __ATOMIC_RELAXED, __HIP_MEMORY_SCOPE_AGENT); }
__device__ __forceinline__ unsigned xb_add(unsigned* p, unsigned v) { return __hip_atomic_fetch_add(p, v, __ATOMIC_RELAXED, __HIP_MEMORY_SCOPE_AGENT); }
__device__ __forceinline__ unsigned xb_xcc_id() { return (unsigned)__builtin_amdgcn_s_getreg((3 << 11) | 20) & 0xFu; }
#define XB_SPIN(cond, bar) do { unsigned _sp = 0; while (cond) { __builtin_amdgcn_s_sleep(1); \
    if ((++_sp & 255u) == 0u) { if (xb_ld(&(bar)[XB_TMO])) break; if (_sp > XB_SPIN_CAP) { atomicAdd(&(bar)[XB_TMO], 1u); break; } } } } while (0)

struct XcdBarrier {
    unsigned* bar; unsigned x;
    volatile LAS unsigned* st;
};

__device__ __forceinline__ XcdBarrier xcd_barrier_post(unsigned* bar, volatile LAS unsigned* st) {
    XcdBarrier b; b.bar = bar; b.x = xb_xcc_id(); b.st = st;
    if (threadIdx.x == 0) (void)xb_add(&bar[XB_XCNT(b.x)], 1u);
    return b;
}
__device__ __forceinline__ void xcd_barrier_complete(unsigned* bar, unsigned x, unsigned& nloc, unsigned& nx) {
    const unsigned G = gridDim.x * gridDim.y * gridDim.z;
    unsigned sum, cnt, mine, sp = 0u;
    for (;;) {
        sum = 0u; cnt = 0u; mine = 0u;
#pragma unroll
        for (unsigned j = 0; j < 16; ++j) { const unsigned c = xb_ld(&bar[XB_XCNT(j)]); sum += c; cnt += (c > 0u) ? 1u : 0u; mine = (j == x) ? c : mine; }
        if (sum == G) break;
        __builtin_amdgcn_s_sleep(1);
        if ((++sp & 255u) == 0u) { if (xb_ld(&bar[XB_TMO])) break; if (sp > XB_SPIN_CAP) { atomicAdd(&bar[XB_TMO], 1u); break; } }
    }
    nloc = mine > 0u ? mine : 1u; nx = cnt > 0u ? cnt : 1u;
}

__device__ __forceinline__ void xcd_barrier(const XcdBarrier& b) {
    asm volatile("s_waitcnt vmcnt(0)" ::: "memory");
    __syncthreads();
    if (threadIdx.x == 0) {
        unsigned* bar = b.bar;
        __builtin_amdgcn_s_waitcnt(0);
        unsigned nloc = b.st[0], nx = b.st[1];
        if (nloc == 0u) { xcd_barrier_complete(bar, b.x, nloc, nx); b.st[0] = nloc; b.st[1] = nx; }
        const unsigned old = xb_add(&bar[XB_XSUB(b.x)], 1u);
        const unsigned gen = old / nloc;
        if (old + 1u == (gen + 1u) * nloc) {
            __builtin_amdgcn_fence(__ATOMIC_RELEASE, "agent");
            asm volatile("s_waitcnt vmcnt(0)" ::: "memory");
            const unsigned og = xb_add(&bar[XB_TOP], 1u);
            const unsigned tg = og / nx;
            if (og + 1u == (tg + 1u) * nx) xb_add(&bar[XB_TOPGEN], 1u);
            else XB_SPIN(xb_ld(&bar[XB_TOPGEN]) == tg, bar);
            __builtin_amdgcn_fence(__ATOMIC_ACQUIRE, "agent");
            xb_add(&bar[XB_XGEN(b.x)], 1u);
            asm volatile("s_waitcnt vmcnt(0)" ::: "memory");
        } else {
            XB_SPIN(xb_ld(&bar[XB_XGEN(b.x)]) == gen, bar);
            __builtin_amdgcn_fence(__ATOMIC_ACQUIRE, "agent");
            asm volatile("s_waitcnt vmcnt(0)" ::: "memory");
        }
    }
    __syncthreads();
}


struct Ctx { LAS unsigned char* lds; int tid, lane, wave, gw, ngw, G; };

struct RmId { int off; __device__ __forceinline__ int operator()(int n) const { return off + n; } };
struct RmHeads { unsigned long long m0, m1;
    __device__ __forceinline__ int operator()(int n) const { const int t = n >> 8; const bool hd = t < 64 ? ((m0 >> t) & 1ull) : ((m1 >> (t - 64)) & 1ull); if (!hd) return n;
        const int r = n & 255, hb = r >> 7, d = r & 127; return (n & ~255) + ((d >> 6) << 7) + hb * 64 + (d & 63); } };
struct RmGU { int up; __device__ __forceinline__ int operator()(int n) const { return (n >> 7) * 256 + up * 128 + (n & 127); } };
template <class RM, bool NT = false>
__device__ __forceinline__ void conv_weight(const Ctx& c, const float* W, int K, int N, int Npad, bf16* WT, RM rm, const float* kgain = nullptr, int it0 = 0, int it1 = -1, int gw = -1, int ngw = -1, unsigned* ticket = nullptr) {
    LAS float* scr = (LAS float*)(c.lds + c.wave * 16384);
    const int nblk = Npad / 32, items = it1 < 0 ? (K / 64) * nblk : it1, lane = c.lane; if (gw < 0) { gw = c.gw; ngw = c.ngw; }
    const int c4 = lane & 7, ch = lane & 7;
    auto body = [&](int it) __attribute__((always_inline)) {
        const int kb = it / nblk, nb = it - kb * nblk, k0 = 64 * kb, n0 = 32 * nb;
        const bool ok = n0 + 4 * c4 < N;
        f32x4 wv[8];
#pragma unroll
        for (int i = 0; i < 8; ++i) { const int kk = 8 * i + (lane >> 3); wv[i] = ok ? (NT ? __builtin_nontemporal_load((const f32x4*)(W + (size_t)(k0 + kk) * N + n0 + 4 * c4)) : *(const f32x4*)(W + (size_t)(k0 + kk) * N + n0 + 4 * c4)) : (f32x4){0.f, 0.f, 0.f, 0.f}; }
#pragma unroll
        for (int i = 0; i < 8; ++i) { const int kk = 8 * i + (lane >> 3); const float kg = kgain ? kgain[k0 + kk] : 1.0f; LAS float* d = scr + kk * 33 + 4 * c4; d[0] = wv[i].x * kg; d[1] = wv[i].y * kg; d[2] = wv[i].z * kg; d[3] = wv[i].w * kg; }
        LDS_FENCE();
        const int r0 = rm(n0);
#pragma unroll
        for (int j = 0; j < 4; ++j) { const int nn = (lane >> 3) + 8 * j; const LAS float* s = scr + (8 * ch) * 33 + nn;
            v4u o; o.x = pk2(s[0 * 33], s[1 * 33]); o.y = pk2(s[2 * 33], s[3 * 33]); o.z = pk2(s[4 * 33], s[5 * 33]); o.w = pk2(s[6 * 33], s[7 * 33]);
            *(v4u*)(WT + (size_t)(r0 + nn) * K + k0 + 8 * ch) = o; }
        LDS_FENCE();
    };
    if (ticket) {
        volatile LAS unsigned* tk = (volatile LAS unsigned*)(c.lds + MISC_OFF + 64);
        if (c.tid == 0) tk[0] = xb_add(ticket, 64u);
        __syncthreads();
        for (;;) {
            const int base = it0 + (int)tk[0];
            __syncthreads();
            if (base >= items) break;
            unsigned nx = 0u; if (c.tid == 0) nx = xb_add(ticket, 64u);
#pragma unroll 1
            for (int j = 0; j < 8; ++j) { const int it = base + c.wave + 8 * j; if (it < items) body(it); }
            if (c.tid == 0) tk[0] = nx;
            __syncthreads();
        }
    } else {
        for (int it = it0 + gw; it < items; it += ngw) body(it);
    }
}
__device__ __forceinline__ void rmsnorm_rows(const Ctx& c, const float* X, const float* g, bf16* Hout, int nrows) {
    const int lane = c.lane;
    for (int m = c.gw; m < nrows; m += c.ngw) {
        const f32x4* xr = (const f32x4*)(X + (size_t)m * DM) + lane; f32x4 v[16]; float ss = 0.f;
#pragma unroll
        for (int j = 0; j < 16; ++j) { v[j] = xr[64 * j]; ss += (v[j].x * v[j].x + v[j].y * v[j].y) + (v[j].z * v[j].z + v[j].w * v[j].w); }
        const float rstd = 1.0f / sqrtf(wsum(ss) * (1.0f / DM) + NORM_EPS);
        const f32x4* gr = (const f32x4*)g + lane; unsigned long long* o8 = (unsigned long long*)(Hout + (size_t)m * DM) + lane;
#pragma unroll
        for (int j = 0; j < 16; ++j) { const f32x4 gg = gr[64 * j]; o8[64 * j] = (unsigned long long)pk2(v[j].x * rstd * gg.x, v[j].y * rstd * gg.y) | ((unsigned long long)pk2(v[j].z * rstd * gg.z, v[j].w * rstd * gg.w) << 32); }
    }
}
__device__ __forceinline__ void rope_table(const Ctx& c, const int* pos, float* ct, float* st) {
    for (int idx = c.gw * 64 + c.lane; idx < MTOK * 64; idx += c.ngw * 64) {
        const int row = idx >> 6, i = idx & 63;
        const float invf = exp2f(-(float)i * 0.20762050593046f);
        const float ang = (float)pos[row] * invf;
        double rev = (double)ang * 0.15915494309189535; rev -= floor(rev);
        const float r = (float)rev;
        ct[idx] = __builtin_amdgcn_cosf(r); st[idx] = __builtin_amdgcn_sinf(r);
    }
}
__device__ __forceinline__ void headnorm_one(float (&x)[8], int j, int row, const f32x4 ga, const f32x4 gb, const float* ct, const float* st) {
    float ss = 0.f;
#pragma unroll
    for (int e = 0; e < 8; ++e) ss += x[e] * x[e];
    ss += __shfl_xor(ss, 1); ss += __shfl_xor(ss, 2); ss += __shfl_xor(ss, 4); ss += __shfl_xor(ss, 8);
    const float rstd = 1.0f / sqrtf(ss * (1.0f / 128.0f) + NORM_EPS);
    x[0] *= rstd * ga.x; x[1] *= rstd * ga.y; x[2] *= rstd * ga.z; x[3] *= rstd * ga.w; x[4] *= rstd * gb.x; x[5] *= rstd * gb.y; x[6] *= rstd * gb.z; x[7] *= rstd * gb.w;
    if (ct) {
        const f32x4 ca = *(const f32x4*)(ct + (size_t)row * 64 + 8 * (j & 7)), cb = *(const f32x4*)(ct + (size_t)row * 64 + 8 * (j & 7) + 4);
        const f32x4 sa = *(const f32x4*)(st + (size_t)row * 64 + 8 * (j & 7)), sb = *(const f32x4*)(st + (size_t)row * 64 + 8 * (j & 7) + 4);
        const float cs[8] = {ca.x, ca.y, ca.z, ca.w, cb.x, cb.y, cb.z, cb.w}, sn[8] = {sa.x, sa.y, sa.z, sa.w, sb.x, sb.y, sb.z, sb.w};
#pragma unroll
        for (int e = 0; e < 8; ++e) { const float pr = __shfl_xor(x[e], 8); x[e] = (j < 8) ? (x[e] * cs[e] - pr * sn[e]) : (pr * sn[e] + x[e] * cs[e]); }
    }
}
__device__ __forceinline__ void headnorm_bf16(const Ctx& c, bf16* Y, int ld, int col0, int nh, int nrows, const float* gain, const float* ct, const float* st) {
    const int lane = c.lane, sub = lane >> 4, j = lane & 15; const int items = nrows * nh, stride = 4 * c.ngw;
    const f32x4 ga = *(const f32x4*)(gain + 8 * j), gb = *(const f32x4*)(gain + 8 * j + 4);
    for (int it = 4 * c.gw + sub; it < items; it += 2 * stride) {
        const int it2 = it + stride; const bool two = it2 < items;
        const int row = it / nh, hh = it - row * nh, row2 = two ? it2 / nh : row, hh2 = two ? it2 - row2 * nh : hh;
        bf16* p = Y + (size_t)row * ld + col0 + hh * 128 + 8 * j; bf16* p2 = Y + (size_t)row2 * ld + col0 + hh2 * 128 + 8 * j;
        const v4u w = *(const v4u*)p; const v4u w2 = *(const v4u*)p2;
        float x[8] = {bflo(w.x), bfhi(w.x), bflo(w.y), bfhi(w.y), bflo(w.z), bfhi(w.z), bflo(w.w), bfhi(w.w)};
        float y[8] = {bflo(w2.x), bfhi(w2.x), bflo(w2.y), bfhi(w2.y), bflo(w2.z), bfhi(w2.z), bflo(w2.w), bfhi(w2.w)};
        headnorm_one(x, j, row, ga, gb, ct, st); headnorm_one(y, j, row2, ga, gb, ct, st);
        v4u o; o.x = pk2(x[0], x[1]); o.y = pk2(x[2], x[3]); o.z = pk2(x[4], x[5]); o.w = pk2(x[6], x[7]); *(v4u*)p = o;
        if (two) { v4u o2; o2.x = pk2(y[0], y[1]); o2.y = pk2(y[2], y[3]); o2.z = pk2(y[4], y[5]); o2.w = pk2(y[6], y[7]); *(v4u*)p2 = o2; }
    }
}
__device__ __forceinline__ void headnorm_q4(const Ctx& c, const float* QP, bf16* QX, const float* gain, const float* ssq) {
    const int lane = c.lane, sub = lane >> 4, j = lane & 15;
    const f32x4 ga = *(const f32x4*)(gain + 8 * j), gb = *(const f32x4*)(gain + 8 * j + 4);
    for (int it = 4 * c.gw + sub; it < MTOK * 4; it += 4 * c.ngw) {
        const size_t off = (size_t)(it >> 2) * XW + (it & 3) * 128 + 8 * j;
        f32x4 a = *(const f32x4*)(QP + off), b = *(const f32x4*)(QP + off + 4);
#pragma unroll
        for (int ks = 1; ks < 4; ++ks) { a += *(const f32x4*)(QP + (size_t)ks * MTOK * XW + off); b += *(const f32x4*)(QP + (size_t)ks * MTOK * XW + off + 4); }
        { const float rs = 1.0f / sqrtf(ssq[it >> 2] * (1.0f / DM) + NORM_EPS); a *= rs; b *= rs; }
        float ss = (a.x * a.x + a.y * a.y) + (a.z * a.z + a.w * a.w) + (b.x * b.x + b.y * b.y) + (b.z * b.z + b.w * b.w);
        ss += __shfl_xor(ss, 1); ss += __shfl_xor(ss, 2); ss += __shfl_xor(ss, 4); ss += __shfl_xor(ss, 8);
        const float rstd = 1.0f / sqrtf(ss * (1.0f / 128.0f) + NORM_EPS);
        v4u o; o.x = pk2(a.x * rstd * ga.x, a.y * rstd * ga.y); o.y = pk2(a.z * rstd * ga.z, a.w * rstd * ga.w); o.z = pk2(b.x * rstd * gb.x, b.y * rstd * gb.y); o.w = pk2(b.z * rstd * gb.z, b.w * rstd * gb.w);
        *(v4u*)(QX + off) = o;
    }
}
__device__ __forceinline__ void cmp_finish(const Ctx& c, const float* KCR, const float* VCR, const float* cbias, bf16* KCN, bf16* VCT, const float* gain, const float* ct, const float* st) {
    constexpr size_t PS = 16 * 128 * 128;
    const int lane = c.lane; const float g1 = gain[lane], g2 = gain[lane + 64];
    for (int it = c.gw; it < 2 * 16 * 128; it += c.ngw) {
        const int which = it >> 11, r = it & 2047, bg = r >> 7, n = r & 127, b = bg >> 2;
        const size_t o = ((size_t)bg * 128 + n) * 128;
        if (which == 0) {
            if (n == 127) { KCN[o + lane] = 0; KCN[o + lane + 64] = 0; continue; }
            float x1 = ((KCR[o + lane] + KCR[PS + o + lane]) + (KCR[2 * PS + o + lane] + KCR[3 * PS + o + lane])) + cbias[lane], x2 = ((KCR[o + lane + 64] + KCR[PS + o + lane + 64]) + (KCR[2 * PS + o + lane + 64] + KCR[3 * PS + o + lane + 64])) + cbias[lane + 64];
            const float rstd = 1.0f / sqrtf(wsum(x1 * x1 + x2 * x2) * (1.0f / 128.0f) + NORM_EPS);
            x1 = x1 * rstd * g1; x2 = x2 * rstd * g2;
            const int row = b * T + 16 * n + 31; const float cs = ct[row * 64 + lane], sn = st[row * 64 + lane];
            KCN[o + lane] = (bf16)f2bf(x1 * cs - x2 * sn); KCN[o + lane + 64] = (bf16)f2bf(x1 * sn + x2 * cs);
        } else {
            const float v1 = n == 127 ? 0.f : ((VCR[o + lane] + VCR[PS + o + lane]) + (VCR[2 * PS + o + lane] + VCR[3 * PS + o + lane])) + cbias[128 + lane], v2 = n == 127 ? 0.f : ((VCR[o + lane + 64] + VCR[PS + o + lane + 64]) + (VCR[2 * PS + o + lane + 64] + VCR[3 * PS + o + lane + 64])) + cbias[128 + lane + 64];
            VCT[o + lane] = (bf16)f2bf(v1); VCT[o + lane + 64] = (bf16)f2bf(v2);
        }
    }
}
__device__ __forceinline__ void moba_kmean(const Ctx& c, const bf16* Y, float* kmean) {
    const int lane = c.lane;
    for (int it = c.gw; it < NB * 16 * 8; it += c.ngw) {
        const int b = it >> 7, h = (it >> 3) & 15, n = it & 7;
        const bf16* src = Y + ((size_t)b * T + 256 * n) * EVEN_LD + C_MK + h * 128 + 2 * lane;
        float a0 = 0.f, a1 = 0.f;
        for (int k = 0; k < 256; ++k) { const unsigned w = *(const unsigned*)(src + (size_t)k * EVEN_LD); a0 += bflo(w); a1 += bfhi(w); }
        float* dst = kmean + (size_t)it * 128 + 2 * lane; dst[0] = a0 * (1.0f / 256.0f); dst[1] = a1 * (1.0f / 256.0f);
    }
}

__device__ __forceinline__ float dot128(const LAS float* qs, const bf16* krow) {
    const v4u* kp = (const v4u*)krow; float s = 0.f;
#pragma unroll 4
    for (int cch = 0; cch < 16; ++cch) { const v4u w = kp[cch]; const LAS f32x4* q4 = (const LAS f32x4*)(qs + 8 * cch); const f32x4 qa = q4[0], qb = q4[1];
        s += qa.x * bflo(w.x) + qa.y * bfhi(w.x) + qa.z * bflo(w.y) + qa.w * bfhi(w.y) + qb.x * bflo(w.z) + qb.y * bfhi(w.z) + qb.z * bflo(w.w) + qb.w * bfhi(w.w); }
    return s;
}
__device__ __forceinline__ void load_q(LAS float* qs, const bf16* qrow, int lane) {
    LDS_FENCE();
    const unsigned w = *(const unsigned*)(qrow + 2 * lane); qs[2 * lane] = bflo(w); qs[2 * lane + 1] = bfhi(w);
    LDS_FENCE();
}
__device__ __forceinline__ void pv_accum(float& a0, float& a1, float p, int voff, const bf16* Vb, int lane) {
    for (int j = 0; j < 64; ++j) {
        const float pj = rdlane(p, j);
        if (pj != 0.f) { const int off = __builtin_amdgcn_readlane(voff, j); const unsigned w = *(const unsigned*)(Vb + (size_t)off + 2 * lane); a0 += pj * bflo(w); a1 += pj * bfhi(w); }
    }
}
struct SoftAcc { float m, l, a0, a1; };
__device__ __forceinline__ void sa_init(SoftAcc& S) { S.m = NEG_INF; S.l = 0.f; S.a0 = 0.f; S.a1 = 0.f; }
__device__ __forceinline__ void sa_chunk(SoftAcc& S, float s  , int voff, const bf16* Vb, int lane) {
    const float cm = wmax(s);
    if (cm == NEG_INF) return;
    const float mn = fmaxf(S.m, cm);
    const float p = __expf(s - mn), alpha = __expf(S.m - mn);
    S.l = S.l * alpha + wsum(p); S.a0 *= alpha; S.a1 *= alpha; S.m = mn;
    pv_accum(S.a0, S.a1, p, voff, Vb, lane);
}
__device__ __forceinline__ void moba_row(const Ctx& c, LAS float* qs, const bf16* Y, const float* kmean, bf16* O, int b, int h, int t) {
    const int lane = c.lane; const size_t row = (size_t)b * T + t; const bf16* Yb = Y + (size_t)b * T * EVEN_LD;
    load_q(qs, Y + row * EVEN_LD + C_MQ + h * 128, lane);
    const int cur = t >> 8;
    float gate = NEG_INF;
    if (lane < cur) { const float* km = kmean + ((size_t)(b * 16 + h) * 8 + lane) * 128; float s = 0.f; for (int d = 0; d < 128; ++d) s += qs[d] * km[d]; gate = s; }
    int rank = 0;
    for (int m2 = 0; m2 < 8; ++m2) { const float gm = rdlane(gate, m2); rank += (gm > gate || (gm == gate && m2 < lane)) ? 1 : 0; }
    const unsigned selmask = (unsigned)__ballot((lane < cur) && (rank < 3));
    SoftAcc S; sa_init(S);
    const bf16* Kb = Yb + C_MK + h * 128; const bf16* Vb = Yb + C_MV + h * 128;
    const int nch = (t >> 6) + 1;
    for (int kc = 0; kc < nch; ++kc) {
        const int n = kc >> 2;
        if (n < cur && !((selmask >> n) & 1u)) continue;
        const int key = kc * 64 + lane; const bool valid = key <= t; const int koff = (valid ? key : t) * EVEN_LD;
        float s = dot128(qs, Kb + koff) * ATT_SCALE; if (!valid) s = NEG_INF;
        sa_chunk(S, s, koff, Vb, lane);
    }
    const float inv = 1.0f / fmaxf(S.l, 1e-30f);
    *(unsigned*)(O + row * DM + h * 128 + 2 * lane) = pk2(S.a0 * inv, S.a1 * inv);
}
__device__ __forceinline__ void nsa_item(const Ctx& c, LAS float* qs, LAS float* ps, const bf16* Y, const bf16* KCN, const bf16* VCN, bf16* O, int b, int g, int t) {
    const int lane = c.lane; const size_t row = (size_t)b * T + t; const bf16* Yb = Y + (size_t)b * T * EVEN_LD;
    const bf16* Kc = KCN + (size_t)(b * 4 + g) * 128 * 128; const bf16* Vc = VCN + (size_t)(b * 4 + g) * 128 * 128;
    float oc0[4], oc1[4]; float P0 = 0.f, P1 = 0.f;
    const int n0 = lane, n1 = 64 + lane; const bool v0 = 16 * n0 + 31 <= t, v1 = (n1 < 127) && (16 * n1 + 31 <= t);
#pragma unroll
    for (int hh = 0; hh < 4; ++hh) {
        load_q(qs, Y + row * EVEN_LD + C_NQ + (g * 4 + hh) * 128, lane);
        float s0 = dot128(qs, Kc + (v0 ? n0 : 0) * 128) * ATT_SCALE, s1 = dot128(qs, Kc + (v1 ? n1 : 0) * 128) * ATT_SCALE;
        if (!v0) s0 = NEG_INF; if (!v1) s1 = NEG_INF;
        const float m = wmax(fmaxf(s0, s1)); float a0 = 0.f, a1 = 0.f;
        if (m != NEG_INF) {
            float p0 = __expf(s0 - m), p1 = __expf(s1 - m);
            const float inv = 1.0f / fmaxf(wsum(p0 + p1), 1e-30f);
            p0 *= inv; p1 *= inv; P0 += p0; P1 += p1;
            pv_accum(a0, a1, p0, n0 * 128, Vc, lane); pv_accum(a0, a1, p1, (v1 ? n1 : 0) * 128, Vc, lane);
        }
        oc0[hh] = a0; oc1[hh] = a1;
    }
    LDS_FENCE(); ps[lane] = P0; ps[64 + lane] = P1; LDS_FENCE();
    float imp = 0.f;
    if (lane < 32) { for (int n = 4 * lane - 1; n <= 4 * lane + 3; ++n) if (n >= 0 && n < 127) imp += ps[n]; }
    const int cur = t >> 6;
    const float v = (lane >= 32) ? NEG_INF : ((lane == cur || lane == 0) ? __builtin_inff() : (lane <= cur ? imp : NEG_INF));
    int rank = 0;
    for (int m2 = 0; m2 < 32; ++m2) { const float vm = rdlane(v, m2); rank += (vm > v || (vm == v && m2 < lane)) ? 1 : 0; }
    const unsigned selmask = (unsigned)__ballot(lane < 32 && lane <= cur && rank < 16);
    const bf16* Ks = Yb + C_KS + g * 128; const bf16* Vs = Yb + C_VS + g * 128; const bf16* Kw = Yb + C_KW + g * 128; const bf16* Vw = Yb + C_VW + g * 128;
#pragma unroll
    for (int hh = 0; hh < 4; ++hh) {
        const int h = g * 4 + hh;
        load_q(qs, Y + row * EVEN_LD + C_NQ + h * 128, lane);
        SoftAcc S; sa_init(S);
        for (int j = 0; j <= cur; ++j) {
            if (!((selmask >> j) & 1u)) continue;
            const int key = 64 * j + lane; const bool valid = key <= t; const int koff = (valid ? key : t) * EVEN_LD;
            float s = dot128(qs, Ks + koff) * ATT_SCALE; if (!valid) s = NEG_INF;
            sa_chunk(S, s, koff, Vs, lane);
        }
        SoftAcc W; sa_init(W);
        for (int c0 = 0; c0 < 512 && c0 <= t; c0 += 64) {
            const int key = t - c0 - lane; const bool valid = key >= 0; const int koff = (valid ? key : 0) * EVEN_LD;
            float s = dot128(qs, Kw + koff) * ATT_SCALE; if (!valid) s = NEG_INF;
            sa_chunk(W, s, koff, Vw, lane);
        }
        const bf16* gl = Y + row * EVEN_LD + C_GL + h * 3;
        const float g0 = 1.0f / (1.0f + __expf(-bf2f(gl[0]))), g1 = 1.0f / (1.0f + __expf(-bf2f(gl[1]))), g2 = 1.0f / (1.0f + __expf(-bf2f(gl[2])));
        const float is = 1.0f / fmaxf(S.l, 1e-30f), iw = 1.0f / fmaxf(W.l, 1e-30f);
        const float o0 = g0 * oc0[hh] + g1 * (S.a0 * is) + g2 * (W.a0 * iw), o1 = g0 * oc1[hh] + g1 * (S.a1 * is) + g2 * (W.a1 * iw);
        *(unsigned*)(O + row * DM + 2048 + h * 128 + 2 * lane) = pk2(o0, o1);
    }
}
__device__ __forceinline__ void sb_row(const Ctx& c, LAS float* qs, const bf16* Y, bf16* O, int b, int h, int t) {
    const int lane = c.lane; const size_t row = (size_t)b * T + t; const bf16* Yb = Y + (size_t)b * T * ODD_LD;
    load_q(qs, Y + row * ODD_LD + C_SQ + h * 128, lane);
    const bf16* Kb = Yb + C_SK + h * 128; const bf16* Vb = Yb + C_SV + h * 128;
    float carry = 0.f, a0 = 0.f, a1 = 0.f;
    for (int c0 = 0; c0 < t; c0 += 64) {
        const int key = t - 1 - c0 - lane; const bool valid = key >= 0; const int koff = (valid ? key : 0) * ODD_LD;
        const float z = dot128(qs, Kb + koff) * ATT_SCALE;
        const float L = __logf(1.0f + __expf(-fabsf(z)));
        const float lsp = fminf(z, 0.f) - L;
        const float lr = valid ? (lsp - z) : 0.f;
        float incl = lr;
#pragma unroll
        for (int o = 1; o < 64; o <<= 1) { const float u = __shfl_up(incl, o); if (lane >= o) incl += u; }
        const float a = valid ? __expf(lsp + carry + (incl - lr)) : 0.f;
        carry += rdlane(incl, 63);
        pv_accum(a0, a1, a, koff, Vb, lane);
    }
    *(unsigned*)(O + row * DM + h * 128 + 2 * lane) = pk2(a0, a1);
}
__device__ __forceinline__ void dil_row(const Ctx& c, LAS float* qs, const bf16* Y, bf16* O, int b, int hd, int t) {
    const int lane = c.lane; const size_t row = (size_t)b * T + t; const bf16* Yb = Y + (size_t)b * T * ODD_LD;
    float og0[3], og1[3], lse[3];
#pragma unroll
    for (int gi = 0; gi < 3; ++gi) {
        const int r = gi == 0 ? 1 : (gi == 1 ? 4 : 16), nd = gi * 8 + hd;
        load_q(qs, Y + row * ODD_LD + C_DQ + nd * 128, lane);
        const bf16* Kb = Yb + C_DK + nd * 128; const bf16* Vb = Yb + C_DV + nd * 128;
        SoftAcc S; sa_init(S);
        for (int c0 = 0; c0 < 129; c0 += 64) {
            const int ci = c0 + lane, key = t - r * ci; const bool valid = (ci <= 128) && key >= 0; const int koff = (valid ? key : 0) * ODD_LD;
            float s = dot128(qs, Kb + koff) * ATT_SCALE; if (!valid) s = NEG_INF;
            sa_chunk(S, s, koff, Vb, lane);
        }
        const float inv = 1.0f / fmaxf(S.l, 1e-30f);
        og0[gi] = S.a0 * inv; og1[gi] = S.a1 * inv; lse[gi] = S.m + __logf(fmaxf(S.l, 1e-30f));
    }
    const float mx = fmaxf(lse[0], fmaxf(lse[1], lse[2]));
    const float w0 = __expf(lse[0] - mx), w1 = __expf(lse[1] - mx), w2 = __expf(lse[2] - mx), iw = 1.0f / (w0 + w1 + w2);
    *(unsigned*)(O + row * DM + 3072 + hd * 128 + 2 * lane) = pk2((w0 * og0[0] + w1 * og0[1] + w2 * og0[2]) * iw, (w0 * og1[0] + w1 * og1[1] + w2 * og1[2]) * iw);
}
__device__ __forceinline__ void xattn_row(const Ctx& c, LAS float* qs, const bf16* QX, const bf16* KVX, bf16* OX, int b, int h, int t) {
    const int lane = c.lane; const size_t row = (size_t)b * T + t;
    load_q(qs, QX + row * XW + h * 128, lane);
    const bf16* Kb = KVX + (size_t)b * MEM_LEN * 1024 + h * 128; const bf16* Vb = Kb + 512;
    SoftAcc S; sa_init(S);
    for (int c0 = 0; c0 < MEM_LEN; c0 += 64) { const int koff = (c0 + lane) * 1024; const float s = dot128(qs, Kb + koff) * ATT_SCALE; sa_chunk(S, s, koff, Vb, lane); }
    const float inv = 1.0f / fmaxf(S.l, 1e-30f);
    *(unsigned*)(OX + row * XW + h * 128 + 2 * lane) = pk2(S.a0 * inv, S.a1 * inv);
}
__device__ __forceinline__ int spread_t(int i) { return ((i & (T - 1)) + (i >> 11) * 997) & (T - 1); }


namespace fa {
typedef short bf16x8 __attribute__((ext_vector_type(8)));
typedef short s16x4 __attribute__((ext_vector_type(4)));
typedef float f32x16 __attribute__((ext_vector_type(16)));
typedef unsigned u32x2 __attribute__((ext_vector_type(2)));
constexpr int KT_BYTES = 64 * 256, VT_BYTES = 64 * 256, STAGE = KT_BYTES + VT_BYTES;
constexpr float C2 = 0.08838834764831845f * 1.4426950408889634f;
struct Unit {
    const bf16* q; int qstride;
    const bf16* k; int kstride;
    const bf16* v; int vstride;
    bf16* o; int ostride;
    float* lse; int lse_stride;
    const unsigned* sel; int sel_stride;
    int pos0, t_lo, t_hi;
    int window, causal;
    int sel_shift, own_blk, nrows;
    const bf16* comb_oc; const bf16* comb_os; const bf16* comb_gl; int comb_gls;
    const float* qp; const float* qgain; const float* qssq;
    size_t qps;
    const float* kmean;
};
__device__ __forceinline__ unsigned cvtpk(float lo, float hi) { return pg8::cvt_pk_bf16(lo, hi); }
__device__ __forceinline__ float xmax32(float v) { return fmaxf(v, __shfl_xor(v, 32)); }
__device__ __forceinline__ float xsum32(float v) { return v + __shfl_xor(v, 32); }
__device__ __forceinline__ float xother32(float v, int) { return __shfl_xor(v, 32); }
__device__ __forceinline__ bf16x8 pack8(const f32x16& p, const int b) { v4u w = {cvtpk(p[b + 0], p[b + 1]), cvtpk(p[b + 2], p[b + 3]), cvtpk(p[b + 4], p[b + 5]), cvtpk(p[b + 6], p[b + 7])}; return __builtin_bit_cast(bf16x8, w); }

#define FA_LOAD(tile) do { const int kb_ = (tile) * 64; const bf16* kp_ = u.k + (size_t)(kb_ + sr) * u.kstride + sc * 8; kq0 = *(const v4u*)kp_; kq1 = *(const v4u*)(kp_ + (size_t)32 * u.kstride); \
        const bf16* vp_ = u.v + (size_t)(kb_ + sr) * u.vstride + sc * 8; vq0 = *(const v4u*)vp_; vq1 = *(const v4u*)(vp_ + (size_t)32 * u.vstride); } while (0)
#define FA_WRITE(st) do { LAS unsigned char* b_ = L + (st) * STAGE; *(LAS v4u*)(b_ + kw0) = kq0; *(LAS v4u*)(b_ + kw0 + 32 * 256) = kq1; \
        *(LAS v4u*)(b_ + vw0) = vq0; *(LAS v4u*)(b_ + vw0 + 32 * 256) = vq1; } while (0)
#define FA_SB0() __builtin_amdgcn_sched_barrier(0)
#define FA_QK(st) do { const LAS unsigned char* kl_ = L + (st) * STAGE; p0 = f32x16{}; p1 = f32x16{}; \
        _Pragma("unroll") for (int h_ = 0; h_ < 2; ++h_) { bf16x8 ka_[4], kb_[4]; \
            _Pragma("unroll") for (int d1 = 0; d1 < 4; ++d1) { const int cb_ = ((4 * h_ + d1) * 32 + hi * 16) ^ ((r32 & 15) << 4); ka_[d1] = *(const LAS bf16x8*)(kl_ + r32 * 256 + cb_); kb_[d1] = *(const LAS bf16x8*)(kl_ + (32 + r32) * 256 + cb_); } \
            FA_SB0(); \
            _Pragma("unroll") for (int d1 = 0; d1 < 4; ++d1) { p0 = __builtin_amdgcn_mfma_f32_32x32x16_bf16(ka_[d1], q[4 * h_ + d1], p0, 0, 0, 0); p1 = __builtin_amdgcn_mfma_f32_32x32x16_bf16(kb_[d1], q[4 * h_ + d1], p1, 0, 0, 0); } \
            FA_SB0(); } } while (0)
#define FA_TRRD(dst, addr, off) asm volatile("ds_read_b64_tr_b16 %0, %1 offset:%2" : "=&v"(dst) : "v"(addr), "i"(off) : "memory")
#define FA_PV(st) do { const int so_ = (st) * STAGE; \
        _Pragma("unroll") for (int db = 0; db < 4; ++db) { const int a0_ = vtr[2 * db] + so_, a1_ = vtr[2 * db + 1] + so_; s16x4 l0_, h0_, l1_, h1_, l2_, h2_, l3_, h3_; \
            FA_TRRD(l0_, a0_, 0); FA_TRRD(h0_, a1_, 0); FA_TRRD(l1_, a0_, 4096); FA_TRRD(h1_, a1_, 4096); FA_TRRD(l2_, a0_, 8192); FA_TRRD(h2_, a1_, 8192); FA_TRRD(l3_, a0_, 12288); FA_TRRD(h3_, a1_, 12288); \
            asm volatile("s_waitcnt lgkmcnt(0)" ::: "memory"); FA_SB0(); \
            o[db] = __builtin_amdgcn_mfma_f32_32x32x16_bf16((bf16x8){l0_[0], l0_[1], l0_[2], l0_[3], h0_[0], h0_[1], h0_[2], h0_[3]}, P[0], o[db], 0, 0, 0); \
            o[db] = __builtin_amdgcn_mfma_f32_32x32x16_bf16((bf16x8){l1_[0], l1_[1], l1_[2], l1_[3], h1_[0], h1_[1], h1_[2], h1_[3]}, P[1], o[db], 0, 0, 0); \
            o[db] = __builtin_amdgcn_mfma_f32_32x32x16_bf16((bf16x8){l2_[0], l2_[1], l2_[2], l2_[3], h2_[0], h2_[1], h2_[2], h2_[3]}, P[2], o[db], 0, 0, 0); \
            o[db] = __builtin_amdgcn_mfma_f32_32x32x16_bf16((bf16x8){l3_[0], l3_[1], l3_[2], l3_[3], h3_[0], h3_[1], h3_[2], h3_[3]}, P[3], o[db], 0, 0, 0); \
            FA_SB0(); } } while (0)
#define FA_VTR_SETUP() int vtr[8]; { const int q_ = (lane & 15) >> 2, p_ = lane & 3, ch_ = (lane >> 4) & 1; const int lb_ = (int)(unsigned)(size_t)L; \
        _Pragma("unroll") for (int db = 0; db < 4; ++db) { _Pragma("unroll") for (int s_ = 0; s_ < 2; ++s_) { const int row_ = 8 * s_ + 4 * hi + q_, chunk_ = 4 * db + 2 * ch_ + (p_ >> 1); \
            vtr[2 * db + s_] = lb_ + KT_BYTES + 256 * row_ + 16 * (chunk_ ^ (((row_ & 3) << 2) | ((row_ >> 2) & 3))) + 8 * (p_ & 1); } } }

template <int MODE>
__device__ __forceinline__ void run_unit(const Ctx& c, const Unit& u) {
    const int tid = c.tid, lane = c.lane, w = c.wave, r32 = lane & 31, hi = lane >> 5;
    LAS unsigned char* L = c.lds;
    const int row = 32 * w + r32; const bool wact = 32 * w < u.nrows;
    bf16x8 q[8];
    if (MODE == 0 && u.qp) {
        const float* bp = u.qp + (size_t)row * 512 + hi * 8; f32x4 va[8], vb[8]; float ss = 0.f;
        const float rsx = 1.0f / sqrtf(u.qssq[row] * (1.0f / 4096.0f) + 1e-6f);
#pragma unroll
        for (int d0 = 0; d0 < 8; ++d0) { f32x4 a = *(const f32x4*)(bp + 16 * d0), b = *(const f32x4*)(bp + 16 * d0 + 4);
#pragma unroll
            for (int ks = 1; ks < 4; ++ks) { a += *(const f32x4*)(bp + ks * u.qps + 16 * d0); b += *(const f32x4*)(bp + ks * u.qps + 16 * d0 + 4); }
            a *= rsx; b *= rsx; va[d0] = a; vb[d0] = b; ss += ((a.x * a.x + a.y * a.y) + (a.z * a.z + a.w * a.w)) + ((b.x * b.x + b.y * b.y) + (b.z * b.z + b.w * b.w)); }
        ss = xsum32(ss);
        const float rstd = 1.0f / sqrtf(ss * (1.0f / 128.0f) + 1e-6f);
#pragma unroll
        for (int d0 = 0; d0 < 8; ++d0) { const f32x4 ga = *(const f32x4*)(u.qgain + 16 * d0 + hi * 8), gb = *(const f32x4*)(u.qgain + 16 * d0 + hi * 8 + 4); const f32x4 a = va[d0] * rstd * ga, b = vb[d0] * rstd * gb;
            v4u wq; wq.x = cvtpk(a.x, a.y); wq.y = cvtpk(a.z, a.w); wq.z = cvtpk(b.x, b.y); wq.w = cvtpk(b.z, b.w); q[d0] = __builtin_bit_cast(bf16x8, wq); }
    } else { const bf16* qp = u.q + (size_t)(wact ? row : 0) * u.qstride + hi * 8;
#pragma unroll
      for (int d0 = 0; d0 < 8; ++d0) q[d0] = *(const bf16x8*)(qp + 16 * d0); }
    const int pq = u.pos0 + row, wlo = u.pos0 + 32 * w, whi = wlo + 31;
    unsigned selm = 0xffffffffu; if (u.sel && wact) selm = u.sel[(size_t)row * u.sel_stride];
    const int sr = tid >> 4, sc = tid & 15, vr = tid >> 3, vc = tid & 7;
    const int kw0 = sr * 256 + ((sc * 16) ^ ((sr & 15) << 4)), vw0 = KT_BYTES + 256 * sr + 16 * (sc ^ (((sr & 3) << 2) | ((sr >> 2) & 3)));
    FA_VTR_SETUP();
    v4u kq0, kq1, vq0, vq1;
    f32x16 o[4] = {f32x16{}, f32x16{}, f32x16{}, f32x16{}}; f32x16 p0, p1; bf16x8 P[4];
    float m_run = -1e30f, l_run = 0.f, carry = 0.f;
    const int nt = u.t_hi - u.t_lo;
    __syncthreads();
    if (nt > 0) { FA_LOAD(MODE == 0 ? u.t_lo : u.t_hi - 1); FA_WRITE(0); }
    if (MODE == 0 && u.kmean) {
        const int grow = tid >> 5, gd4 = (tid & 31) * 4, gn = grow & 7; const f32x4 km = *(const f32x4*)(u.kmean + gn * 128 + gd4);
        unsigned h0 = f2bf(km.x), h1 = f2bf(km.y), h2 = f2bf(km.z), h3 = f2bf(km.w);
        if (grow >> 3) { h0 = f2bf(km.x - bflo(h0)); h1 = f2bf(km.y - bflo(h1)); h2 = f2bf(km.z - bflo(h2)); h3 = f2bf(km.w - bflo(h3)); }
        *(LAS u32x2*)(L + STAGE + grow * 256 + ((gd4 * 2) ^ ((grow & 15) << 4))) = (u32x2){h0 | (h1 << 16), h2 | (h3 << 16)};
    }
    __syncthreads();
    if (MODE == 0 && u.kmean) {
        FA_QK(1);
        float gown[4], g8[8];
#pragma unroll
        for (int e = 0; e < 4; ++e) gown[e] = p0[e] + p0[4 + e];
#pragma unroll
        for (int e = 0; e < 4; ++e) { const float go = xother32(gown[e], hi); g8[e] = hi ? go : gown[e]; g8[4 + e] = hi ? gown[e] : go; }
#pragma unroll
        for (int n = 0; n < 8; ++n) if (n >= u.own_blk) g8[n] = NEG_INF;
        selm = 0u;
#pragma unroll
        for (int n = 0; n < 8; ++n) { int rank = 0;
#pragma unroll
            for (int m2 = 0; m2 < 8; ++m2) rank += (g8[m2] > g8[n] || (g8[m2] == g8[n] && m2 < n)) ? 1 : 0;
            if (rank < 3 && n < u.own_blk) selm |= 1u << n; }
        __syncthreads();
    }
    for (int i = 0; i < nt; ++i) {
        const int tile = MODE == 0 ? u.t_lo + i : u.t_hi - 1 - i, st = i & 1, kb = tile * 64;
        if (i + 1 < nt) FA_LOAD(MODE == 0 ? tile + 1 : tile - 1);
        if (MODE == 0) {
            bool act = wact;
            if (u.causal && (kb > whi || kb + 63 <= wlo - u.window)) act = false;
            bool allowed = true;
            if (u.sel || u.kmean) { const int blk = tile >> u.sel_shift; allowed = (blk == u.own_blk) || ((selm >> blk) & 1u); if (!__any(allowed)) act = false; }
            if (act) {
                FA_QK(st);
                if (u.causal && (kb + 63 > wlo || kb <= whi - u.window)) {
                    const int dq = pq - kb - 4 * hi;
#pragma unroll
                    for (int r = 0; r < 16; ++r) { const int cc = (r & 3) + 8 * (r >> 2);
                        if ((unsigned)(dq - cc) >= (unsigned)u.window) p0[r] = NEG_INF;
                        if ((unsigned)(dq - cc - 32) >= (unsigned)u.window) p1[r] = NEG_INF; }
                }
                if (!allowed) {
#pragma unroll
                    for (int r = 0; r < 16; ++r) { p0[r] = NEG_INF; p1[r] = NEG_INF; } }
                float pm = fmaxf(p0[0], p1[0]);
#pragma unroll
                for (int r = 1; r < 16; ++r) pm = fmaxf(pm, fmaxf(p0[r], p1[r]));
                pm = xmax32(pm);
                if (__any((pm - m_run) * C2 > 11.5f)) {
                    const float mn = fmaxf(m_run, pm), alpha = __builtin_amdgcn_exp2f((m_run - mn) * C2); m_run = mn; l_run *= alpha;
#pragma unroll
                    for (int db = 0; db < 4; ++db)
#pragma unroll
                        for (int r = 0; r < 16; ++r) o[db][r] *= alpha; }
                const float mb = m_run * C2;
                float ps = 0.f;
#pragma unroll
                for (int r = 0; r < 16; ++r) { p0[r] = __builtin_amdgcn_exp2f(p0[r] * C2 - mb); p1[r] = __builtin_amdgcn_exp2f(p1[r] * C2 - mb); ps += p0[r] + p1[r]; }
                l_run += ps;
                P[0] = pack8(p0, 0); P[1] = pack8(p0, 8); P[2] = pack8(p1, 0); P[3] = pack8(p1, 8);
                FA_PV(st);
            }
        } else {
            if (wact && kb < whi && __any(carry > -110.0f)) {
                FA_QK(st);
                const int dq = pq - kb - 4 * hi;
                float own[8];
#define FA_SBG(PP, g, koff) do { float lr_[4], ls_[4]; \
                    _Pragma("unroll") for (int e = 0; e < 4; ++e) { const int cc = e + 8 * (g) + (koff); const float z = PP[4 * (g) + e] * ATT_SCALE; const float lg = __logf(1.0f + __expf(-fabsf(z))); \
                        const bool strict = dq - cc > 0; const float lr = fminf(z, 0.f) - lg - z; lr_[e] = strict ? lr : 0.f; ls_[e] = strict ? lr + z : NEG_INF; } \
                    PP[4 * (g) + 3] = ls_[3]; PP[4 * (g) + 2] = ls_[2] + lr_[3]; PP[4 * (g) + 1] = ls_[1] + (lr_[3] + lr_[2]); PP[4 * (g)] = ls_[0] + (lr_[3] + lr_[2] + lr_[1]); \
                    own[(g) + ((koff) ? 4 : 0)] = (lr_[3] + lr_[2]) + (lr_[1] + lr_[0]); } while (0)
                FA_SBG(p0, 0, 0); FA_SBG(p0, 1, 0); FA_SBG(p0, 2, 0); FA_SBG(p0, 3, 0); FA_SBG(p1, 0, 32); FA_SBG(p1, 1, 32); FA_SBG(p1, 2, 32); FA_SBG(p1, 3, 32);
#undef FA_SBG
                float oth[8];
#pragma unroll
                for (int g = 0; g < 8; ++g) oth[g] = xother32(own[g], hi);
                float suf = carry;
#pragma unroll
                for (int g = 7; g >= 0; --g) {
                    const float base = suf + (hi == 0 ? oth[g] : 0.f);
                    if (g >= 4) {
#pragma unroll
                        for (int e = 0; e < 4; ++e) p1[4 * (g - 4) + e] = __expf(p1[4 * (g - 4) + e] + base);
                    } else {
#pragma unroll
                        for (int e = 0; e < 4; ++e) p0[4 * g + e] = __expf(p0[4 * g + e] + base);
                    }
                    suf += own[g] + oth[g];
                }
                carry = suf;
                P[0] = pack8(p0, 0); P[1] = pack8(p0, 8); P[2] = pack8(p1, 0); P[3] = pack8(p1, 8);
                FA_PV(st);
            }
        }
        if (i + 1 < nt) FA_WRITE(st ^ 1);
        if (MODE == 1) {
            if (!__syncthreads_or((wact && carry > -110.0f) ? 1 : 0)) break;
        } else __syncthreads();
    }
    if (wact) {
        float inv = 1.0f;
        if (MODE == 0) { const float lt = xsum32(l_run); inv = lt > 0.f ? 1.0f / lt : 0.f;
            if (u.lse && hi == 0) u.lse[(size_t)row * u.lse_stride] = m_run * ATT_SCALE + __logf(fmaxf(lt, 1e-30f)); }
        bf16* op = u.o + (size_t)row * u.ostride + 4 * hi;
        if (MODE == 0 && u.comb_gl) {
            const bf16* gl = u.comb_gl + (size_t)row * u.comb_gls;
            const float g0 = 1.0f / (1.0f + __expf(-bf2f(gl[0]))), g1 = 1.0f / (1.0f + __expf(-bf2f(gl[1]))), g2 = inv / (1.0f + __expf(-bf2f(gl[2])));
            const bf16* pc = u.comb_oc + (size_t)row * 2048 + 4 * hi; const bf16* ps_ = u.comb_os + (size_t)row * 2048 + 4 * hi;
#pragma unroll
            for (int db = 0; db < 4; ++db)
#pragma unroll
                for (int g = 0; g < 4; ++g) { const u32x2 wc = *(const u32x2*)(pc + 32 * db + 8 * g), wsv = *(const u32x2*)(ps_ + 32 * db + 8 * g); u32x2 wv;
                    wv.x = cvtpk(g0 * bflo(wc.x) + g1 * bflo(wsv.x) + g2 * o[db][4 * g], g0 * bfhi(wc.x) + g1 * bfhi(wsv.x) + g2 * o[db][4 * g + 1]);
                    wv.y = cvtpk(g0 * bflo(wc.y) + g1 * bflo(wsv.y) + g2 * o[db][4 * g + 2], g0 * bfhi(wc.y) + g1 * bfhi(wsv.y) + g2 * o[db][4 * g + 3]);
                    *(u32x2*)(op + 32 * db + 8 * g) = wv; }
        } else {
#pragma unroll
        for (int db = 0; db < 4; ++db)
#pragma unroll
            for (int g = 0; g < 4; ++g) { u32x2 wv; wv.x = cvtpk(o[db][4 * g] * inv, o[db][4 * g + 1] * inv); wv.y = cvtpk(o[db][4 * g + 2] * inv, o[db][4 * g + 3] * inv);
                *(u32x2*)(op + 32 * db + 8 * g) = wv; }
        }
    }
}

__device__ __forceinline__ void cmp_unit(const Ctx& c, const bf16* Yq  , int ldy, const bf16* Kc, const bf16* Vct, bf16* OCrow  , unsigned* SELrow  , int tt) {
    const int tid = c.tid, lane = c.lane, w = c.wave, r32 = lane & 31, hi = lane >> 5;
    LAS unsigned char* L = c.lds;
    const int tok = 8 * w + (r32 >> 2), hh = r32 & 3, t = 64 * tt + tok;
    struct { const bf16* k; int kstride; const bf16* v; int vstride; } u; u.k = Kc; u.kstride = 128; u.v = Vct; u.vstride = 128;
    bf16x8 q[8];
    { const bf16* qp = Yq + (size_t)tok * ldy + hh * 128 + hi * 8;
#pragma unroll
      for (int d0 = 0; d0 < 8; ++d0) q[d0] = *(const bf16x8*)(qp + 16 * d0); }
    const int sr = tid >> 4, sc = tid & 15, vr = tid >> 3, vc = tid & 7;
    const int kw0 = sr * 256 + ((sc * 16) ^ ((sr & 15) << 4)), vw0 = KT_BYTES + 256 * sr + 16 * (sc ^ (((sr & 3) << 2) | ((sr >> 2) & 3)));
    FA_VTR_SETUP();
    v4u kq0, kq1, vq0, vq1;
    __syncthreads();
    FA_LOAD(0); FA_WRITE(0); FA_LOAD(1); FA_WRITE(1);
    __syncthreads();
    f32x16 p0, p1, s00, s01;
    FA_QK(0); s00 = p0; s01 = p1;
    FA_QK(1);
    const int nmax = (t - 31) >> 4;
    { const int nb = 4 * hi;
#pragma unroll
      for (int r = 0; r < 16; ++r) { const int cc = (r & 3) + 8 * (r >> 2) + nb;
          if (cc > nmax) s00[r] = NEG_INF; if (cc + 32 > nmax) s01[r] = NEG_INF; if (cc + 64 > nmax) p0[r] = NEG_INF; if (cc + 96 > nmax || cc + 96 > 126) p1[r] = NEG_INF; } }
    float pm = NEG_INF;
#pragma unroll
    for (int r = 0; r < 16; ++r) pm = fmaxf(pm, fmaxf(fmaxf(s00[r], s01[r]), fmaxf(p0[r], p1[r])));
    pm = xmax32(pm);
    const float mb = (pm == NEG_INF ? 0.f : pm) * C2;
    float ps = 0.f;
#pragma unroll
    for (int r = 0; r < 16; ++r) { s00[r] = __builtin_amdgcn_exp2f(s00[r] * C2 - mb); s01[r] = __builtin_amdgcn_exp2f(s01[r] * C2 - mb); p0[r] = __builtin_amdgcn_exp2f(p0[r] * C2 - mb); p1[r] = __builtin_amdgcn_exp2f(p1[r] * C2 - mb);
        ps += (s00[r] + s01[r]) + (p0[r] + p1[r]); }
    ps = xsum32(ps);
    const float inv = 1.0f / fmaxf(ps, 1e-30f);
#pragma unroll
    for (int r = 0; r < 16; ++r) { s00[r] *= inv; s01[r] *= inv; p0[r] *= inv; p1[r] *= inv; }
    f32x16 o[4] = {f32x16{}, f32x16{}, f32x16{}, f32x16{}}; bf16x8 P[4];
    P[0] = pack8(s00, 0); P[1] = pack8(s00, 8); P[2] = pack8(s01, 0); P[3] = pack8(s01, 8); FA_PV(0);
    P[0] = pack8(p0, 0); P[1] = pack8(p0, 8); P[2] = pack8(p1, 0); P[3] = pack8(p1, 8); FA_PV(1);
    { bf16* op = OCrow + (size_t)tok * 2048 + hh * 128 + 4 * hi;
#pragma unroll
      for (int db = 0; db < 4; ++db)
#pragma unroll
          for (int g = 0; g < 4; ++g) { u32x2 wv; wv.x = cvtpk(o[db][4 * g], o[db][4 * g + 1]); wv.y = cvtpk(o[db][4 * g + 2], o[db][4 * g + 3]); *(u32x2*)(op + 32 * db + 8 * g) = wv; } }
    float cs[16], cl[16];
#pragma unroll
    for (int rq = 0; rq < 4; ++rq) {
        cs[rq] = (s00[4 * rq] + s00[4 * rq + 1]) + (s00[4 * rq + 2] + s00[4 * rq + 3]); cl[rq] = s00[4 * rq + 3];
        cs[4 + rq] = (s01[4 * rq] + s01[4 * rq + 1]) + (s01[4 * rq + 2] + s01[4 * rq + 3]); cl[4 + rq] = s01[4 * rq + 3];
        cs[8 + rq] = (p0[4 * rq] + p0[4 * rq + 1]) + (p0[4 * rq + 2] + p0[4 * rq + 3]); cl[8 + rq] = p0[4 * rq + 3];
        cs[12 + rq] = (p1[4 * rq] + p1[4 * rq + 1]) + (p1[4 * rq + 2] + p1[4 * rq + 3]); cl[12 + rq] = p1[4 * rq + 3]; }
#pragma unroll
    for (int k = 0; k < 16; ++k) { cs[k] += __shfl_xor(cs[k], 1); cs[k] += __shfl_xor(cs[k], 2); cl[k] += __shfl_xor(cl[k], 1); cl[k] += __shfl_xor(cl[k], 2); }
    float impE[16], impO[16];
    { float ocs[16], ocl[16];
#pragma unroll
      for (int k = 0; k < 16; ++k) { ocs[k] = xother32(cs[k], hi); ocl[k] = xother32(cl[k], hi); }
#pragma unroll
      for (int k = 0; k < 16; ++k) { const float ecs = hi ? ocs[k] : cs[k], ocs_ = hi ? cs[k] : ocs[k], clO = hi ? ocl[k] : cl[k];
          float clE = 0.f; if (k > 0) clE = hi ? cl[k - 1] : ocl[k - 1];
          impE[k] = ecs + clE; impO[k] = ocs_ + clO; } }
    LAS float* tab = (LAS float*)(L + 2 * STAGE) + (8 * w + (r32 >> 2)) * 32;
    if (hh == 0 && hi == 0) {
#pragma unroll
        for (int k = 0; k < 16; ++k) { const int je = 2 * k, jo = 2 * k + 1;
            const float ve = (je == 0 || je == tt) ? __builtin_inff() : (je <= tt ? impE[k] : NEG_INF), vo = (jo == tt) ? __builtin_inff() : (jo <= tt ? impO[k] : NEG_INF);
            tab[je] = ve; tab[jo] = vo; } }
    LDS_FENCE();
    const int a4 = 4 * (hh + 4 * hi);
    const f32x4 vj = *(const LAS f32x4*)(tab + a4);
    int rk0 = 0, rk1 = 0, rk2 = 0, rk3 = 0;
#pragma unroll
    for (int i4 = 0; i4 < 8; ++i4) { const f32x4 vi = *(const LAS f32x4*)(tab + 4 * i4);
#pragma unroll
        for (int e = 0; e < 4; ++e) { const float x = vi[e]; const int i = 4 * i4 + e;
            rk0 += (x > vj.x || (x == vj.x && i < a4 + 0)) ? 1 : 0; rk1 += (x > vj.y || (x == vj.y && i < a4 + 1)) ? 1 : 0;
            rk2 += (x > vj.z || (x == vj.z && i < a4 + 2)) ? 1 : 0; rk3 += (x > vj.w || (x == vj.w && i < a4 + 3)) ? 1 : 0; } }
    unsigned m = 0u;
    if (rk0 < 16 && a4 + 0 <= tt) m |= 1u << (a4 + 0); if (rk1 < 16 && a4 + 1 <= tt) m |= 1u << (a4 + 1); if (rk2 < 16 && a4 + 2 <= tt) m |= 1u << (a4 + 2); if (rk3 < 16 && a4 + 3 <= tt) m |= 1u << (a4 + 3);
    m |= (unsigned)__shfl_xor((int)m, 1); m |= (unsigned)__shfl_xor((int)m, 2); m |= (unsigned)__shfl_xor((int)m, 32);
    if (hh == 0 && hi == 0) SELrow[tok] = m;
    LDS_FENCE();
}
#undef FA_LOAD
#undef FA_WRITE
#undef FA_QK
#undef FA_PV
#undef FA_TRRD
#undef FA_VTR_SETUP
#undef FA_SB0
}


__device__ __forceinline__ void cmp_bias(const Ctx& c, const float* pe_k, const float* pe_v, const float* phi_k, const float* phi_v, float* cbias) {
    for (int it = c.gw; it < 256; it += c.ngw) {
        const int which = it >> 7, e = it & 127; const float* pe = which ? pe_v : pe_k; const float* phi = which ? phi_v : phi_k; float s = 0.f;
        for (int k = c.lane; k < 4096; k += 64) s += pe[k] * phi[(size_t)k * 128 + e];
        s = wsum(s); if (c.lane == 0) cbias[it] = s;
    }
}
__device__ __forceinline__ void cmp_mfma(const Ctx& c, const bf16* Y, const bf16* PHIKT, const bf16* PHIVT, float* KCR4, float* VCR4) {
    const int lane = c.lane, r32 = lane & 31, hi = lane >> 5;
    for (int it = c.gw; it < 2048; it += c.ngw) {
        const int lq = it & 3, eb = (it >> 2) & 3, nt = (it >> 4) & 3, bg = (it >> 6) & 15, which = it >> 10, b = bg >> 2, g = bg & 3;
        const int n = (32 * nt + r32) < 126 ? (32 * nt + r32) : 126;
        const bf16* arow = Y + ((size_t)b * T + 16 * n + 8 * lq) * EVEN_LD + (which ? C_VC : C_KC) + g * 128 + hi * 8;
        const bf16* brow = (which ? PHIVT : PHIKT) + (size_t)(32 * eb + r32) * 4096 + (8 * lq) * 128 + hi * 8;
        fa::f32x16 acc = {};
        fa::bf16x8 a0[8], b0[8], a1[8], b1[8];
#define CM_LOAD(l, A_, B_) do { _Pragma("unroll") for (int s8 = 0; s8 < 8; ++s8) { A_[s8] = *(const fa::bf16x8*)(arow + (size_t)(l) * EVEN_LD + 16 * s8); B_[s8] = *(const fa::bf16x8*)(brow + (l) * 128 + 16 * s8); } __builtin_amdgcn_sched_barrier(0); } while (0)
#define CM_MMA(A_, B_) do { _Pragma("unroll") for (int s8 = 0; s8 < 8; ++s8) acc = __builtin_amdgcn_mfma_f32_32x32x16_bf16(A_[s8], B_[s8], acc, 0, 0, 0); __builtin_amdgcn_sched_barrier(0); } while (0)
        CM_LOAD(0, a0, b0);
#pragma unroll 1
        for (int l = 0; l < 8; l += 2) {
            CM_LOAD(l + 1, a1, b1); CM_MMA(a0, b0);
            if (l + 2 < 8) CM_LOAD(l + 2, a0, b0);
            CM_MMA(a1, b1);
        }
#undef CM_LOAD
#undef CM_MMA
        float* dst = (which ? VCR4 : KCR4) + (size_t)lq * (16 * 128 * 128) + ((size_t)bg * 128 + 32 * nt) * 128 + 32 * eb + r32;
#pragma unroll
        for (int r = 0; r < 16; ++r) { const int nn = (r & 3) + 8 * (r >> 2) + 4 * hi; if (32 * nt + nn < 127) dst[nn * 128] = acc[r]; }
    }
}
__device__ __forceinline__ void vt_pass(const Ctx& c, const bf16* Ysrc, int ld, int col0, int nheads, bf16* VT, int NH, int head0, int TL, int dil_mode) {
    LAS unsigned char* scr = c.lds + c.wave * 16384; const int lane = c.lane; const int npb = TL / 32, items = NB * nheads * npb;
    for (int it = c.gw; it < items; it += c.ngw) {
        const int pb = it % npb, bh = it / npb, hh = bh % nheads, b = bh / nheads;
        const int r = dil_mode ? (hh < 8 ? 1 : (hh < 16 ? 4 : 16)) : 1, CL = TL / r, pp0 = 32 * pb, cls = pp0 / CL, i0 = pp0 - cls * CL, tok0 = cls + r * i0;
        const bf16* src = Ysrc + ((size_t)b * TL + tok0) * ld + col0 + hh * 128;
#pragma unroll
        for (int k = 0; k < 8; ++k) { const int ci = lane + 64 * k, rr = ci >> 4, ch = ci & 15; const v4u w = *(const v4u*)(src + (size_t)rr * r * ld + ch * 8);
            LAS unsigned* d2 = (LAS unsigned*)(scr + rr * 264 + ch * 16); d2[0] = w.x; d2[1] = w.y; d2[2] = w.z; d2[3] = w.w; }
        LDS_FENCE();
        bf16* dst = VT + ((size_t)(b * NH + head0 + hh) * 128) * TL + pp0;
#pragma unroll
        for (int k = 0; k < 8; ++k) { const int ci = lane + 64 * k, d = ci >> 2, q4 = ci & 3; const LAS bf16* s = (const LAS bf16*)(scr + (8 * q4) * 264 + 2 * d);
            v4u o; o.x = (unsigned)s[0] | ((unsigned)s[132] << 16); o.y = (unsigned)s[2 * 132] | ((unsigned)s[3 * 132] << 16); o.z = (unsigned)s[4 * 132] | ((unsigned)s[5 * 132] << 16); o.w = (unsigned)s[6 * 132] | ((unsigned)s[7 * 132] << 16);
            *(v4u*)(dst + (size_t)d * TL + 8 * q4) = o; }
        LDS_FENCE();
    }
}
__device__ __forceinline__ void moba_sel_row(const Ctx& c, LAS float* qs, const bf16* Y, const float* kmean, unsigned* SELM, int b, int h, int t) {
    const int lane = c.lane; const size_t row = (size_t)b * T + t;
    load_q(qs, Y + row * EVEN_LD + C_MQ + h * 128, lane);
    const int cur = t >> 8;
    float gate = NEG_INF;
    if (lane < cur) { const float* km = kmean + ((size_t)(b * 16 + h) * 8 + lane) * 128; float s = 0.f; for (int d = 0; d < 128; ++d) s += qs[d] * km[d]; gate = s; }
    int rank = 0;
    for (int m2 = 0; m2 < 8; ++m2) { const float gm = rdlane(gate, m2); rank += (gm > gate || (gm == gate && m2 < lane)) ? 1 : 0; }
    const unsigned selmask = (unsigned)__ballot((lane < cur) && (rank < 3));
    if (lane == 0) SELM[(size_t)(b * 16 + h) * T + t] = selmask;
}
__device__ __forceinline__ void nsa_cmp_item(const Ctx& c, LAS float* qs, LAS float* ps, const bf16* Y, const bf16* KCN, const bf16* VCN, bf16* OC, unsigned* SELN, int b, int g, int t) {
    const int lane = c.lane; const size_t row = (size_t)b * T + t;
    const bf16* Kc = KCN + (size_t)(b * 4 + g) * 128 * 128; const bf16* Vc = VCN + (size_t)(b * 4 + g) * 128 * 128;
    float P0 = 0.f, P1 = 0.f;
    const int n0 = lane, n1 = 64 + lane; const bool v0 = 16 * n0 + 31 <= t, v1 = (n1 < 127) && (16 * n1 + 31 <= t);
#pragma unroll 1
    for (int hh = 0; hh < 4; ++hh) {
        const int h = g * 4 + hh;
        load_q(qs, Y + row * EVEN_LD + C_NQ + h * 128, lane);
        float s0 = dot128(qs, Kc + (v0 ? n0 : 0) * 128) * ATT_SCALE, s1 = dot128(qs, Kc + (v1 ? n1 : 0) * 128) * ATT_SCALE;
        if (!v0) s0 = NEG_INF; if (!v1) s1 = NEG_INF;
        const float m = wmax(fmaxf(s0, s1)); float a0 = 0.f, a1 = 0.f;
        if (m != NEG_INF) {
            float p0 = __expf(s0 - m), p1 = __expf(s1 - m);
            const float inv = 1.0f / fmaxf(wsum(p0 + p1), 1e-30f);
            p0 *= inv; p1 *= inv; P0 += p0; P1 += p1;
            pv_accum(a0, a1, p0, n0 * 128, Vc, lane); pv_accum(a0, a1, p1, (v1 ? n1 : 0) * 128, Vc, lane);
        }
        *(unsigned*)(OC + row * 2048 + h * 128 + 2 * lane) = pk2(a0, a1);
    }
    LDS_FENCE(); ps[lane] = P0; ps[64 + lane] = P1; LDS_FENCE();
    float imp = 0.f;
    if (lane < 32) { for (int n = 4 * lane - 1; n <= 4 * lane + 3; ++n) if (n >= 0 && n < 127) imp += ps[n]; }
    const int cur = t >> 6;
    const float v = (lane >= 32) ? NEG_INF : ((lane == cur || lane == 0) ? __builtin_inff() : (lane <= cur ? imp : NEG_INF));
    int rank = 0;
    for (int m2 = 0; m2 < 32; ++m2) { const float vm = rdlane(v, m2); rank += (vm > v || (vm == v && m2 < lane)) ? 1 : 0; }
    const unsigned selmask = (unsigned)__ballot(lane < 32 && lane <= cur && rank < 16);
    if (lane == 0) SELN[(size_t)(b * 4 + g) * T + t] = selmask;
}
__device__ __forceinline__ void nsa_combine(const Ctx& c, const bf16* Y, const bf16* OC, const bf16* OS, const bf16* OW, bf16* O) {
    const int lane = c.lane;
    for (int it = c.gw; it < MTOK * 16; it += c.ngw) {
        const int row = it >> 4, h = it & 15; const size_t off = (size_t)row * 2048 + h * 128 + 2 * lane;
        const bf16* gl = Y + (size_t)row * EVEN_LD + C_GL + h * 3;
        const float g0 = 1.0f / (1.0f + __expf(-bf2f(gl[0]))), g1 = 1.0f / (1.0f + __expf(-bf2f(gl[1]))), g2 = 1.0f / (1.0f + __expf(-bf2f(gl[2])));
        const unsigned wc = *(const unsigned*)(OC + off), wsv = *(const unsigned*)(OS + off), ww = *(const unsigned*)(OW + off);
        *(unsigned*)(O + (size_t)row * DM + 2048 + h * 128 + 2 * lane) = pk2(g0 * bflo(wc) + g1 * bflo(wsv) + g2 * bflo(ww), g0 * bfhi(wc) + g1 * bfhi(wsv) + g2 * bfhi(ww));
    }
}
__device__ __forceinline__ void dil_combine(const Ctx& c, const bf16* OG, const float* LSE, bf16* O) {
    const int lane = c.lane;
    for (int it = c.gw; it < MTOK * 8; it += c.ngw) {
        const int row = it >> 3, hd = it & 7; const size_t off = (size_t)row * 1024 + hd * 128 + 2 * lane;
        const float l0 = LSE[(size_t)row * 8 + hd], l1 = LSE[(size_t)MTOK * 8 + (size_t)row * 8 + hd], l2 = LSE[(size_t)2 * MTOK * 8 + (size_t)row * 8 + hd];
        const float mx = fmaxf(l0, fmaxf(l1, l2)); const float w0 = __expf(l0 - mx), w1 = __expf(l1 - mx), w2 = __expf(l2 - mx), iw = 1.0f / (w0 + w1 + w2);
        const unsigned a = *(const unsigned*)(OG + off), bq = *(const unsigned*)(OG + (size_t)MTOK * 1024 + off), cq = *(const unsigned*)(OG + (size_t)2 * MTOK * 1024 + off);
        *(unsigned*)(O + (size_t)row * DM + 3072 + hd * 128 + 2 * lane) = pk2((w0 * bflo(a) + w1 * bflo(bq) + w2 * bflo(cq)) * iw, (w0 * bfhi(a) + w1 * bfhi(bq) + w2 * bfhi(cq)) * iw);
    }
}
__device__ __forceinline__ int snake(int round, int b, int G) { return (round & 1) ? round * G + (G - 1 - b) : round * G + b; }

struct Args { const float* in[31]; float* out; unsigned char* ws; int ph_lo, ph_hi; };
#if MK_ONE_LAUNCH
#define GRID_BAR() xcd_barrier(bar)
#else
#define GRID_BAR() do { } while (0)
#endif
#define IN(k) (lo <= (k) && (k) < hi)
#define SEAM(k) do { if (IN(k) && IN((k) + 1)) GRID_BAR(); if (PROBE_MASK != 0ull) { const unsigned long long now_ = __builtin_amdgcn_s_memrealtime(); if ((PROBE_MASK >> (k)) & 1ull) pacc += now_ - pprev; pprev = now_; } } while (0)
template <int layer>
__device__ __forceinline__ void run_layer(const Args& args, const Ctx& c, const XcdBarrier& bar, const int lo, const int hi, unsigned long long& pprev, unsigned long long& pacc) {
    unsigned char* ws = args.ws;
    const float* x_in = args.in[0]; const float* mem = args.in[1]; const int* positions = (const int*)args.in[2];
    float* ropec = (float*)(ws + WS_ROPE); float* ropes = ropec + MTOK * 64;
    float* kmean = (float*)(ws + WS_KMEAN); float* KCR = (float*)(ws + WS_QP); float* VCR = (float*)(ws + WS_QP + 4 * MiB);
    bf16* KCN = (bf16*)(ws + WS_KCN); bf16* VCN = (bf16*)(ws + WS_VCN); bf16* MEMN = (bf16*)(ws + WS_MEMN);
    bf16* QX = (bf16*)(ws + WS_QX); bf16* KVX = (bf16*)(ws + WS_KVX); bf16* OX = (bf16*)(ws + WS_OX);
    bf16* WQ_T = (bf16*)(ws + WS_WQ); bf16* WKV_T = (bf16*)(ws + WS_WKV); bf16* WO_T = (bf16*)(ws + WS_WO); bf16* WOUT_T = (bf16*)(ws + WS_WOUT);
    bf16* WIN_T = (bf16*)(ws + (layer == 0 ? WS_WIN : WS_WIN1)); bf16* WGU_T = (bf16*)(ws + WS_WGU); bf16* WD_T = (bf16*)(ws + (layer == 0 ? WS_WD : WS_WD1));
    float* X = (float*)(ws + WS_X); bf16* H = (bf16*)(ws + WS_H); bf16* O = (bf16*)(ws + WS_O); bf16* Y = (bf16*)(ws + WS_Y); bf16* HID = Y;
    LAS float* qs = (LAS float*)(c.lds + c.wave * 16384); LAS float* ps = qs + 128;
    float* SSQ = (float*)(ws + WS_CTL) + CW_SSQ;
    float* QP = (float*)(ws + WS_QP); bf16* MEMN2 = (bf16*)(ws + WS_MEMN2); bf16* KVX2 = (bf16*)(ws + WS_KVX2); bf16* WKV2 = (bf16*)(ws + WS_WKV2); bf16* KVXL = KVX2 + (size_t)layer * 1024 * 2048;
    bf16* PHIKT = (bf16*)(ws + WS_PHIK); bf16* PHIVT = (bf16*)(ws + WS_PHIV); float* CBIAS = (float*)(ws + WS_CBIAS);
    bf16* VT = (bf16*)(ws + WS_VT); bf16* PART = (bf16*)(ws + WS_PART); bf16* VTX = (bf16*)(ws + WS_VTX); unsigned* SELM = (unsigned*)(ws + WS_SELM); unsigned* SELN = (unsigned*)(ws + WS_SELN);
    constexpr int pb = layer * NPL; constexpr bool even = (layer & 1) == 0;
    const int e_rem1 = ((MTOK / 256) * (EVEN_LD / 256)) % c.G, e_ns1 = e_rem1 ? (c.G - e_rem1 - 32 > 0 ? c.G - e_rem1 - 32 : 0) : 0;
    const int e_rem2 = ((MTOK / 256) * (GU_ROWS / 256)) % c.G, e_ns2 = e_rem2 ? c.G - e_rem2 : 0;
    const int e_it1 = e_ns1 * 8 * EARLY_N1, e_it2 = e_it1 + e_ns2 * 8 * EARLY_N2;
#if FUSE_HEADNORM
#define WIN1_RM RmHeads{0x0FFFFFF000000000ull, 0ull}
#else
#define WIN1_RM RmId{0}
#endif

        const int LDY = even ? EVEN_LD : ODD_LD;
        const float* xcur = layer == 0 ? x_in : X;
#define TK(n) ((unsigned*)(ws + WS_CTL) + CW_TICKET + 64 * (8 * layer + (n)))
        if (IN(pb + 0)) REPS(pb + 0) {
#if FUSE_HEADNORM
            if (even) conv_weight(c, args.in[4], DM, EVEN_N, EVEN_LD, WIN_T, RmHeads{0x330ff00ffffull, 0ull}, layer == 0 ? nullptr : args.in[3] + layer * DM, 0, -1, -1, -1, TK(0)); else conv_weight(c, args.in[16], DM, ODD_LD, ODD_LD, WIN_T, RmHeads{0x0FFFFFF000000000ull, 0ull}, layer == 0 ? nullptr : args.in[3] + layer * DM, layer == 1 ? e_it2 : 0, -1, -1, -1, TK(0));
#else
            if (even) conv_weight(c, args.in[4], DM, EVEN_N, EVEN_LD, WIN_T, RmId{0}, layer == 0 ? nullptr : args.in[3] + layer * DM); else conv_weight(c, args.in[16], DM, ODD_LD, ODD_LD, WIN_T, RmId{0}, layer == 0 ? nullptr : args.in[3] + layer * DM, layer == 1 ? e_it2 : 0);
#endif
            conv_weight(c, even ? args.in[5] : args.in[17], DM, DM, DM, WOUT_T, RmId{0}, nullptr, 0, -1, -1, -1, TK(1));
            conv_weight(c, args.in[22] + (size_t)layer * DM * XW, DM, XW, XW, WQ_T, RmId{0}, args.in[20] + layer * DM);
            if constexpr (layer == 0) { conv_weight(c, args.in[23], DM, 2 * XW, 2 * XW, WKV2, RmId{0}); conv_weight(c, args.in[23] + (size_t)DM * 2 * XW, DM, 2 * XW, 2 * XW, WKV2, RmId{1024}); }
            conv_weight(c, args.in[24] + (size_t)layer * XW * DM, XW, DM, DM, WO_T, RmId{0});
            conv_weight(c, args.in[28] + (size_t)layer * DM * FFN, DM, FFN, FFN, WGU_T, RmGU{0}, args.in[27] + layer * DM, 0, -1, -1, -1, TK(2));
            conv_weight(c, args.in[29] + (size_t)layer * DM * FFN, DM, FFN, FFN, WGU_T, RmGU{1}, args.in[27] + layer * DM, 0, -1, -1, -1, TK(3));
            conv_weight(c, args.in[30] + (size_t)layer * FFN * DM, FFN, DM, DM, WD_T, RmId{0}, nullptr, 0, -1, -1, -1, TK(4));
            if (layer == 0) rope_table(c, positions, ropec, ropes);
            if constexpr (even) { conv_weight(c, args.in[14], 4096, 128, 128, PHIKT, RmId{0}); conv_weight(c, args.in[15], 4096, 128, 128, PHIVT, RmId{0}); cmp_bias(c, args.in[12], args.in[13], args.in[14], args.in[15], CBIAS); }
            if constexpr (layer == 0) { rmsnorm_rows(c, mem, args.in[21], MEMN2, MEM_ROWS); rmsnorm_rows(c, mem, args.in[21] + DM, MEMN2 + (size_t)MEM_ROWS * DM, MEM_ROWS); }
            if constexpr (layer == 0) rmsnorm_rows(c, xcur, args.in[3] + layer * DM, H, MTOK);
        }
        SEAM(pb + 0);
        if (IN(pb + 1)) REPS(pb + 1) {
            pg8::Gemm g{H, WIN_T, MTOK, LDY, DM, DM}; pg8::StaticOrder S; S.init(MTOK, LDY, c.G, (int)blockIdx.x);
#if FUSE_HEADNORM
            pg8::HeadSpec hs{};
            if (even) { hs.lo[0] = 0; hs.hi[0] = 8; hs.g[0] = args.in[6]; hs.lo[1] = 8; hs.hi[1] = 16; hs.g[1] = args.in[7]; hs.lo[2] = 24; hs.hi[2] = 32; hs.g[2] = args.in[8]; hs.lo[3] = 36; hs.hi[3] = 38; hs.g[3] = args.in[10]; hs.lo[4] = 40; hs.hi[4] = 42; hs.g[4] = args.in[11]; }
            else { hs.lo[0] = 36; hs.hi[0] = 48; hs.g[0] = args.in[18]; hs.lo[1] = 48; hs.hi[1] = 60; hs.g[1] = args.in[19]; }
            pg8::EpiYHeads E{Y, LDY, layer == 0 ? nullptr : SSQ + (size_t)((layer - 1) * 3 + 2) * MTOK, hs, ropec, ropes, (LAS float*)(c.lds + 132096)};
            pg8::gemm_phase<pg8::EpiYHeads, pg8::StaticOrder, true, true>(c.lds, g, S, E);
#else
            pg8::EpiBf16P E{Y, LDY, layer == 0 ? nullptr : SSQ + (size_t)((layer - 1) * 3 + 2) * MTOK};
            pg8::gemm_phase<pg8::EpiBf16P, pg8::StaticOrder, true, true>(c.lds, g, S, E);
#endif
            if constexpr (layer == 0) {
                pg8::Gemm g2{MEMN2, WKV2, 2 * MEM_ROWS, 2 * 1024, DM, DM}; pg8::DiagOrder S2; S2.init(2, 4, 4, c.G, c.G - 1 - (int)blockIdx.x); pg8::EpiBf16P E2{KVX2, 2048, nullptr};
                pg8::gemm_phase<pg8::EpiBf16P, pg8::DiagOrder, true, true>(c.lds, g2, S2, E2);
                const int j1 = (int)blockIdx.x - e_rem1;
                if (j1 >= 0 && j1 < e_ns1) { __syncthreads(); conv_weight<decltype(WIN1_RM), EARLY_NT != 0>(c, args.in[16], DM, ODD_LD, ODD_LD, (bf16*)(ws + WS_WIN1), WIN1_RM, args.in[3] + DM, 0, e_it1, j1 * 8 + c.wave, e_ns1 * 8); }
            }
        }
        SEAM(pb + 1);
        if constexpr (even || !FUSE_HEADNORM) {
        if (IN(pb + 2)) REPS(pb + 2) {
            if (even) {
#if !FUSE_HEADNORM
                headnorm_bf16(c, Y, EVEN_LD, C_MQ, 16, MTOK, args.in[6], ropec, ropes);
                headnorm_bf16(c, Y, EVEN_LD, C_MK, 16, MTOK, args.in[7], ropec, ropes);
                headnorm_bf16(c, Y, EVEN_LD, C_NQ, 16, MTOK, args.in[8], ropec, ropes);
                headnorm_bf16(c, Y, EVEN_LD, C_KS, 4, MTOK, args.in[10], ropec, ropes);
                headnorm_bf16(c, Y, EVEN_LD, C_KW, 4, MTOK, args.in[11], ropec, ropes);
#endif
                cmp_mfma(c, Y, PHIKT, PHIVT, KCR, VCR);
#if FUSE_HEADNORM
                moba_kmean(c, Y, kmean);
#endif
            } else {
#if !FUSE_HEADNORM
                headnorm_bf16(c, Y, ODD_LD, C_DQ, 24, MTOK, args.in[18], ropec, ropes);
                headnorm_bf16(c, Y, ODD_LD, C_DK, 24, MTOK, args.in[19], ropec, ropes);
#endif
            }
        }
        SEAM(pb + 2);
        }
        if constexpr (even) {
            if (IN(pb + 3)) REPS(pb + 3) { cmp_finish(c, KCR, VCR, CBIAS, KCN, VCN, args.in[9], ropec, ropes); if (!FUSE_HEADNORM) moba_kmean(c, Y, kmean); }
            SEAM(pb + 3);
            if (IN(pb + 4)) REPS(pb + 4) {
#if FA_EVEN
                for (int idx = (int)blockIdx.x; idx < NB * 4 * 32; idx += c.G) { const int tt = 31 - (idx >> 4), bg = idx & 15, b = bg >> 2, g = bg & 3; const size_t r0 = (size_t)b * T + 64 * tt;
                    fa::cmp_unit(c, Y + r0 * EVEN_LD + C_NQ + 4 * g * 128, EVEN_LD, KCN + (size_t)bg * 128 * 128, VCN + (size_t)bg * 128 * 128, PART + r0 * 2048 + 4 * g * 128, SELN + (size_t)bg * T + 64 * tt, tt); }
#endif
            }
            SEAM(pb + 4);
        }
        if (IN(pb + 5)) REPS(pb + 5) {
            if constexpr (even && !FA_EVEN) {
                for (int it = c.gw; it < NB * 16 * T; it += c.ngw) { const int bh = it >> 11; moba_row(c, qs, Y, kmean, O, bh >> 4, bh & 15, spread_t(it)); }
                for (int it = c.gw; it < NB * 4 * T; it += c.ngw) { const int bg = it >> 11; nsa_item(c, qs, ps, Y, KCN, VCN, O, bg >> 2, bg & 3, spread_t(it)); }
            } else if constexpr (!even && !FA_ODD) {
                for (int it = c.gw; it < NB * 24 * T; it += c.ngw) { const int bh = it >> 11; sb_row(c, qs, Y, O, bh / 24, bh % 24, spread_t(it)); }
                for (int it = c.gw; it < NB * 8 * T; it += c.ngw) { const int bh = it >> 11; dil_row(c, qs, Y, O, bh >> 3, bh & 7, spread_t(it)); }
            } else if constexpr (even) {
                bf16* OS = PART + (size_t)MTOK * 2048; bf16* OW = PART + (size_t)2 * MTOK * 2048;
                for (int blk = (int)blockIdx.x; blk < 256; blk += c.G)
#pragma unroll 1
                for (int round = 0; round < 3; ++round) {
                    const int xcd = blk & 7, slot = blk >> 3;
#pragma unroll 1
                    for (int half = 0; half < 2; ++half) {
                        fa::Unit u; u.qp = nullptr; u.qgain = nullptr; u.qssq = nullptr; u.qps = 0; u.comb_gl = nullptr; u.comb_oc = nullptr; u.comb_os = nullptr; u.comb_gls = 0; u.kmean = nullptr; u.lse = nullptr; u.lse_stride = 0; u.causal = 1; u.nrows = 256; u.qstride = EVEN_LD; u.kstride = EVEN_LD; u.vstride = EVEN_LD; u.sel_stride = 1; u.t_lo = 0; u.window = 1 << 30;
                        u.sel = nullptr; u.sel_shift = 0; u.own_blk = -1;
                        if (round == 0) {
                            const int fam = xcd * 8 + (slot >> 2), pr = slot & 3, qb = half ? pr : 7 - pr, b = fam >> 4, h = fam & 15; const size_t r0 = (size_t)b * T + 256 * qb;
                            u.pos0 = 256 * qb; u.t_hi = 4 * qb + 4;
                            u.q = Y + r0 * EVEN_LD + C_MQ + h * 128; u.k = Y + (size_t)b * T * EVEN_LD + C_MK + h * 128; u.v = Y + (size_t)b * T * EVEN_LD + C_MV + h * 128;
                            u.o = O + r0 * DM + h * 128; u.ostride = DM; u.kmean = kmean + (size_t)(b * 16 + h) * 8 * 128; u.sel_shift = 2; u.own_blk = qb;
                        } else {
                            const int fam = xcd * 2 + (slot >> 4), j = slot & 15, hh = j >> 2, pr = j & 3, b = fam >> 2, g = fam & 3, h = g * 4 + hh;
                            const int qb = half ? pr : 7 - pr; const size_t r0 = (size_t)b * T + 256 * qb;
                            u.pos0 = 256 * qb; u.t_hi = 4 * qb + 4; u.q = Y + r0 * EVEN_LD + C_NQ + h * 128; u.ostride = 2048;
                            if (round == 1) { u.k = Y + (size_t)b * T * EVEN_LD + C_KS + g * 128; u.v = Y + (size_t)b * T * EVEN_LD + C_VS + g * 128; u.o = OS + r0 * 2048 + h * 128; u.sel = SELN + (size_t)(b * 4 + g) * T + 256 * qb; }
                            else { u.k = Y + (size_t)b * T * EVEN_LD + C_KW + g * 128; u.v = Y + (size_t)b * T * EVEN_LD + C_VW + g * 128; u.t_lo = qb >= 2 ? 4 * qb - 8 : 0; u.window = 512;
                                u.o = O + r0 * DM + 2048 + h * 128; u.ostride = DM; u.comb_oc = PART + r0 * 2048 + h * 128; u.comb_os = OS + r0 * 2048 + h * 128; u.comb_gl = Y + r0 * EVEN_LD + C_GL + h * 3; u.comb_gls = EVEN_LD; }
                        }
                        fa::run_unit<0>(c, u);
                    }
                }
            } else {
                float* LSE = (float*)(ws + WS_LSE);
                if constexpr (!FA_SB) { for (int it = c.gw; it < NB * 24 * T; it += c.ngw) { const int bh = it >> 11; sb_row(c, qs, Y, O, bh / 24, bh % 24, spread_t(it)); } }
                if constexpr (!FA_DIL) { for (int it = c.gw; it < NB * 8 * T; it += c.ngw) { const int bh = it >> 11; dil_row(c, qs, Y, O, bh >> 3, bh & 7, spread_t(it)); } }
                for (int round = 0; round < 7 * 256 / c.G + 1; ++round) {
                    const int idx = snake(round, (int)blockIdx.x, c.G); if (idx >= 1792) continue;
                    if (!FA_SB && idx < 768) continue;
                    if (!FA_DIL && idx >= 768) continue;
#ifdef PROBE_SKIP_DIL
                    if (idx >= 768) continue;
#endif
#ifdef PROBE_SKIP_SB
                    if (idx < 768) continue;
#endif
                    fa::Unit u; u.qp = nullptr; u.qgain = nullptr; u.qssq = nullptr; u.qps = 0; u.comb_gl = nullptr; u.comb_oc = nullptr; u.comb_os = nullptr; u.comb_gls = 0; u.kmean = nullptr; u.lse = nullptr; u.lse_stride = 0; u.causal = 1; u.nrows = 256; u.qstride = ODD_LD; u.kstride = ODD_LD; u.vstride = ODD_LD; u.sel = nullptr; u.sel_stride = 0; u.sel_shift = 0; u.own_blk = -1; u.t_lo = 0; u.window = 1 << 30;
                    if (idx < 768) {
                        const int qb = 7 - idx / 96, bh = idx % 96, b = bh / 24, h = bh % 24; const size_t r0 = (size_t)b * T + 256 * qb;
                        u.pos0 = 256 * qb; u.t_hi = 4 * qb + 4;
                        u.q = Y + r0 * ODD_LD + C_SQ + h * 128; u.k = Y + (size_t)b * T * ODD_LD + C_SK + h * 128; u.v = Y + (size_t)b * T * ODD_LD + C_SV + h * 128; u.o = O + r0 * DM + h * 128; u.ostride = DM;
                        fa::run_unit<1>(c, u);
                    } else {
                        int gi, r, b, hd, cls, un;
                        if (idx < 1024) { const int j = idx - 768; gi = 0; r = 1; un = j & 7; hd = (j >> 3) & 7; b = j >> 6; cls = 0; }
                        else if (idx < 1280) { const int j = idx - 1024; gi = 1; r = 4; un = j & 1; cls = (j >> 1) & 3; hd = (j >> 3) & 7; b = j >> 6; }
                        else { const int j = idx - 1280; gi = 2; r = 16; un = 0; cls = j & 15; hd = (j >> 4) & 7; b = j >> 7; }
                        const int nd = gi * 8 + hd, CL = T / r; const size_t tok0 = (size_t)b * T + cls + (size_t)r * 256 * un;
                        u.nrows = CL < 256 ? CL : 256; u.pos0 = 256 * un; u.t_lo = un > 0 ? 4 * un - 2 : 0; u.t_hi = (4 * un + 4) < CL / 64 ? (4 * un + 4) : CL / 64; u.window = 129;
                        u.qstride = r * ODD_LD; u.kstride = r * ODD_LD; u.vstride = r * ODD_LD;
                        u.q = Y + tok0 * ODD_LD + C_DQ + nd * 128; u.k = Y + ((size_t)b * T + cls) * ODD_LD + C_DK + nd * 128; u.v = Y + ((size_t)b * T + cls) * ODD_LD + C_DV + nd * 128;
                        u.o = PART + (size_t)gi * MTOK * 1024 + tok0 * 1024 + hd * 128; u.ostride = r * 1024; u.lse = LSE + (size_t)gi * MTOK * 8 + tok0 * 8 + hd; u.lse_stride = r * 8;
                        fa::run_unit<0>(c, u);
                    }
                }
            }
        }
        SEAM(pb + 5);
        if constexpr (!even) {
            if (IN(pb + 6)) REPS(pb + 6) { if constexpr (FA_ODD && FA_DIL) dil_combine(c, PART, (const float*)(ws + WS_LSE), O); }
            SEAM(pb + 6);
        }
        if (IN(pb + 7)) REPS(pb + 7) {
            pg8::Gemm g{O, WOUT_T, MTOK, DM, DM, DM}; pg8::StaticOrder S; S.init(MTOK, DM, c.G, (int)blockIdx.x);
#if RES_BF16
            if constexpr (layer == 0) { pg8::EpiResBf16N<float> E{x_in, DM, H, SSQ + (size_t)(layer * 3 + 0) * MTOK}; pg8::gemm_phase<pg8::EpiResBf16N<float>, pg8::StaticOrder, true, true>(c.lds, g, S, E); }
            else { pg8::EpiResBf16N<bf16> E{H, DM, H, SSQ + (size_t)(layer * 3 + 0) * MTOK}; pg8::gemm_phase<pg8::EpiResBf16N<bf16>, pg8::StaticOrder, true, true>(c.lds, g, S, E); }
#else
            pg8::EpiResF32N E{xcur, X, DM, H, SSQ + (size_t)(layer * 3 + 0) * MTOK};
            pg8::gemm_phase<pg8::EpiResF32N, pg8::StaticOrder, true, true>(c.lds, g, S, E);
#endif
        }
        SEAM(pb + 7);
        if (IN(pb + 9)) REPS(pb + 9) {
            pg8::Gemm g{H, WQ_T, MTOK, XW, DM, DM / 4}; pg8::SplitKOrder S; S.init(MTOK, XW, 4, c.G, (int)blockIdx.x); pg8::EpiF32Part E{QP, XW, (size_t)MTOK * XW};
            pg8::gemm_phase<pg8::EpiF32Part, pg8::SplitKOrder, true, true>(c.lds, g, S, E);
            headnorm_bf16(c, KVXL, 2048, layer * 1024, 4, MEM_ROWS, args.in[26] + layer * HD, nullptr, nullptr);
        }
        SEAM(pb + 9);
        if (IN(pb + 11)) REPS(pb + 11) {
            if constexpr (!FA_XATTN) { for (int it = c.gw; it < NB * 4 * T; it += c.ngw) { const int bh = it >> 11; xattn_row(c, qs, QX, KVX, OX, bh >> 2, bh & 3, it & (T - 1)); } }
            else for (int idx = (int)blockIdx.x; idx < 128; idx += c.G) {
                const int qb = idx & 7, bh = idx >> 3, b = bh >> 2, h = bh & 3; const size_t r0 = (size_t)b * T + 256 * qb;
                fa::Unit u; u.qp = nullptr; u.qgain = nullptr; u.qssq = nullptr; u.qps = 0; u.comb_gl = nullptr; u.comb_oc = nullptr; u.comb_os = nullptr; u.comb_gls = 0; u.kmean = nullptr; u.lse = nullptr; u.lse_stride = 0; u.causal = 0; u.nrows = 256; u.qstride = XW; u.kstride = 2048; u.vstride = 2048; u.sel = nullptr; u.sel_stride = 0; u.sel_shift = 0; u.own_blk = -1;
                u.t_lo = 0; u.t_hi = 4; u.window = 1 << 30; u.pos0 = 0;
                u.q = nullptr; u.qp = QP + r0 * XW + h * 128; u.qps = (size_t)MTOK * XW; u.qgain = args.in[25] + layer * HD; u.qssq = SSQ + (size_t)(layer * 3 + 0) * MTOK + r0; u.k = KVXL + (size_t)b * MEM_LEN * 2048 + layer * 1024 + h * 128; u.v = KVXL + (size_t)b * MEM_LEN * 2048 + layer * 1024 + XW + h * 128; u.o = OX + r0 * XW + h * 128; u.ostride = XW;
                fa::run_unit<0>(c, u);
            }
        }
        SEAM(pb + 11);
        if (IN(pb + 12)) REPS(pb + 12) {
            pg8::Gemm g{OX, WO_T, MTOK, DM, XW, XW}; pg8::StaticOrder S; S.init(MTOK, DM, c.G, (int)blockIdx.x);
#if RES_BF16
            pg8::EpiResBf16N<bf16> E{H, DM, H, SSQ + (size_t)(layer * 3 + 1) * MTOK}; pg8::gemm_phase<pg8::EpiResBf16N<bf16>, pg8::StaticOrder, true, true>(c.lds, g, S, E);
#else
            pg8::EpiResF32N E{X, X, DM, H, SSQ + (size_t)(layer * 3 + 1) * MTOK};
            pg8::gemm_phase<pg8::EpiResF32N, pg8::StaticOrder, true, true>(c.lds, g, S, E);
#endif
        }
        SEAM(pb + 12);
        if (IN(pb + 14)) REPS(pb + 14) {
            pg8::Gemm g{H, WGU_T, MTOK, GU_ROWS, DM, DM}; pg8::StaticOrder S; S.init(MTOK, GU_ROWS, c.G, (int)blockIdx.x);
            pg8::EpiSwiGLU E{HID, FFN, SSQ + (size_t)(layer * 3 + 1) * MTOK};
            pg8::gemm_phase<pg8::EpiSwiGLU, pg8::StaticOrder, true, true>(c.lds, g, S, E);
            if constexpr (layer == 0) { const int j2 = (int)blockIdx.x - e_rem2;
                if (e_ns2 > 0 && j2 >= 0) { __syncthreads(); conv_weight<decltype(WIN1_RM), EARLY_NT != 0>(c, args.in[16], DM, ODD_LD, ODD_LD, (bf16*)(ws + WS_WIN1), WIN1_RM, args.in[3] + DM, e_it1, e_it2, j2 * 8 + c.wave, e_ns2 * 8); } }
        }
        SEAM(pb + 14);
        if (IN(pb + 15)) REPS(pb + 15) {
            pg8::Gemm g{HID, WD_T, MTOK, DM, FFN, FFN}; pg8::StaticOrder S; S.init(MTOK, DM, c.G, (int)blockIdx.x);
#if RES_BF16
            if constexpr (layer == 1) { pg8::EpiOutBf16Res E{H, args.out, DM}; pg8::gemm_phase<pg8::EpiOutBf16Res, pg8::StaticOrder, true, true>(c.lds, g, S, E); }
            else { pg8::EpiResBf16N<bf16> E{H, DM, H, SSQ + (size_t)(layer * 3 + 2) * MTOK}; pg8::gemm_phase<pg8::EpiResBf16N<bf16>, pg8::StaticOrder, true, true>(c.lds, g, S, E); }
#else
            if constexpr (layer == 1) { pg8::EpiResF32 E{X, args.out, DM}; pg8::gemm_phase<pg8::EpiResF32, pg8::StaticOrder, true, true>(c.lds, g, S, E); }
            else { pg8::EpiResF32N E{X, X, DM, H, SSQ + (size_t)(layer * 3 + 2) * MTOK}; pg8::gemm_phase<pg8::EpiResF32N, pg8::StaticOrder, true, true>(c.lds, g, S, E); }
#endif
        }
        if constexpr (layer == 0) { if (PROBE_MASK != 0ull) SEAM(pb + 15); } else if (PROBE_MASK != 0ull) { GRID_BAR(); const unsigned long long now_ = __builtin_amdgcn_s_memrealtime(); if ((PROBE_MASK >> (pb + 15)) & 1ull) pacc += now_ - pprev; pprev = now_; }
}
__global__ void __launch_bounds__(NWAVES * 64, 2) fwd(Args args) {
    extern __shared__ __attribute__((aligned(16))) unsigned char lds_raw[];
    Ctx c; c.lds = (LAS unsigned char*)lds_raw; c.tid = threadIdx.x; c.lane = c.tid & 63; c.wave = __builtin_amdgcn_readfirstlane(c.tid >> 6);
    c.G = gridDim.x; c.gw = blockIdx.x * NWAVES + c.wave; c.ngw = c.G * NWAVES;
    unsigned* ctl = (unsigned*)(args.ws + WS_CTL);
    for (int u = c.tid; u < (LDS_BYTES - LDSCTL_OFF) / 4; u += NWAVES * 64) ((LAS unsigned*)(c.lds + LDSCTL_OFF))[u] = 0u;
    __syncthreads();
#if MK_ONE_LAUNCH
    XcdBarrier bar = xcd_barrier_post(ctl + CW_BAR, (volatile LAS unsigned*)(c.lds + MISC_OFF + 32));
#else
    XcdBarrier bar; bar.bar = ctl + CW_BAR; bar.x = 0; bar.st = nullptr;
#endif
    const int lo = args.ph_lo, hi = args.ph_hi;
    unsigned long long pprev = 0ull, pacc = 0ull;
    if (PROBE_MASK != 0ull) pprev = __builtin_amdgcn_s_memrealtime();
    run_layer<0>(args, c, bar, lo, hi, pprev, pacc);
    run_layer<1>(args, c, bar, lo, hi, pprev, pacc);
    if (PROBE_MASK != 0ull) { GRID_BAR(); if (blockIdx.x == 0 && c.tid == 0) args.out[0] += ((float)pacc * 0.01f - PROBE_OFF) * PROBE_SCALE; }
}
#undef IN
#undef SEAM

extern "C" void kernel_launch(void* const* d_in, const int* in_sizes, int n_in, void* d_out, int out_size, void* d_ws, size_t ws_size, hipStream_t stream) {
    static int grid = 0;
    if (grid == 0) {
        if (n_in != 31 || out_size != MTOK * DM || ws_size < WS_END) { fprintf(stderr, "kernel_launch: unexpected shapes (n_in %d, out %d, ws %zu)\n", n_in, out_size, ws_size); grid = -1; return; }
        int dev = 0, cus = 0;
        if (hipGetDevice(&dev) != hipSuccess || hipDeviceGetAttribute(&cus, hipDeviceAttributeMultiprocessorCount, dev) != hipSuccess) { grid = -1; return; }
        if (hipFuncSetAttribute((const void*)fwd, hipFuncAttributeMaxDynamicSharedMemorySize, LDS_BYTES) != hipSuccess) { fprintf(stderr, "kernel_launch: hipFuncSetAttribute failed\n"); grid = -1; return; }
        int per_cu = 0;
        if (hipOccupancyMaxActiveBlocksPerMultiprocessor(&per_cu, (const void*)fwd, NWAVES * 64, LDS_BYTES) != hipSuccess || per_cu < 1) fprintf(stderr, "kernel_launch: occupancy query reports %d\n", per_cu);
        (void)hipGetLastError();
        grid = cus;
    }
    if (grid < 0) return;
    (void)hipMemsetAsync((char*)d_ws + WS_CTL, 0, CTL_ZERO_BYTES, stream);
#ifdef EXTRA_MEMSET
    (void)hipMemsetAsync((char*)d_ws + WS_END, 0, 256, stream);
#endif
    Args a{};
    for (int i = 0; i < 31; ++i) a.in[i] = (const float*)d_in[i];
    a.out = (float*)d_out; a.ws = (unsigned char*)d_ws;
#if MK_ONE_LAUNCH
    a.ph_lo = 0; a.ph_hi = NPH;
    hipLaunchKernelGGL(fwd, dim3(grid), dim3(NWAVES * 64), LDS_BYTES, stream, a);
#else
    for (int ph = 0; ph < NPH; ++ph) {
        if (ph == 3 + NPL || ph == 4 + NPL || ph == 6 || (ph % NPL) == 8 || (ph % NPL) == 10 || (ph % NPL) == 13) continue;
        a.ph_lo = ph; a.ph_hi = ph + 1;
        hipLaunchKernelGGL(fwd, dim3(grid), dim3(NWAVES * 64), LDS_BYTES, stream, a);
    }
#endif
}
```

```cpp
#define MK_ONE_LAUNCH 1
#define RES_BF16 1
#define FUSE_HEADNORM 1
#define EARLY_N1 16
#define EARLY_N2 16
#define EARLY_NT 0
#include <hip/hip_runtime.h>
#include <cstdio>
#include <cstdint>
namespace pg8 {
#define PG8_LAS __attribute__((address_space(3)))
typedef unsigned short bf16_t;
typedef short bf16x8 __attribute__((ext_vector_type(8)));
typedef float f32x4 __attribute__((ext_vector_type(4)));
typedef unsigned u32x4 __attribute__((ext_vector_type(4)));
constexpr int BM = 256, BK = 64, HALF = 128, HTB = HALF * BK * 2  , STAGE_BYTES = 8 * HTB, NXCD = 8, WGM = 8;

__host__ __device__ __forceinline__ int lds_byte(int r, int c) { const int st = (r >> 4) * 2 + (c >> 5), rr = r & 15, cc = c & 31, ob = rr * 64 + cc * 2; return st * 1024 + (ob ^ (((ob >> 9) & 1) << 5)); }
__host__ __device__ __forceinline__ void stage_rc(int b, int& R, int& C) { const int st = b / 1024, sb = b % 1024, swz = sb ^ (((sb >> 9) & 1) << 5); R = (st >> 1) * 16 + swz / 64; C = (st & 1) * 32 + (swz % 64) / 2; }
__host__ __device__ __forceinline__ int perm32(int rho) { const int n = rho >> 4, i = rho & 15; return 8 * (i >> 2) + 4 * n + (i & 3); }

struct Unit { int pm, pn, ks; };
struct Gemm { const bf16_t* A; const bf16_t* Bt; int M, N, K, KL; };

struct StaticOrder {
    int nM, nN, nwg, G, c;
    __host__ __device__ void init(int M, int N, int G_, int c_) { nM = M / BM; nN = N / BM; nwg = nM * nN; G = G_; c = c_; }
    __host__ __device__ bool next(int i, Unit& u) const {
        const long L = (long)i * G + c; if (L >= nwg) return false;
        int wgid = (int)L; { const int q = nwg / NXCD, r = nwg % NXCD, xcd = wgid % NXCD, off = wgid / NXCD; wgid = (xcd < r ? xcd * (q + 1) : r * (q + 1) + (xcd - r) * q) + off; }
        const int nig = WGM * nN, gid = wgid / nig, fm = gid * WGM, gsz = (nM - fm) < WGM ? (nM - fm) : WGM;
        u.pm = fm + ((wgid % nig) % gsz); u.pn = (wgid % nig) / gsz; u.ks = 0; return true;
    }
    __device__ __forceinline__ void a_ready(const Unit&) const {}
    __device__ __forceinline__ void done(const Unit&) const {}
};
struct SplitKOrder {
    int nN, nS, total, G, c;
    __host__ __device__ void init(int M, int N, int nS_, int G_, int c_) { nN = N / BM; nS = nS_; total = (M / BM) * nN * nS; G = G_; c = c_; }
    __host__ __device__ bool next(int i, Unit& u) const { const long L = (long)i * G + c; if (L >= total) return false; const int l = (int)L; u.ks = l % nS; const int r = l / nS; u.pn = r % nN; u.pm = r / nN; return true; }
    __device__ __forceinline__ void a_ready(const Unit&) const {}
    __device__ __forceinline__ void done(const Unit&) const {}
};
struct DiagOrder {
    int bm, bn, total, G, c;
    __host__ __device__ void init(int nblk, int bm_, int bn_, int G_, int c_) { bm = bm_; bn = bn_; total = nblk * bm * bn; G = G_; c = c_; }
    __host__ __device__ bool next(int i, Unit& u) const { const long L = (long)i * G + c; if (L >= total) return false; const int l = (int)L, blk = l / (bm * bn), r = l % (bm * bn); u.pm = blk * bm + r / bn; u.pn = blk * bn + r % bn; u.ks = 0; return true; }
    __device__ __forceinline__ void a_ready(const Unit&) const {}
    __device__ __forceinline__ void done(const Unit&) const {}
};

typedef float f32x2c_t __attribute__((ext_vector_type(2)));
typedef __bf16 bf16x2c_t __attribute__((ext_vector_type(2)));
__device__ __forceinline__ unsigned cvt_pk_bf16(float lo, float hi) { const f32x2c_t v = {lo, hi}; const bf16x2c_t b = __builtin_convertvector(v, bf16x2c_t); return __builtin_bit_cast(unsigned, b); }
typedef float f32x2 __attribute__((ext_vector_type(2)));
__device__ __forceinline__ float row_rstd(const float* ssq, int row) { return ssq ? 1.0f / sqrtf(ssq[row] * (1.0f / 4096.0f) + 1e-6f) : 1.0f; }
struct EpiBf16P {
    static constexpr bool PERM = true, AFTER_DRAIN = false;
    bf16_t* O; int ldc; const float* ssq;
    __device__ __forceinline__ void operator()(const f32x4 (&acc)[2][2][4][2], const Unit& u, int wr, int wc, int fr, int fq) const {
        const int row0 = u.pm * BM + wr * 64 + fr, col0 = u.pn * BM + wc * 32 + 8 * fq;
#pragma unroll
        for (int ai = 0; ai < 2; ++ai)
#pragma unroll
            for (int m = 0; m < 4; ++m) { bf16_t* rowp = O + (size_t)(row0 + ai * HALF + m * 16) * ldc + col0; const float rs = row_rstd(ssq, row0 + ai * HALF + m * 16);
#pragma unroll
                for (int bj = 0; bj < 2; ++bj) { const f32x4 v0 = acc[ai][bj][m][0] * rs, v1 = acc[ai][bj][m][1] * rs;
                    u32x4 w; w.x = cvt_pk_bf16(v0[0], v0[1]); w.y = cvt_pk_bf16(v0[2], v0[3]); w.z = cvt_pk_bf16(v1[0], v1[1]); w.w = cvt_pk_bf16(v1[2], v1[3]);
                    *(u32x4*)(rowp + bj * HALF) = w; } }
    }
};
struct EpiResF32 {
    static constexpr bool PERM = true, AFTER_DRAIN = false;
    const float* base; float* out; int ldc;
    __device__ __forceinline__ void operator()(const f32x4 (&acc)[2][2][4][2], const Unit& u, int wr, int wc, int fr, int fq) const {
        const int row0 = u.pm * BM + wr * 64 + fr, col0 = u.pn * BM + wc * 32 + 8 * fq;
#pragma unroll
        for (int ai = 0; ai < 2; ++ai)
#pragma unroll
            for (int m = 0; m < 4; ++m) { const size_t off = (size_t)(row0 + ai * HALF + m * 16) * ldc + col0;
#pragma unroll
                for (int bj = 0; bj < 2; ++bj) { const f32x4 b0 = *(const f32x4*)(base + off + bj * HALF), b1 = *(const f32x4*)(base + off + bj * HALF + 4);
                    *(f32x4*)(out + off + bj * HALF) = b0 + acc[ai][bj][m][0]; *(f32x4*)(out + off + bj * HALF + 4) = b1 + acc[ai][bj][m][1]; }
                asm volatile("" ::: "memory"); }
    }
};
__device__ __forceinline__ float silu_mul(float g, float u) { return g * __builtin_amdgcn_rcpf(1.0f + __builtin_amdgcn_exp2f(-1.4426950408889634f * g)) * u; }
struct EpiSwiGLU {
    static constexpr bool PERM = true, AFTER_DRAIN = false;
    bf16_t* O; int ldc; const float* ssq;
    __device__ __forceinline__ void operator()(const f32x4 (&acc)[2][2][4][2], const Unit& u, int wr, int wc, int fr, int fq) const {
        const int row0 = u.pm * BM + wr * 64 + fr, col0 = u.pn * HALF + wc * 32 + 8 * fq;
#pragma unroll
        for (int ai = 0; ai < 2; ++ai)
#pragma unroll
            for (int m = 0; m < 4; ++m) { bf16_t* rowp = O + (size_t)(row0 + ai * HALF + m * 16) * ldc + col0; const float rs = row_rstd(ssq, row0 + ai * HALF + m * 16);
                const f32x4 g0 = acc[ai][0][m][0] * rs, g1 = acc[ai][0][m][1] * rs, u0 = acc[ai][1][m][0] * rs, u1 = acc[ai][1][m][1] * rs;
                u32x4 w; w.x = cvt_pk_bf16(silu_mul(g0[0], u0[0]), silu_mul(g0[1], u0[1])); w.y = cvt_pk_bf16(silu_mul(g0[2], u0[2]), silu_mul(g0[3], u0[3]));
                w.z = cvt_pk_bf16(silu_mul(g1[0], u1[0]), silu_mul(g1[1], u1[1])); w.w = cvt_pk_bf16(silu_mul(g1[2], u1[2]), silu_mul(g1[3], u1[3]));
                *(u32x4*)rowp = w; }
    }
};
struct EpiF32Part {
    static constexpr bool PERM = false, AFTER_DRAIN = false;
    float* P; int ldc; size_t part_stride;
    __device__ __forceinline__ void operator()(const f32x4 (&acc)[2][2][4][2], const Unit& u, int wr, int wc, int fr, int fq) const {
        const int row0 = u.pm * BM + wr * 64 + fr, col0 = u.pn * BM + wc * 32 + 4 * fq; float* base = P + (size_t)u.ks * part_stride;
#pragma unroll
        for (int ai = 0; ai < 2; ++ai)
#pragma unroll
            for (int m = 0; m < 4; ++m) { const size_t off = (size_t)(row0 + ai * HALF + m * 16) * ldc + col0;
#pragma unroll
                for (int bj = 0; bj < 2; ++bj)
#pragma unroll
                    for (int n = 0; n < 2; ++n) *(f32x4*)(base + off + bj * HALF + n * 16) = acc[ai][bj][m][n]; }
    }
};
struct EpiResF32N {
    static constexpr bool PERM = true, AFTER_DRAIN = false;
    const float* base; float* out; int ldc; bf16_t* xb; float* ssq;
    __device__ __forceinline__ void operator()(const f32x4 (&acc)[2][2][4][2], const Unit& u, int wr, int wc, int fr, int fq) const {
        const int row0 = u.pm * BM + wr * 64 + fr, col0 = u.pn * BM + wc * 32 + 8 * fq;
#pragma unroll
        for (int ai = 0; ai < 2; ++ai)
#pragma unroll
            for (int m = 0; m < 4; ++m) { const int row = row0 + ai * HALF + m * 16; const size_t off = (size_t)row * ldc + col0; float sq = 0.f;
#pragma unroll
                for (int bj = 0; bj < 2; ++bj) {
                    const f32x4 v0 = *(const f32x4*)(base + off + bj * HALF) + acc[ai][bj][m][0], v1 = *(const f32x4*)(base + off + bj * HALF + 4) + acc[ai][bj][m][1];
                    *(f32x4*)(out + off + bj * HALF) = v0; *(f32x4*)(out + off + bj * HALF + 4) = v1;
                    sq += ((v0[0] * v0[0] + v0[1] * v0[1]) + (v0[2] * v0[2] + v0[3] * v0[3])) + ((v1[0] * v1[0] + v1[1] * v1[1]) + (v1[2] * v1[2] + v1[3] * v1[3]));
                    u32x4 w; w.x = cvt_pk_bf16(v0[0], v0[1]); w.y = cvt_pk_bf16(v0[2], v0[3]); w.z = cvt_pk_bf16(v1[0], v1[1]); w.w = cvt_pk_bf16(v1[2], v1[3]); *(u32x4*)(xb + off + bj * HALF) = w; }
                sq += __shfl_xor(sq, 16); sq += __shfl_xor(sq, 32);
                if (fq == 0) atomicAdd(ssq + row, sq);
                asm volatile("" ::: "memory"); }
    }
};
template <class TB> struct EpiResBf16N {
    static constexpr bool PERM = true, AFTER_DRAIN = false;
    const TB* base; int ldc; bf16_t* xb; float* ssq;
    __device__ __forceinline__ void operator()(const f32x4 (&acc)[2][2][4][2], const Unit& u, int wr, int wc, int fr, int fq) const {
        const int row0 = u.pm * BM + wr * 64 + fr, col0 = u.pn * BM + wc * 32 + 8 * fq;
#pragma unroll
        for (int ai = 0; ai < 2; ++ai)
#pragma unroll
            for (int m = 0; m < 4; ++m) { const int row = row0 + ai * HALF + m * 16; const size_t off = (size_t)row * ldc + col0; float sq = 0.f;
#pragma unroll
                for (int bj = 0; bj < 2; ++bj) { f32x4 v0, v1;
                    if constexpr (sizeof(TB) == 4) { v0 = *(const f32x4*)((const float*)base + off + bj * HALF); v1 = *(const f32x4*)((const float*)base + off + bj * HALF + 4); }
                    else { const u32x4 b = *(const u32x4*)((const bf16_t*)base + off + bj * HALF);
                        v0 = (f32x4){__builtin_bit_cast(float, b.x << 16), __builtin_bit_cast(float, b.x & 0xffff0000u), __builtin_bit_cast(float, b.y << 16), __builtin_bit_cast(float, b.y & 0xffff0000u)};
                        v1 = (f32x4){__builtin_bit_cast(float, b.z << 16), __builtin_bit_cast(float, b.z & 0xffff0000u), __builtin_bit_cast(float, b.w << 16), __builtin_bit_cast(float, b.w & 0xffff0000u)}; }
                    v0 += acc[ai][bj][m][0]; v1 += acc[ai][bj][m][1];
                    u32x4 w; w.x = cvt_pk_bf16(v0[0], v0[1]); w.y = cvt_pk_bf16(v0[2], v0[3]); w.z = cvt_pk_bf16(v1[0], v1[1]); w.w = cvt_pk_bf16(v1[2], v1[3]); *(u32x4*)(xb + off + bj * HALF) = w;
                    const float r0 = __builtin_bit_cast(float, w.x << 16), r1 = __builtin_bit_cast(float, w.x & 0xffff0000u), r2 = __builtin_bit_cast(float, w.y << 16), r3 = __builtin_bit_cast(float, w.y & 0xffff0000u);
                    const float r4 = __builtin_bit_cast(float, w.z << 16), r5 = __builtin_bit_cast(float, w.z & 0xffff0000u), r6 = __builtin_bit_cast(float, w.w << 16), r7 = __builtin_bit_cast(float, w.w & 0xffff0000u);
                    sq += ((r0 * r0 + r1 * r1) + (r2 * r2 + r3 * r3)) + ((r4 * r4 + r5 * r5) + (r6 * r6 + r7 * r7)); }
                sq += __shfl_xor(sq, 16); sq += __shfl_xor(sq, 32);
                if (fq == 0) atomicAdd(ssq + row, sq);
                asm volatile("" ::: "memory"); }
    }
};
struct EpiOutBf16Res {
    static constexpr bool PERM = true, AFTER_DRAIN = false;
    const bf16_t* base; float* out; int ldc;
    __device__ __forceinline__ void operator()(const f32x4 (&acc)[2][2][4][2], const Unit& u, int wr, int wc, int fr, int fq) const {
        const int row0 = u.pm * BM + wr * 64 + fr, col0 = u.pn * BM + wc * 32 + 8 * fq;
#pragma unroll
        for (int ai = 0; ai < 2; ++ai)
#pragma unroll
            for (int m = 0; m < 4; ++m) { const size_t off = (size_t)(row0 + ai * HALF + m * 16) * ldc + col0;
#pragma unroll
                for (int bj = 0; bj < 2; ++bj) { const u32x4 b = *(const u32x4*)(base + off + bj * HALF);
                    const f32x4 v0 = (f32x4){__builtin_bit_cast(float, b.x << 16), __builtin_bit_cast(float, b.x & 0xffff0000u), __builtin_bit_cast(float, b.y << 16), __builtin_bit_cast(float, b.y & 0xffff0000u)};
                    const f32x4 v1 = (f32x4){__builtin_bit_cast(float, b.z << 16), __builtin_bit_cast(float, b.z & 0xffff0000u), __builtin_bit_cast(float, b.w << 16), __builtin_bit_cast(float, b.w & 0xffff0000u)};
                    *(f32x4*)(out + off + bj * HALF) = v0 + acc[ai][bj][m][0]; *(f32x4*)(out + off + bj * HALF + 4) = v1 + acc[ai][bj][m][1]; }
                asm volatile("" ::: "memory"); }
    }
};
struct HeadSpec { int lo[5], hi[5]; const float* g[5]; };
struct EpiYHeads {
    static constexpr bool PERM = true, AFTER_DRAIN = false;
    bf16_t* O; int ldc; const float* ssq; HeadSpec hs; const float* ct; const float* st; PG8_LAS float* tab;
    __device__ __forceinline__ void operator()(const f32x4 (&acc)[2][2][4][2], const Unit& u, int wr, int wc, int fr, int fq) const {
        const float* gain = nullptr;
#pragma unroll
        for (int k = 0; k < 5; ++k) if (u.pn >= hs.lo[k] && u.pn < hs.hi[k]) gain = hs.g[k];
        const int row0 = u.pm * BM + wr * 64 + fr;
        if (gain == nullptr) {
            const int col0 = u.pn * BM + wc * 32 + 8 * fq;
#pragma unroll
            for (int ai = 0; ai < 2; ++ai)
#pragma unroll
                for (int m = 0; m < 4; ++m) { bf16_t* rowp = O + (size_t)(row0 + ai * HALF + m * 16) * ldc + col0; const float rs = row_rstd(ssq, row0 + ai * HALF + m * 16);
#pragma unroll
                    for (int bj = 0; bj < 2; ++bj) { const f32x4 v0 = acc[ai][bj][m][0] * rs, v1 = acc[ai][bj][m][1] * rs;
                        u32x4 w; w.x = cvt_pk_bf16(v0[0], v0[1]); w.y = cvt_pk_bf16(v0[2], v0[3]); w.z = cvt_pk_bf16(v1[0], v1[1]); w.w = cvt_pk_bf16(v1[2], v1[3]);
                        *(u32x4*)(rowp + bj * HALF) = w; } }
            return;
        }
        const int lr0 = wr * 64 + fr;
#pragma unroll
        for (int ai = 0; ai < 2; ++ai)
#pragma unroll
            for (int m = 0; m < 4; ++m) { const float rs = row_rstd(ssq, row0 + ai * HALF + m * 16); float sq = 0.f;
#pragma unroll
                for (int bj = 0; bj < 2; ++bj)
#pragma unroll
                    for (int n = 0; n < 2; ++n) { const f32x4 v = acc[ai][bj][m][n] * rs; sq += (v[0] * v[0] + v[1] * v[1]) + (v[2] * v[2] + v[3] * v[3]); }
                sq += __shfl_xor(sq, 16); sq += __shfl_xor(sq, 32);
                if (fq == 0) tab[(ai * HALF + lr0 + m * 16) * 4 + wc] = sq; }
        asm volatile("s_waitcnt lgkmcnt(0)" ::: "memory"); __builtin_amdgcn_s_barrier(); asm volatile("" ::: "memory");
        const int dlo = 32 * (wc & 1) + 8 * fq, head = wc >> 1;
        const f32x4 ga0 = *(const f32x4*)(gain + dlo), ga1 = *(const f32x4*)(gain + dlo + 4), gb0 = *(const f32x4*)(gain + 64 + dlo), gb1 = *(const f32x4*)(gain + 64 + dlo + 4);
#pragma unroll
        for (int ai = 0; ai < 2; ++ai)
#pragma unroll
            for (int m = 0; m < 4; ++m) { const int row = row0 + ai * HALF + m * 16;
                const float own = tab[(ai * HALF + lr0 + m * 16) * 4 + wc], other = tab[(ai * HALF + lr0 + m * 16) * 4 + (wc ^ 1)];
                const float sc = row_rstd(ssq, row) / sqrtf(((wc & 1) ? other + own : own + other) * (1.0f / 128.0f) + 1e-6f);
                const f32x4 c0 = *(const f32x4*)(ct + (size_t)row * 64 + dlo), c1 = *(const f32x4*)(ct + (size_t)row * 64 + dlo + 4), s0 = *(const f32x4*)(st + (size_t)row * 64 + dlo), s1 = *(const f32x4*)(st + (size_t)row * 64 + dlo + 4);
                const f32x4 a0 = acc[ai][0][m][0] * sc * ga0, a1 = acc[ai][0][m][1] * sc * ga1, b0 = acc[ai][1][m][0] * sc * gb0, b1 = acc[ai][1][m][1] * sc * gb1;
                const f32x4 y10 = a0 * c0 - b0 * s0, y11 = a1 * c1 - b1 * s1, y20 = a0 * s0 + b0 * c0, y21 = a1 * s1 + b1 * c1;
                bf16_t* rowp = O + (size_t)row * ldc + u.pn * BM + head * 128 + dlo;
                u32x4 w; w.x = cvt_pk_bf16(y10[0], y10[1]); w.y = cvt_pk_bf16(y10[2], y10[3]); w.z = cvt_pk_bf16(y11[0], y11[1]); w.w = cvt_pk_bf16(y11[2], y11[3]); *(u32x4*)rowp = w;
                u32x4 w2; w2.x = cvt_pk_bf16(y20[0], y20[1]); w2.y = cvt_pk_bf16(y20[2], y20[3]); w2.z = cvt_pk_bf16(y21[0], y21[1]); w2.w = cvt_pk_bf16(y21[2], y21[3]); *(u32x4*)(rowp + 64) = w2;
                asm volatile("" ::: "memory"); }
    }
};
template <class Epi, class Sched, bool ALIGN_EPI = false, bool SP2 = false>
__device__ __forceinline__ void gemm_phase(PG8_LAS unsigned char* lds, const Gemm g, const Sched& S, const Epi& E) {
    const int tid = threadIdx.x, wid = __builtin_amdgcn_readfirstlane(tid >> 6), lane = tid & 63, wr = wid >> 2, wc = wid & 3, fr = lane & 15, fq = lane >> 4;
    const int K = g.K, nt = g.KL / BK;
    unsigned voffA[2], voffB[2];
#pragma unroll
    for (int i = 0; i < 2; ++i) { int R, C; stage_rc(tid * 16 + i * 8192, R, C); const int Rb = Epi::PERM ? ((R & ~31) + perm32(R & 31)) : R;
        voffA[i] = (unsigned)(R * K + C) * 2u; voffB[i] = (unsigned)(Rb * K + C) * 2u; }
    const size_t kstep = (size_t)(BK * 2);
    const size_t hstep = (size_t)HALF * K * 2;
    const size_t tstep = 2 * hstep;
    const unsigned ldsw = (unsigned)wid * 1024u;
    const int aoff = lds_byte(wr * 64 + fr, fq * 8), boff = lds_byte(wc * 32 + fr, fq * 8);
#define PG8_SA(b, h) (((b) * 2 + (h)) * HTB)
#define PG8_SB(b, h) ((4 + (b) * 2 + (h)) * HTB)
#define PG8_STAGE(bufoff, gbase, voff) do { _Pragma("unroll") for (int _i = 0; _i < 2; ++_i) \
        __builtin_amdgcn_global_load_lds((const unsigned*)((const char*)(gbase) + (voff)[_i]), (PG8_LAS unsigned*)(lds + (bufoff) + ldsw + _i * 8192), 16, 0, 0); } while (0)
#define PG8_LDA(dst, b, h) do { _Pragma("unroll") for (int m = 0; m < 4; ++m) _Pragma("unroll") for (int k = 0; k < 2; ++k) dst[m][k] = *(const PG8_LAS bf16x8*)(lds + PG8_SA(b, h) + aoff + m * 2048 + k * 1024); } while (0)
#define PG8_LDB(dst, b, h) do { _Pragma("unroll") for (int n = 0; n < 2; ++n) _Pragma("unroll") for (int k = 0; k < 2; ++k) dst[n][k] = *(const PG8_LAS bf16x8*)(lds + PG8_SB(b, h) + boff + n * 2048 + k * 1024); } while (0)
#define PG8_MMA(ai, bj, At, Bt) do { __builtin_amdgcn_s_setprio(1); _Pragma("unroll") for (int m = 0; m < 4; ++m) _Pragma("unroll") for (int n = 0; n < 2; ++n) _Pragma("unroll") for (int k = 0; k < 2; ++k) \
        acc[ai][bj][m][n] = __builtin_amdgcn_mfma_f32_16x16x32_bf16(Bt[n][k], At[m][k], acc[ai][bj][m][n], 0, 0, 0); __builtin_amdgcn_s_setprio(0); } while (0)
#define PG8_WAIT_V(n) asm volatile("s_waitcnt vmcnt(" #n ")" ::: "memory")
#define PG8_WAIT_L(n) asm volatile("s_waitcnt lgkmcnt(" #n ")" ::: "memory")
#define PG8_BAR __builtin_amdgcn_s_barrier()
#define PG8_SCHED __builtin_amdgcn_sched_barrier(0)
    Unit cur, nxt; int ui = 0;
    if (!S.next(0, cur)) return;
    f32x4 acc[2][2][4][2];
#pragma unroll
    for (int a = 0; a < 2; ++a)
#pragma unroll
        for (int b = 0; b < 2; ++b)
#pragma unroll
            for (int m = 0; m < 4; ++m)
#pragma unroll
                for (int n = 0; n < 2; ++n) acc[a][b][m][n] = (f32x4){0.f, 0.f, 0.f, 0.f};
    bf16x8 At[4][2], B0[2][2], B1[2][2];
    const size_t ksb = (size_t)g.KL * 2;
    const char* cA = (const char*)g.A + (size_t)cur.pm * tstep + (size_t)cur.ks * ksb; const char* cB = (const char*)g.Bt + (size_t)cur.pn * tstep + (size_t)cur.ks * ksb;
    S.a_ready(cur);
    if constexpr (SP2) {
        PG8_STAGE(PG8_SB(0, 0), cB, voffB); PG8_STAGE(PG8_SB(0, 1), cB + hstep, voffB); PG8_STAGE(PG8_SA(0, 0), cA, voffA); PG8_STAGE(PG8_SA(0, 1), cA + hstep, voffA);
        if (wr == 1) PG8_BAR;
        PG8_WAIT_V(2); PG8_BAR;
        PG8_STAGE(PG8_SB(1, 0), cB + kstep, voffB); PG8_STAGE(PG8_SA(1, 0), cA + kstep, voffA); PG8_STAGE(PG8_SB(1, 1), cB + hstep + kstep, voffB);
        PG8_WAIT_V(6); PG8_BAR;
    } else {
        PG8_STAGE(PG8_SB(0, 0), cB, voffB); PG8_STAGE(PG8_SA(0, 0), cA, voffA); PG8_STAGE(PG8_SB(0, 1), cB + hstep, voffB); PG8_STAGE(PG8_SA(0, 1), cA + hstep, voffA);
        if (wr == 1) PG8_BAR;
        PG8_WAIT_V(4); PG8_BAR;
        PG8_STAGE(PG8_SB(1, 0), cB + kstep, voffB); PG8_STAGE(PG8_SA(1, 0), cA + kstep, voffA); PG8_STAGE(PG8_SB(1, 1), cB + hstep + kstep, voffB);
        PG8_WAIT_V(6); PG8_BAR;
    }
    for (;;) {
        const bool has_next = S.next(ui + 1, nxt);
        const char* nA = has_next ? (const char*)g.A + (size_t)nxt.pm * tstep + (size_t)nxt.ks * ksb : cA; const char* nB = has_next ? (const char*)g.Bt + (size_t)nxt.pn * tstep + (size_t)nxt.ks * ksb : cB;
        for (int t = 0; t < nt; t += 2) {
            const bool last = (t == nt - 2);
            const char* a1 = cA + (size_t)(t + 1) * kstep;
            const char* a2 = last ? nA : cA + (size_t)(t + 2) * kstep; const char* b2 = last ? nB : cB + (size_t)(t + 2) * kstep;
            const char* a3 = a2 + kstep; const char* b3 = b2 + kstep;
            if (last && has_next) S.a_ready(nxt);
            if constexpr (SP2) {
            PG8_LDB(B0, 0, 0); PG8_LDB(B1, 0, 1); PG8_SCHED; PG8_LDA(At, 0, 0); PG8_STAGE(PG8_SA(1, 1), a1 + hstep, voffA);
            PG8_WAIT_V(8); PG8_WAIT_L(0); PG8_BAR; PG8_MMA(0, 0, At, B0); PG8_MMA(0, 1, At, B1); PG8_BAR; PG8_SCHED;
            PG8_LDA(At, 0, 1); PG8_STAGE(PG8_SB(0, 0), b2, voffB); PG8_STAGE(PG8_SB(0, 1), b2 + hstep, voffB); PG8_STAGE(PG8_SA(0, 0), a2, voffA);
            PG8_WAIT_V(8); PG8_WAIT_L(0); PG8_BAR; PG8_MMA(1, 0, At, B0); PG8_MMA(1, 1, At, B1); PG8_BAR; PG8_SCHED;
            PG8_LDB(B0, 1, 0); PG8_LDB(B1, 1, 1); PG8_SCHED; PG8_LDA(At, 1, 0); PG8_STAGE(PG8_SA(0, 1), a2 + hstep, voffA);
            PG8_WAIT_V(8); PG8_WAIT_L(0); PG8_BAR; PG8_MMA(0, 0, At, B0); PG8_MMA(0, 1, At, B1); PG8_BAR; PG8_SCHED;
            PG8_LDA(At, 1, 1); PG8_STAGE(PG8_SB(1, 0), b3, voffB); PG8_STAGE(PG8_SB(1, 1), b3 + hstep, voffB); PG8_STAGE(PG8_SA(1, 0), a3, voffA);
            PG8_WAIT_V(8); PG8_WAIT_L(0); PG8_BAR; PG8_MMA(1, 0, At, B0); PG8_MMA(1, 1, At, B1); PG8_BAR; PG8_SCHED;
            } else {
            PG8_LDB(B0, 0, 0); PG8_SCHED; PG8_LDA(At, 0, 0); PG8_STAGE(PG8_SA(1, 1), a1 + hstep, voffA);
            PG8_WAIT_L(8); PG8_BAR; PG8_WAIT_L(0); PG8_MMA(0, 0, At, B0); PG8_BAR; PG8_SCHED;
            PG8_LDB(B1, 0, 1); PG8_STAGE(PG8_SB(0, 0), b2, voffB);
            PG8_BAR; PG8_WAIT_L(0); PG8_MMA(0, 1, At, B1); PG8_BAR;
            PG8_LDA(At, 0, 1); PG8_STAGE(PG8_SA(0, 0), a2, voffA);
            PG8_BAR; PG8_WAIT_L(0); PG8_MMA(1, 0, At, B0); PG8_BAR; PG8_SCHED;
            PG8_STAGE(PG8_SB(0, 1), b2 + hstep, voffB);
            PG8_WAIT_V(6); PG8_BAR; PG8_MMA(1, 1, At, B1); PG8_BAR;
            PG8_LDB(B0, 1, 0); PG8_SCHED; PG8_LDA(At, 1, 0); PG8_STAGE(PG8_SA(0, 1), a2 + hstep, voffA);
            PG8_WAIT_L(8); PG8_BAR; PG8_WAIT_L(0); PG8_MMA(0, 0, At, B0); PG8_BAR; PG8_SCHED;
            PG8_LDB(B1, 1, 1); PG8_STAGE(PG8_SB(1, 0), b3, voffB);
            PG8_BAR; PG8_WAIT_L(0); PG8_MMA(0, 1, At, B1); PG8_BAR;
            PG8_LDA(At, 1, 1); PG8_STAGE(PG8_SA(1, 0), a3, voffA);
            PG8_BAR; PG8_WAIT_L(0); PG8_MMA(1, 0, At, B0); PG8_BAR; PG8_SCHED;
            PG8_STAGE(PG8_SB(1, 1), b3 + hstep, voffB);
            PG8_WAIT_V(6); PG8_BAR; PG8_MMA(1, 1, At, B1); PG8_BAR;
            }
        }
        if constexpr (ALIGN_EPI) { if (wr == 0) PG8_BAR; }
        if constexpr (!Epi::AFTER_DRAIN) { E(acc, cur, wr, wc, fr, fq); S.done(cur); }
        if (!has_next) break;
#pragma unroll
        for (int a = 0; a < 2; ++a)
#pragma unroll
            for (int b = 0; b < 2; ++b)
#pragma unroll
                for (int m = 0; m < 4; ++m)
#pragma unroll
                    for (int n = 0; n < 2; ++n) acc[a][b][m][n] = (f32x4){0.f, 0.f, 0.f, 0.f};
        cur = nxt; cA = nA; cB = nB; ++ui;
        if constexpr (ALIGN_EPI) { if (wr == 1) PG8_BAR; }
    }
    PG8_WAIT_V(0);
    if constexpr (!ALIGN_EPI) { if (wr == 0) PG8_BAR; }
    PG8_BAR;
    if constexpr (Epi::AFTER_DRAIN) { E.fused(acc, cur, wr, wc, fr, fq, lds, wid, lane); S.done(cur); }
#undef PG8_SA
#undef PG8_SB
#undef PG8_STAGE
#undef PG8_LDA
#undef PG8_LDB
#undef PG8_MMA
#undef PG8_WAIT_V
#undef PG8_WAIT_L
#undef PG8_BAR
#undef PG8_SCHED
}
}
#define GAS __attribute__((address_space(1)))
#define LAS __attribute__((address_space(3)))
typedef unsigned short bf16;
typedef unsigned v4u __attribute__((ext_vector_type(4)));
typedef float f32x4 __attribute__((ext_vector_type(4)));
constexpr int NB = 4, T = 2048, DM = 4096, MTOK = NB * T, HD = 128;
constexpr int EVEN_N = 11312, EVEN_LD = 11520, ODD_LD = 18432, FFN = 11008, GU_ROWS = 2 * FFN;
constexpr int MEM_LEN = 256, MEM_ROWS = NB * MEM_LEN, XW = 512;
constexpr float NORM_EPS = 1e-6f;
constexpr float ATT_SCALE = 0.08838834764831845f;
#define NEG_INF (-__builtin_inff())
constexpr int C_MQ = 0, C_MK = 2048, C_MV = 4096, C_NQ = 6144, C_KC = 8192, C_VC = 8704, C_KS = 9216, C_VS = 9728, C_KW = 10240, C_VW = 10752, C_GL = 11264;
constexpr int C_SQ = 0, C_SK = 3072, C_SV = 6144, C_DQ = 9216, C_DK = 12288, C_DV = 15360;
constexpr size_t MiB = 1u << 20;
constexpr size_t WS_CTL = 0, CTL_ZERO_BYTES = 256 * 1024;
constexpr size_t WS_ROPE = 1 * MiB;
constexpr size_t WS_KMEAN = 5 * MiB;
constexpr size_t WS_KCR = 6 * MiB, WS_VCR = 7 * MiB;
constexpr size_t WS_KCN = 8 * MiB, WS_VCN = 9 * MiB;
constexpr size_t WS_MEMN = 10 * MiB;
constexpr size_t WS_QX = 18 * MiB;
constexpr size_t WS_KVX = 26 * MiB;
constexpr size_t WS_OX = 28 * MiB;
constexpr size_t WS_WQ = 36 * MiB, WS_WKV = 40 * MiB, WS_WO = 48 * MiB, WS_WOUT = 52 * MiB, WS_WIN = 84 * MiB, WS_WGU = 228 * MiB, WS_WD = 400 * MiB;
constexpr size_t WS_X = 486 * MiB;
constexpr size_t WS_H = 614 * MiB;
constexpr size_t WS_O = 678 * MiB;
constexpr size_t WS_Y = 742 * MiB;
constexpr size_t WS_VT = 1030 * MiB;
constexpr size_t WS_PART = 1126 * MiB;
constexpr size_t WS_LSE = 1222 * MiB;
constexpr size_t WS_VTX = 1223 * MiB;
constexpr size_t WS_SELM = 5 * MiB + 256 * 1024, WS_SELN = 5 * MiB + 768 * 1024;
constexpr size_t WS_PHIK = 1224 * MiB, WS_PHIV = 1225 * MiB;
constexpr size_t WS_CBIAS = 5 * MiB + 896 * 1024;
constexpr size_t WS_QP = 1226 * MiB;
constexpr size_t WS_MEMN2 = 1290 * MiB;
constexpr size_t WS_KVX2 = 1306 * MiB;
constexpr size_t WS_WKV2 = 1314 * MiB;
constexpr size_t WS_WD1 = 1330 * MiB;
constexpr size_t WS_WIN1 = 1416 * MiB;
constexpr size_t WS_END = 1560 * MiB;
#ifndef EARLY_N1
#define EARLY_N1 20
#endif
#ifndef EARLY_N2
#define EARLY_N2 20
#endif
#ifndef EARLY_NT
#define EARLY_NT 1
#endif
constexpr int CW_BAR = 4096;
constexpr int CW_SSQ = 16384;
constexpr int RING_BYTES = 131072, LDSCTL_OFF = RING_BYTES, MISC_OFF = LDSCTL_OFF + 320, LDS_BYTES = 147456;
constexpr int NWAVES = 8;
#ifndef MK_ONE_LAUNCH
#define MK_ONE_LAUNCH 0
#endif
constexpr int NPL = 16, NPH = 2 * NPL;
#ifndef DUP_PHASE
#define DUP_PHASE (-1)
#endif
#ifndef DUP_N
#define DUP_N 2
#endif
#define REPS(k) for (int rep_ = 0; rep_ < ((DUP_PHASE == (k)) ? DUP_N : 1); ++rep_)
#ifndef PROBE_MASK
#define PROBE_MASK 0ull
#endif
#ifndef PROBE_SCALE
#define PROBE_SCALE 1e-3f
#endif
#ifndef PROBE_OFF
#define PROBE_OFF 0.f
#endif
#ifndef FUSE_HEADNORM
#define FUSE_HEADNORM 0
#endif
#ifndef RES_BF16
#define RES_BF16 0
#endif
#ifndef FA_EVEN
#define FA_EVEN 1
#endif
#ifndef FA_ODD
#define FA_ODD 1
#endif
#ifndef FA_SB
#define FA_SB 1
#endif
#ifndef FA_DIL
#define FA_DIL 1
#endif
#ifndef FA_XATTN
#define FA_XATTN 1
#endif

__device__ __forceinline__ unsigned f2bf(float f) { unsigned u = __builtin_bit_cast(unsigned, f); return (u + 0x7fffu + ((u >> 16) & 1u)) >> 16; }
__device__ __forceinline__ unsigned pk2(float lo, float hi) { return f2bf(lo) | (f2bf(hi) << 16); }
__device__ __forceinline__ float bflo(unsigned w) { return __builtin_bit_cast(float, w << 16); }
__device__ __forceinline__ float bfhi(unsigned w) { return __builtin_bit_cast(float, w & 0xffff0000u); }
__device__ __forceinline__ float bf2f(bf16 b) { return __builtin_bit_cast(float, ((unsigned)b) << 16); }
__device__ __forceinline__ float wsum(float v) {
#pragma unroll
    for (int o = 1; o < 64; o <<= 1) v += __shfl_xor(v, o);
    return v; }
__device__ __forceinline__ float wmax(float v) {
#pragma unroll
    for (int o = 1; o < 64; o <<= 1) v = fmaxf(v, __shfl_xor(v, o));
    return v; }
__device__ __forceinline__ float rdlane(float v, int j) { return __builtin_bit_cast(float, __builtin_amdgcn_readlane(__builtin_bit_cast(int, v), j)); }
#define LDS_FENCE() do { asm volatile("s_waitcnt lgkmcnt(0)" ::: "memory"); __builtin_amdgcn_wave_barrier(); } while (0)

#define XB_TMO      128
#define XB_XCNT(j)  (256  + 64 * (j))
#define XB_XSUB(j)  (1280 + 64 * (j))
#define XB_XGEN(j)  (2304 + 64 * (j))
#define XB_TOP      3328
#define XB_TOPGEN   3392
#define XCD_BAR_WORDS 3456
#define XB_SPIN_CAP (1u << 18)

__device__ __forceinline__ unsigned xb_ld(unsigned* p)              { return __hip_atomic_load(p, __ATOMIC_RELAXED, __HIP_MEMORY_SCOPE_AGENT); }
__device__ __forceinline__ unsigned xb_add(unsigned* p, unsigned v) { return __hip_atomic_fetch_add(p, v, __ATOMIC_RELAXED, __HIP_MEMORY_SCOPE_AGENT); }
__device__ __forceinline__ unsigned xb_xcc_id() { return (unsigned)__builtin_amdgcn_s_getreg((3 << 11) | 20) & 0xFu; }
#define XB_SPIN(cond, bar) do { unsigned _sp = 0; while (cond) { __builtin_amdgcn_s_sleep(1); \
    if ((++_sp & 255u) == 0u) { if (xb_ld(&(bar)[XB_TMO])) break; if (_sp > XB_SPIN_CAP) { atomicAdd(&(bar)[XB_TMO], 1u); break; } } } } while (0)

struct XcdBarrier {
    unsigned* bar; unsigned x;
    volatile LAS unsigned* st;
};

__device__ __forceinline__ XcdBarrier xcd_barrier_post(unsigned* bar, volatile LAS unsigned* st) {
    XcdBarrier b; b.bar = bar; b.x = xb_xcc_id(); b.st = st;
    if (threadIdx.x == 0) (void)xb_add(&bar[XB_XCNT(b.x)], 1u);
    return b;
}
__device__ __forceinline__ void xcd_barrier_complete(unsigned* bar, unsigned x, unsigned& nloc, unsigned& nx) {
    const unsigned G = gridDim.x * gridDim.y * gridDim.z;
    unsigned sum, cnt, mine, sp = 0u;
    for (;;) {
        sum = 0u; cnt = 0u; mine = 0u;
#pragma unroll
        for (unsigned j = 0; j < 16; ++j) { const unsigned c = xb_ld(&bar[XB_XCNT(j)]); sum += c; cnt += (c > 0u) ? 1u : 0u; mine = (j == x) ? c : mine; }
        if (sum == G) break;
        __builtin_amdgcn_s_sleep(1);
        if ((++sp & 255u) == 0u) { if (xb_ld(&bar[XB_TMO])) break; if (sp > XB_SPIN_CAP) { atomicAdd(&bar[XB_TMO], 1u); break; } }
    }
    nloc = mine > 0u ? mine : 1u; nx = cnt > 0u ? cnt : 1u;
}

__device__ __forceinline__ void xcd_barrier(const XcdBarrier& b) {
    asm volatile("s_waitcnt vmcnt(0)" ::: "memory");
    __syncthreads();
    if (threadIdx.x == 0) {
        unsigned* bar = b.bar;
        __builtin_amdgcn_s_waitcnt(0);
        unsigned nloc = b.st[0], nx = b.st[1];
        if (nloc == 0u) { xcd_barrier_complete(bar, b.x, nloc, nx); b.st[0] = nloc; b.st[1] = nx; }
        const unsigned old = xb_add(&bar[XB_XSUB(b.x)], 1u);
        const unsigned gen = old / nloc;
        if (old + 1u == (gen + 1u) * nloc) {
            __builtin_amdgcn_fence(__ATOMIC_RELEASE, "agent");
            asm volatile("s_waitcnt vmcnt(0)" ::: "memory");
            const unsigned og = xb_add(&bar[XB_TOP], 1u);
            const unsigned tg = og / nx;
            if (og + 1u == (tg + 1u) * nx) xb_add(&bar[XB_TOPGEN], 1u);
            else XB_SPIN(xb_ld(&bar[XB_TOPGEN]) == tg, bar);
            __builtin_amdgcn_fence(__ATOMIC_ACQUIRE, "agent");
            xb_add(&bar[XB_XGEN(b.x)], 1u);
            asm volatile("s_waitcnt vmcnt(0)" ::: "memory");
        } else {
            XB_SPIN(xb_ld(&bar[XB_XGEN(b.x)]) == gen, bar);
            __builtin_amdgcn_fence(__ATOMIC_ACQUIRE, "agent");
            asm volatile("s_waitcnt vmcnt(0)" ::: "memory");
        }
    }
    __syncthreads();
}


struct Ctx { LAS unsigned char* lds; int tid, lane, wave, gw, ngw, G; };

struct RmId { int off; __device__ __forceinline__ int operator()(int n) const { return off + n; } };
struct RmHeads { unsigned long long m0, m1;
    __device__ __forceinline__ int operator()(int n) const { const int t = n >> 8; const bool hd = t < 64 ? ((m0 >> t) & 1ull) : ((m1 >> (t - 64)) & 1ull); if (!hd) return n;
        const int r = n & 255, hb = r >> 7, d = r & 127; return (n & ~255) + ((d >> 6) << 7) + hb * 64 + (d & 63); } };
struct RmGU { int up; __device__ __forceinline__ int operator()(int n) const { return (n >> 7) * 256 + up * 128 + (n & 127); } };
template <class RM, bool NT = false>
__device__ __forceinline__ void conv_weight(const Ctx& c, const float* W, int K, int N, int Npad, bf16* WT, RM rm, const float* kgain = nullptr, int it0 = 0, int it1 = -1, int gw = -1, int ngw = -1) {
    LAS float* scr = (LAS float*)(c.lds + c.wave * 16384);
    const int nblk = Npad / 32, items = it1 < 0 ? (K / 64) * nblk : it1, lane = c.lane; if (gw < 0) { gw = c.gw; ngw = c.ngw; }
    for (int it = it0 + gw; it < items; it += ngw) {
        const int kb = it / nblk, nb = it - kb * nblk, k0 = 64 * kb, n0 = 32 * nb;
        const int c4 = lane & 7; const bool ok = n0 + 4 * c4 < N;
        f32x4 wv[8];
#pragma unroll
        for (int i = 0; i < 8; ++i) { const int kk = 8 * i + (lane >> 3); wv[i] = ok ? (NT ? __builtin_nontemporal_load((const f32x4*)(W + (size_t)(k0 + kk) * N + n0 + 4 * c4)) : *(const f32x4*)(W + (size_t)(k0 + kk) * N + n0 + 4 * c4)) : (f32x4){0.f, 0.f, 0.f, 0.f}; }
#pragma unroll
        for (int i = 0; i < 8; ++i) { const int kk = 8 * i + (lane >> 3); const float kg = kgain ? kgain[k0 + kk] : 1.0f; LAS float* d = scr + kk * 33 + 4 * c4; d[0] = wv[i].x * kg; d[1] = wv[i].y * kg; d[2] = wv[i].z * kg; d[3] = wv[i].w * kg; }
        LDS_FENCE();
        const int ch = lane & 7, r0 = rm(n0);
#pragma unroll
        for (int j = 0; j < 4; ++j) { const int nn = (lane >> 3) + 8 * j; const LAS float* s = scr + (8 * ch) * 33 + nn;
            v4u o; o.x = pk2(s[0 * 33], s[1 * 33]); o.y = pk2(s[2 * 33], s[3 * 33]); o.z = pk2(s[4 * 33], s[5 * 33]); o.w = pk2(s[6 * 33], s[7 * 33]);
            *(v4u*)(WT + (size_t)(r0 + nn) * K + k0 + 8 * ch) = o; }
        LDS_FENCE();
    }
}
__device__ __forceinline__ void rmsnorm_rows(const Ctx& c, const float* X, const float* g, bf16* Hout, int nrows) {
    const int lane = c.lane;
    for (int m = c.gw; m < nrows; m += c.ngw) {
        const f32x4* xr = (const f32x4*)(X + (size_t)m * DM) + lane; f32x4 v[16]; float ss = 0.f;
#pragma unroll
        for (int j = 0; j < 16; ++j) { v[j] = xr[64 * j]; ss += (v[j].x * v[j].x + v[j].y * v[j].y) + (v[j].z * v[j].z + v[j].w * v[j].w); }
        const float rstd = 1.0f / sqrtf(wsum(ss) * (1.0f / DM) + NORM_EPS);
        const f32x4* gr = (const f32x4*)g + lane; unsigned long long* o8 = (unsigned long long*)(Hout + (size_t)m * DM) + lane;
#pragma unroll
        for (int j = 0; j < 16; ++j) { const f32x4 gg = gr[64 * j]; o8[64 * j] = (unsigned long long)pk2(v[j].x * rstd * gg.x, v[j].y * rstd * gg.y) | ((unsigned long long)pk2(v[j].z * rstd * gg.z, v[j].w * rstd * gg.w) << 32); }
    }
}
__device__ __forceinline__ void rope_table(const Ctx& c, const int* pos, float* ct, float* st) {
    for (int idx = c.gw * 64 + c.lane; idx < MTOK * 64; idx += c.ngw * 64) {
        const int row = idx >> 6, i = idx & 63;
        const float invf = exp2f(-(float)i * 0.20762050593046f);
        const float ang = (float)pos[row] * invf;
        double rev = (double)ang * 0.15915494309189535; rev -= floor(rev);
        const float r = (float)rev;
        ct[idx] = __builtin_amdgcn_cosf(r); st[idx] = __builtin_amdgcn_sinf(r);
    }
}
__device__ __forceinline__ void headnorm_one(float (&x)[8], int j, int row, const f32x4 ga, const f32x4 gb, const float* ct, const float* st) {
    float ss = 0.f;
#pragma unroll
    for (int e = 0; e < 8; ++e) ss += x[e] * x[e];
    ss += __shfl_xor(ss, 1); ss += __shfl_xor(ss, 2); ss += __shfl_xor(ss, 4); ss += __shfl_xor(ss, 8);
    const float rstd = 1.0f / sqrtf(ss * (1.0f / 128.0f) + NORM_EPS);
    x[0] *= rstd * ga.x; x[1] *= rstd * ga.y; x[2] *= rstd * ga.z; x[3] *= rstd * ga.w; x[4] *= rstd * gb.x; x[5] *= rstd * gb.y; x[6] *= rstd * gb.z; x[7] *= rstd * gb.w;
    if (ct) {
        const f32x4 ca = *(const f32x4*)(ct + (size_t)row * 64 + 8 * (j & 7)), cb = *(const f32x4*)(ct + (size_t)row * 64 + 8 * (j & 7) + 4);
        const f32x4 sa = *(const f32x4*)(st + (size_t)row * 64 + 8 * (j & 7)), sb = *(const f32x4*)(st + (size_t)row * 64 + 8 * (j & 7) + 4);
        const float cs[8] = {ca.x, ca.y, ca.z, ca.w, cb.x, cb.y, cb.z, cb.w}, sn[8] = {sa.x, sa.y, sa.z, sa.w, sb.x, sb.y, sb.z, sb.w};
#pragma unroll
        for (int e = 0; e < 8; ++e) { const float pr = __shfl_xor(x[e], 8); x[e] = (j < 8) ? (x[e] * cs[e] - pr * sn[e]) : (pr * sn[e] + x[e] * cs[e]); }
    }
}
__device__ __forceinline__ void headnorm_bf16(const Ctx& c, bf16* Y, int ld, int col0, int nh, int nrows, const float* gain, const float* ct, const float* st) {
    const int lane = c.lane, sub = lane >> 4, j = lane & 15; const int items = nrows * nh, stride = 4 * c.ngw;
    const f32x4 ga = *(const f32x4*)(gain + 8 * j), gb = *(const f32x4*)(gain + 8 * j + 4);
    for (int it = 4 * c.gw + sub; it < items; it += 2 * stride) {
        const int it2 = it + stride; const bool two = it2 < items;
        const int row = it / nh, hh = it - row * nh, row2 = two ? it2 / nh : row, hh2 = two ? it2 - row2 * nh : hh;
        bf16* p = Y + (size_t)row * ld + col0 + hh * 128 + 8 * j; bf16* p2 = Y + (size_t)row2 * ld + col0 + hh2 * 128 + 8 * j;
        const v4u w = *(const v4u*)p; const v4u w2 = *(const v4u*)p2;
        float x[8] = {bflo(w.x), bfhi(w.x), bflo(w.y), bfhi(w.y), bflo(w.z), bfhi(w.z), bflo(w.w), bfhi(w.w)};
        float y[8] = {bflo(w2.x), bfhi(w2.x), bflo(w2.y), bfhi(w2.y), bflo(w2.z), bfhi(w2.z), bflo(w2.w), bfhi(w2.w)};
        headnorm_one(x, j, row, ga, gb, ct, st); headnorm_one(y, j, row2, ga, gb, ct, st);
        v4u o; o.x = pk2(x[0], x[1]); o.y = pk2(x[2], x[3]); o.z = pk2(x[4], x[5]); o.w = pk2(x[6], x[7]); *(v4u*)p = o;
        if (two) { v4u o2; o2.x = pk2(y[0], y[1]); o2.y = pk2(y[2], y[3]); o2.z = pk2(y[4], y[5]); o2.w = pk2(y[6], y[7]); *(v4u*)p2 = o2; }
    }
}
__device__ __forceinline__ void headnorm_q4(const Ctx& c, const float* QP, bf16* QX, const float* gain, const float* ssq) {
    const int lane = c.lane, sub = lane >> 4, j = lane & 15;
    const f32x4 ga = *(const f32x4*)(gain + 8 * j), gb = *(const f32x4*)(gain + 8 * j + 4);
    for (int it = 4 * c.gw + sub; it < MTOK * 4; it += 4 * c.ngw) {
        const size_t off = (size_t)(it >> 2) * XW + (it & 3) * 128 + 8 * j;
        f32x4 a = *(const f32x4*)(QP + off), b = *(const f32x4*)(QP + off + 4);
#pragma unroll
        for (int ks = 1; ks < 4; ++ks) { a += *(const f32x4*)(QP + (size_t)ks * MTOK * XW + off); b += *(const f32x4*)(QP + (size_t)ks * MTOK * XW + off + 4); }
        { const float rs = 1.0f / sqrtf(ssq[it >> 2] * (1.0f / DM) + NORM_EPS); a *= rs; b *= rs; }
        float ss = (a.x * a.x + a.y * a.y) + (a.z * a.z + a.w * a.w) + (b.x * b.x + b.y * b.y) + (b.z * b.z + b.w * b.w);
        ss += __shfl_xor(ss, 1); ss += __shfl_xor(ss, 2); ss += __shfl_xor(ss, 4); ss += __shfl_xor(ss, 8);
        const float rstd = 1.0f / sqrtf(ss * (1.0f / 128.0f) + NORM_EPS);
        v4u o; o.x = pk2(a.x * rstd * ga.x, a.y * rstd * ga.y); o.y = pk2(a.z * rstd * ga.z, a.w * rstd * ga.w); o.z = pk2(b.x * rstd * gb.x, b.y * rstd * gb.y); o.w = pk2(b.z * rstd * gb.z, b.w * rstd * gb.w);
        *(v4u*)(QX + off) = o;
    }
}
__device__ __forceinline__ void cmp_finish(const Ctx& c, const float* KCR, const float* VCR, const float* cbias, bf16* KCN, bf16* VCT, const float* gain, const float* ct, const float* st) {
    constexpr size_t PS = 16 * 128 * 128;
    const int lane = c.lane; const float g1 = gain[lane], g2 = gain[lane + 64];
    for (int it = c.gw; it < 2 * 16 * 128; it += c.ngw) {
        const int which = it >> 11, r = it & 2047, bg = r >> 7, n = r & 127, b = bg >> 2;
        const size_t o = ((size_t)bg * 128 + n) * 128;
        if (which == 0) {
            if (n == 127) { KCN[o + lane] = 0; KCN[o + lane + 64] = 0; continue; }
            float x1 = ((KCR[o + lane] + KCR[PS + o + lane]) + (KCR[2 * PS + o + lane] + KCR[3 * PS + o + lane])) + cbias[lane], x2 = ((KCR[o + lane + 64] + KCR[PS + o + lane + 64]) + (KCR[2 * PS + o + lane + 64] + KCR[3 * PS + o + lane + 64])) + cbias[lane + 64];
            const float rstd = 1.0f / sqrtf(wsum(x1 * x1 + x2 * x2) * (1.0f / 128.0f) + NORM_EPS);
            x1 = x1 * rstd * g1; x2 = x2 * rstd * g2;
            const int row = b * T + 16 * n + 31; const float cs = ct[row * 64 + lane], sn = st[row * 64 + lane];
            KCN[o + lane] = (bf16)f2bf(x1 * cs - x2 * sn); KCN[o + lane + 64] = (bf16)f2bf(x1 * sn + x2 * cs);
        } else {
            const float v1 = n == 127 ? 0.f : ((VCR[o + lane] + VCR[PS + o + lane]) + (VCR[2 * PS + o + lane] + VCR[3 * PS + o + lane])) + cbias[128 + lane], v2 = n == 127 ? 0.f : ((VCR[o + lane + 64] + VCR[PS + o + lane + 64]) + (VCR[2 * PS + o + lane + 64] + VCR[3 * PS + o + lane + 64])) + cbias[128 + lane + 64];
            VCT[o + lane] = (bf16)f2bf(v1); VCT[o + lane + 64] = (bf16)f2bf(v2);
        }
    }
}
__device__ __forceinline__ void moba_kmean(const Ctx& c, const bf16* Y, float* kmean) {
    const int lane = c.lane;
    for (int it = c.gw; it < NB * 16 * 8; it += c.ngw) {
        const int b = it >> 7, h = (it >> 3) & 15, n = it & 7;
        const bf16* src = Y + ((size_t)b * T + 256 * n) * EVEN_LD + C_MK + h * 128 + 2 * lane;
        float a0 = 0.f, a1 = 0.f;
        for (int k = 0; k < 256; ++k) { const unsigned w = *(const unsigned*)(src + (size_t)k * EVEN_LD); a0 += bflo(w); a1 += bfhi(w); }
        float* dst = kmean + (size_t)it * 128 + 2 * lane; dst[0] = a0 * (1.0f / 256.0f); dst[1] = a1 * (1.0f / 256.0f);
    }
}

__device__ __forceinline__ float dot128(const LAS float* qs, const bf16* krow) {
    const v4u* kp = (const v4u*)krow; float s = 0.f;
#pragma unroll 4
    for (int cch = 0; cch < 16; ++cch) { const v4u w = kp[cch]; const LAS f32x4* q4 = (const LAS f32x4*)(qs + 8 * cch); const f32x4 qa = q4[0], qb = q4[1];
        s += qa.x * bflo(w.x) + qa.y * bfhi(w.x) + qa.z * bflo(w.y) + qa.w * bfhi(w.y) + qb.x * bflo(w.z) + qb.y * bfhi(w.z) + qb.z * bflo(w.w) + qb.w * bfhi(w.w); }
    return s;
}
__device__ __forceinline__ void load_q(LAS float* qs, const bf16* qrow, int lane) {
    LDS_FENCE();
    const unsigned w = *(const unsigned*)(qrow + 2 * lane); qs[2 * lane] = bflo(w); qs[2 * lane + 1] = bfhi(w);
    LDS_FENCE();
}
__device__ __forceinline__ void pv_accum(float& a0, float& a1, float p, int voff, const bf16* Vb, int lane) {
    for (int j = 0; j < 64; ++j) {
        const float pj = rdlane(p, j);
        if (pj != 0.f) { const int off = __builtin_amdgcn_readlane(voff, j); const unsigned w = *(const unsigned*)(Vb + (size_t)off + 2 * lane); a0 += pj * bflo(w); a1 += pj * bfhi(w); }
    }
}
struct SoftAcc { float m, l, a0, a1; };
__device__ __forceinline__ void sa_init(SoftAcc& S) { S.m = NEG_INF; S.l = 0.f; S.a0 = 0.f; S.a1 = 0.f; }
__device__ __forceinline__ void sa_chunk(SoftAcc& S, float s  , int voff, const bf16* Vb, int lane) {
    const float cm = wmax(s);
    if (cm == NEG_INF) return;
    const float mn = fmaxf(S.m, cm);
    const float p = __expf(s - mn), alpha = __expf(S.m - mn);
    S.l = S.l * alpha + wsum(p); S.a0 *= alpha; S.a1 *= alpha; S.m = mn;
    pv_accum(S.a0, S.a1, p, voff, Vb, lane);
}
__device__ __forceinline__ void moba_row(const Ctx& c, LAS float* qs, const bf16* Y, const float* kmean, bf16* O, int b, int h, int t) {
    const int lane = c.lane; const size_t row = (size_t)b * T + t; const bf16* Yb = Y + (size_t)b * T * EVEN_LD;
    load_q(qs, Y + row * EVEN_LD + C_MQ + h * 128, lane);
    const int cur = t >> 8;
    float gate = NEG_INF;
    if (lane < cur) { const float* km = kmean + ((size_t)(b * 16 + h) * 8 + lane) * 128; float s = 0.f; for (int d = 0; d < 128; ++d) s += qs[d] * km[d]; gate = s; }
    int rank = 0;
    for (int m2 = 0; m2 < 8; ++m2) { const float gm = rdlane(gate, m2); rank += (gm > gate || (gm == gate && m2 < lane)) ? 1 : 0; }
    const unsigned selmask = (unsigned)__ballot((lane < cur) && (rank < 3));
    SoftAcc S; sa_init(S);
    const bf16* Kb = Yb + C_MK + h * 128; const bf16* Vb = Yb + C_MV + h * 128;
    const int nch = (t >> 6) + 1;
    for (int kc = 0; kc < nch; ++kc) {
        const int n = kc >> 2;
        if (n < cur && !((selmask >> n) & 1u)) continue;
        const int key = kc * 64 + lane; const bool valid = key <= t; const int koff = (valid ? key : t) * EVEN_LD;
        float s = dot128(qs, Kb + koff) * ATT_SCALE; if (!valid) s = NEG_INF;
        sa_chunk(S, s, koff, Vb, lane);
    }
    const float inv = 1.0f / fmaxf(S.l, 1e-30f);
    *(unsigned*)(O + row * DM + h * 128 + 2 * lane) = pk2(S.a0 * inv, S.a1 * inv);
}
__device__ __forceinline__ void nsa_item(const Ctx& c, LAS float* qs, LAS float* ps, const bf16* Y, const bf16* KCN, const bf16* VCN, bf16* O, int b, int g, int t) {
    const int lane = c.lane; const size_t row = (size_t)b * T + t; const bf16* Yb = Y + (size_t)b * T * EVEN_LD;
    const bf16* Kc = KCN + (size_t)(b * 4 + g) * 128 * 128; const bf16* Vc = VCN + (size_t)(b * 4 + g) * 128 * 128;
    float oc0[4], oc1[4]; float P0 = 0.f, P1 = 0.f;
    const int n0 = lane, n1 = 64 + lane; const bool v0 = 16 * n0 + 31 <= t, v1 = (n1 < 127) && (16 * n1 + 31 <= t);
#pragma unroll
    for (int hh = 0; hh < 4; ++hh) {
        load_q(qs, Y + row * EVEN_LD + C_NQ + (g * 4 + hh) * 128, lane);
        float s0 = dot128(qs, Kc + (v0 ? n0 : 0) * 128) * ATT_SCALE, s1 = dot128(qs, Kc + (v1 ? n1 : 0) * 128) * ATT_SCALE;
        if (!v0) s0 = NEG_INF; if (!v1) s1 = NEG_INF;
        const float m = wmax(fmaxf(s0, s1)); float a0 = 0.f, a1 = 0.f;
        if (m != NEG_INF) {
            float p0 = __expf(s0 - m), p1 = __expf(s1 - m);
            const float inv = 1.0f / fmaxf(wsum(p0 + p1), 1e-30f);
            p0 *= inv; p1 *= inv; P0 += p0; P1 += p1;
            pv_accum(a0, a1, p0, n0 * 128, Vc, lane); pv_accum(a0, a1, p1, (v1 ? n1 : 0) * 128, Vc, lane);
        }
        oc0[hh] = a0; oc1[hh] = a1;
    }
    LDS_FENCE(); ps[lane] = P0; ps[64 + lane] = P1; LDS_FENCE();
    float imp = 0.f;
    if (lane < 32) { for (int n = 4 * lane - 1; n <= 4 * lane + 3; ++n) if (n >= 0 && n < 127) imp += ps[n]; }
    const int cur = t >> 6;
    const float v = (lane >= 32) ? NEG_INF : ((lane == cur || lane == 0) ? __builtin_inff() : (lane <= cur ? imp : NEG_INF));
    int rank = 0;
    for (int m2 = 0; m2 < 32; ++m2) { const float vm = rdlane(v, m2); rank += (vm > v || (vm == v && m2 < lane)) ? 1 : 0; }
    const unsigned selmask = (unsigned)__ballot(lane < 32 && lane <= cur && rank < 16);
    const bf16* Ks = Yb + C_KS + g * 128; const bf16* Vs = Yb + C_VS + g * 128; const bf16* Kw = Yb + C_KW + g * 128; const bf16* Vw = Yb + C_VW + g * 128;
#pragma unroll
    for (int hh = 0; hh < 4; ++hh) {
        const int h = g * 4 + hh;
        load_q(qs, Y + row * EVEN_LD + C_NQ + h * 128, lane);
        SoftAcc S; sa_init(S);
        for (int j = 0; j <= cur; ++j) {
            if (!((selmask >> j) & 1u)) continue;
            const int key = 64 * j + lane; const bool valid = key <= t; const int koff = (valid ? key : t) * EVEN_LD;
            float s = dot128(qs, Ks + koff) * ATT_SCALE; if (!valid) s = NEG_INF;
            sa_chunk(S, s, koff, Vs, lane);
        }
        SoftAcc W; sa_init(W);
        for (int c0 = 0; c0 < 512 && c0 <= t; c0 += 64) {
            const int key = t - c0 - lane; const bool valid = key >= 0; const int koff = (valid ? key : 0) * EVEN_LD;
            float s = dot128(qs, Kw + koff) * ATT_SCALE; if (!valid) s = NEG_INF;
            sa_chunk(W, s, koff, Vw, lane);
        }
        const bf16* gl = Y + row * EVEN_LD + C_GL + h * 3;
        const float g0 = 1.0f / (1.0f + __expf(-bf2f(gl[0]))), g1 = 1.0f / (1.0f + __expf(-bf2f(gl[1]))), g2 = 1.0f / (1.0f + __expf(-bf2f(gl[2])));
        const float is = 1.0f / fmaxf(S.l, 1e-30f), iw = 1.0f / fmaxf(W.l, 1e-30f);
        const float o0 = g0 * oc0[hh] + g1 * (S.a0 * is) + g2 * (W.a0 * iw), o1 = g0 * oc1[hh] + g1 * (S.a1 * is) + g2 * (W.a1 * iw);
        *(unsigned*)(O + row * DM + 2048 + h * 128 + 2 * lane) = pk2(o0, o1);
    }
}
__device__ __forceinline__ void sb_row(const Ctx& c, LAS float* qs, const bf16* Y, bf16* O, int b, int h, int t) {
    const int lane = c.lane; const size_t row = (size_t)b * T + t; const bf16* Yb = Y + (size_t)b * T * ODD_LD;
    load_q(qs, Y + row * ODD_LD + C_SQ + h * 128, lane);
    const bf16* Kb = Yb + C_SK + h * 128; const bf16* Vb = Yb + C_SV + h * 128;
    float carry = 0.f, a0 = 0.f, a1 = 0.f;
    for (int c0 = 0; c0 < t; c0 += 64) {
        const int key = t - 1 - c0 - lane; const bool valid = key >= 0; const int koff = (valid ? key : 0) * ODD_LD;
        const float z = dot128(qs, Kb + koff) * ATT_SCALE;
        const float L = __logf(1.0f + __expf(-fabsf(z)));
        const float lsp = fminf(z, 0.f) - L;
        const float lr = valid ? (lsp - z) : 0.f;
        float incl = lr;
#pragma unroll
        for (int o = 1; o < 64; o <<= 1) { const float u = __shfl_up(incl, o); if (lane >= o) incl += u; }
        const float a = valid ? __expf(lsp + carry + (incl - lr)) : 0.f;
        carry += rdlane(incl, 63);
        pv_accum(a0, a1, a, koff, Vb, lane);
    }
    *(unsigned*)(O + row * DM + h * 128 + 2 * lane) = pk2(a0, a1);
}
__device__ __forceinline__ void dil_row(const Ctx& c, LAS float* qs, const bf16* Y, bf16* O, int b, int hd, int t) {
    const int lane = c.lane; const size_t row = (size_t)b * T + t; const bf16* Yb = Y + (size_t)b * T * ODD_LD;
    float og0[3], og1[3], lse[3];
#pragma unroll
    for (int gi = 0; gi < 3; ++gi) {
        const int r = gi == 0 ? 1 : (gi == 1 ? 4 : 16), nd = gi * 8 + hd;
        load_q(qs, Y + row * ODD_LD + C_DQ + nd * 128, lane);
        const bf16* Kb = Yb + C_DK + nd * 128; const bf16* Vb = Yb + C_DV + nd * 128;
        SoftAcc S; sa_init(S);
        for (int c0 = 0; c0 < 129; c0 += 64) {
            const int ci = c0 + lane, key = t - r * ci; const bool valid = (ci <= 128) && key >= 0; const int koff = (valid ? key : 0) * ODD_LD;
            float s = dot128(qs, Kb + koff) * ATT_SCALE; if (!valid) s = NEG_INF;
            sa_chunk(S, s, koff, Vb, lane);
        }
        const float inv = 1.0f / fmaxf(S.l, 1e-30f);
        og0[gi] = S.a0 * inv; og1[gi] = S.a1 * inv; lse[gi] = S.m + __logf(fmaxf(S.l, 1e-30f));
    }
    const float mx = fmaxf(lse[0], fmaxf(lse[1], lse[2]));
    const float w0 = __expf(lse[0] - mx), w1 = __expf(lse[1] - mx), w2 = __expf(lse[2] - mx), iw = 1.0f / (w0 + w1 + w2);
    *(unsigned*)(O + row * DM + 3072 + hd * 128 + 2 * lane) = pk2((w0 * og0[0] + w1 * og0[1] + w2 * og0[2]) * iw, (w0 * og1[0] + w1 * og1[1] + w2 * og1[2]) * iw);
}
__device__ __forceinline__ void xattn_row(const Ctx& c, LAS float* qs, const bf16* QX, const bf16* KVX, bf16* OX, int b, int h, int t) {
    const int lane = c.lane; const size_t row = (size_t)b * T + t;
    load_q(qs, QX + row * XW + h * 128, lane);
    const bf16* Kb = KVX + (size_t)b * MEM_LEN * 1024 + h * 128; const bf16* Vb = Kb + 512;
    SoftAcc S; sa_init(S);
    for (int c0 = 0; c0 < MEM_LEN; c0 += 64) { const int koff = (c0 + lane) * 1024; const float s = dot128(qs, Kb + koff) * ATT_SCALE; sa_chunk(S, s, koff, Vb, lane); }
    const float inv = 1.0f / fmaxf(S.l, 1e-30f);
    *(unsigned*)(OX + row * XW + h * 128 + 2 * lane) = pk2(S.a0 * inv, S.a1 * inv);
}
__device__ __forceinline__ int spread_t(int i) { return ((i & (T - 1)) + (i >> 11) * 997) & (T - 1); }


namespace fa {
typedef short bf16x8 __attribute__((ext_vector_type(8)));
typedef short s16x4 __attribute__((ext_vector_type(4)));
typedef float f32x16 __attribute__((ext_vector_type(16)));
typedef unsigned u32x2 __attribute__((ext_vector_type(2)));
constexpr int KT_BYTES = 64 * 256, VT_BYTES = 64 * 256, STAGE = KT_BYTES + VT_BYTES;
constexpr float C2 = 0.08838834764831845f * 1.4426950408889634f;
struct Unit {
    const bf16* q; int qstride;
    const bf16* k; int kstride;
    const bf16* v; int vstride;
    bf16* o; int ostride;
    float* lse; int lse_stride;
    const unsigned* sel; int sel_stride;
    int pos0, t_lo, t_hi;
    int window, causal;
    int sel_shift, own_blk, nrows;
    const bf16* comb_oc; const bf16* comb_os; const bf16* comb_gl; int comb_gls;
    const float* qp; const float* qgain; const float* qssq;
    size_t qps;
    const float* kmean;
};
__device__ __forceinline__ unsigned cvtpk(float lo, float hi) { return pg8::cvt_pk_bf16(lo, hi); }
__device__ __forceinline__ float xmax32(float v) { return fmaxf(v, __shfl_xor(v, 32)); }
__device__ __forceinline__ float xsum32(float v) { return v + __shfl_xor(v, 32); }
__device__ __forceinline__ float xother32(float v, int) { return __shfl_xor(v, 32); }
__device__ __forceinline__ bf16x8 pack8(const f32x16& p, const int b) { v4u w = {cvtpk(p[b + 0], p[b + 1]), cvtpk(p[b + 2], p[b + 3]), cvtpk(p[b + 4], p[b + 5]), cvtpk(p[b + 6], p[b + 7])}; return __builtin_bit_cast(bf16x8, w); }

#define FA_LOAD(tile) do { const int kb_ = (tile) * 64; const bf16* kp_ = u.k + (size_t)(kb_ + sr) * u.kstride + sc * 8; kq0 = *(const v4u*)kp_; kq1 = *(const v4u*)(kp_ + (size_t)32 * u.kstride); \
        const bf16* vp_ = u.v + (size_t)(kb_ + sr) * u.vstride + sc * 8; vq0 = *(const v4u*)vp_; vq1 = *(const v4u*)(vp_ + (size_t)32 * u.vstride); } while (0)
#define FA_WRITE(st) do { LAS unsigned char* b_ = L + (st) * STAGE; *(LAS v4u*)(b_ + kw0) = kq0; *(LAS v4u*)(b_ + kw0 + 32 * 256) = kq1; \
        *(LAS v4u*)(b_ + vw0) = vq0; *(LAS v4u*)(b_ + vw0 + 32 * 256) = vq1; } while (0)
#define FA_SB0() __builtin_amdgcn_sched_barrier(0)
#define FA_QK(st) do { const LAS unsigned char* kl_ = L + (st) * STAGE; p0 = f32x16{}; p1 = f32x16{}; \
        _Pragma("unroll") for (int h_ = 0; h_ < 2; ++h_) { bf16x8 ka_[4], kb_[4]; \
            _Pragma("unroll") for (int d1 = 0; d1 < 4; ++d1) { const int cb_ = ((4 * h_ + d1) * 32 + hi * 16) ^ ((r32 & 15) << 4); ka_[d1] = *(const LAS bf16x8*)(kl_ + r32 * 256 + cb_); kb_[d1] = *(const LAS bf16x8*)(kl_ + (32 + r32) * 256 + cb_); } \
            FA_SB0(); \
            _Pragma("unroll") for (int d1 = 0; d1 < 4; ++d1) { p0 = __builtin_amdgcn_mfma_f32_32x32x16_bf16(ka_[d1], q[4 * h_ + d1], p0, 0, 0, 0); p1 = __builtin_amdgcn_mfma_f32_32x32x16_bf16(kb_[d1], q[4 * h_ + d1], p1, 0, 0, 0); } \
            FA_SB0(); } } while (0)
#define FA_TRRD(dst, addr, off) asm volatile("ds_read_b64_tr_b16 %0, %1 offset:%2" : "=&v"(dst) : "v"(addr), "i"(off) : "memory")
#define FA_PV(st) do { const int so_ = (st) * STAGE; \
        _Pragma("unroll") for (int db = 0; db < 4; ++db) { const int a0_ = vtr[2 * db] + so_, a1_ = vtr[2 * db + 1] + so_; s16x4 l0_, h0_, l1_, h1_, l2_, h2_, l3_, h3_; \
            FA_TRRD(l0_, a0_, 0); FA_TRRD(h0_, a1_, 0); FA_TRRD(l1_, a0_, 4096); FA_TRRD(h1_, a1_, 4096); FA_TRRD(l2_, a0_, 8192); FA_TRRD(h2_, a1_, 8192); FA_TRRD(l3_, a0_, 12288); FA_TRRD(h3_, a1_, 12288); \
            asm volatile("s_waitcnt lgkmcnt(0)" ::: "memory"); FA_SB0(); \
            o[db] = __builtin_amdgcn_mfma_f32_32x32x16_bf16((bf16x8){l0_[0], l0_[1], l0_[2], l0_[3], h0_[0], h0_[1], h0_[2], h0_[3]}, P[0], o[db], 0, 0, 0); \
            o[db] = __builtin_amdgcn_mfma_f32_32x32x16_bf16((bf16x8){l1_[0], l1_[1], l1_[2], l1_[3], h1_[0], h1_[1], h1_[2], h1_[3]}, P[1], o[db], 0, 0, 0); \
            o[db] = __builtin_amdgcn_mfma_f32_32x32x16_bf16((bf16x8){l2_[0], l2_[1], l2_[2], l2_[3], h2_[0], h2_[1], h2_[2], h2_[3]}, P[2], o[db], 0, 0, 0); \
            o[db] = __builtin_amdgcn_mfma_f32_32x32x16_bf16((bf16x8){l3_[0], l3_[1], l3_[2], l3_[3], h3_[0], h3_[1], h3_[2], h3_[3]}, P[3], o[db], 0, 0, 0); \
            FA_SB0(); } } while (0)
#define FA_VTR_SETUP() int vtr[8]; { const int q_ = (lane & 15) >> 2, p_ = lane & 3, ch_ = (lane >> 4) & 1; const int lb_ = (int)(unsigned)(size_t)L; \
        _Pragma("unroll") for (int db = 0; db < 4; ++db) { _Pragma("unroll") for (int s_ = 0; s_ < 2; ++s_) { const int row_ = 8 * s_ + 4 * hi + q_, chunk_ = 4 * db + 2 * ch_ + (p_ >> 1); \
            vtr[2 * db + s_] = lb_ + KT_BYTES + 256 * row_ + 16 * (chunk_ ^ (((row_ & 3) << 2) | ((row_ >> 2) & 3))) + 8 * (p_ & 1); } } }

template <int MODE>
__device__ __forceinline__ void run_unit(const Ctx& c, const Unit& u) {
    const int tid = c.tid, lane = c.lane, w = c.wave, r32 = lane & 31, hi = lane >> 5;
    LAS unsigned char* L = c.lds;
    const int row = 32 * w + r32; const bool wact = 32 * w < u.nrows;
    bf16x8 q[8];
    if (MODE == 0 && u.qp) {
        const float* bp = u.qp + (size_t)row * 512 + hi * 8; f32x4 va[8], vb[8]; float ss = 0.f;
        const float rsx = 1.0f / sqrtf(u.qssq[row] * (1.0f / 4096.0f) + 1e-6f);
#pragma unroll
        for (int d0 = 0; d0 < 8; ++d0) { f32x4 a = *(const f32x4*)(bp + 16 * d0), b = *(const f32x4*)(bp + 16 * d0 + 4);
#pragma unroll
            for (int ks = 1; ks < 4; ++ks) { a += *(const f32x4*)(bp + ks * u.qps + 16 * d0); b += *(const f32x4*)(bp + ks * u.qps + 16 * d0 + 4); }
            a *= rsx; b *= rsx; va[d0] = a; vb[d0] = b; ss += ((a.x * a.x + a.y * a.y) + (a.z * a.z + a.w * a.w)) + ((b.x * b.x + b.y * b.y) + (b.z * b.z + b.w * b.w)); }
        ss = xsum32(ss);
        const float rstd = 1.0f / sqrtf(ss * (1.0f / 128.0f) + 1e-6f);
#pragma unroll
        for (int d0 = 0; d0 < 8; ++d0) { const f32x4 ga = *(const f32x4*)(u.qgain + 16 * d0 + hi * 8), gb = *(const f32x4*)(u.qgain + 16 * d0 + hi * 8 + 4); const f32x4 a = va[d0] * rstd * ga, b = vb[d0] * rstd * gb;
            v4u wq; wq.x = cvtpk(a.x, a.y); wq.y = cvtpk(a.z, a.w); wq.z = cvtpk(b.x, b.y); wq.w = cvtpk(b.z, b.w); q[d0] = __builtin_bit_cast(bf16x8, wq); }
    } else { const bf16* qp = u.q + (size_t)(wact ? row : 0) * u.qstride + hi * 8;
#pragma unroll
      for (int d0 = 0; d0 < 8; ++d0) q[d0] = *(const bf16x8*)(qp + 16 * d0); }
    const int pq = u.pos0 + row, wlo = u.pos0 + 32 * w, whi = wlo + 31;
    unsigned selm = 0xffffffffu; if (u.sel && wact) selm = u.sel[(size_t)row * u.sel_stride];
    const int sr = tid >> 4, sc = tid & 15, vr = tid >> 3, vc = tid & 7;
    const int kw0 = sr * 256 + ((sc * 16) ^ ((sr & 15) << 4)), vw0 = KT_BYTES + 256 * sr + 16 * (sc ^ (((sr & 3) << 2) | ((sr >> 2) & 3)));
    FA_VTR_SETUP();
    v4u kq0, kq1, vq0, vq1;
    f32x16 o[4] = {f32x16{}, f32x16{}, f32x16{}, f32x16{}}; f32x16 p0, p1; bf16x8 P[4];
    float m_run = -1e30f, l_run = 0.f, carry = 0.f;
    const int nt = u.t_hi - u.t_lo;
    __syncthreads();
    if (nt > 0) { FA_LOAD(MODE == 0 ? u.t_lo : u.t_hi - 1); FA_WRITE(0); }
    if (MODE == 0 && u.kmean) {
        const int grow = tid >> 5, gd4 = (tid & 31) * 4, gn = grow & 7; const f32x4 km = *(const f32x4*)(u.kmean + gn * 128 + gd4);
        unsigned h0 = f2bf(km.x), h1 = f2bf(km.y), h2 = f2bf(km.z), h3 = f2bf(km.w);
        if (grow >> 3) { h0 = f2bf(km.x - bflo(h0)); h1 = f2bf(km.y - bflo(h1)); h2 = f2bf(km.z - bflo(h2)); h3 = f2bf(km.w - bflo(h3)); }
        *(LAS u32x2*)(L + STAGE + grow * 256 + ((gd4 * 2) ^ ((grow & 15) << 4))) = (u32x2){h0 | (h1 << 16), h2 | (h3 << 16)};
    }
    __syncthreads();
    if (MODE == 0 && u.kmean) {
        FA_QK(1);
        float gown[4], g8[8];
#pragma unroll
        for (int e = 0; e < 4; ++e) gown[e] = p0[e] + p0[4 + e];
#pragma unroll
        for (int e = 0; e < 4; ++e) { const float go = xother32(gown[e], hi); g8[e] = hi ? go : gown[e]; g8[4 + e] = hi ? gown[e] : go; }
#pragma unroll
        for (int n = 0; n < 8; ++n) if (n >= u.own_blk) g8[n] = NEG_INF;
        selm = 0u;
#pragma unroll
        for (int n = 0; n < 8; ++n) { int rank = 0;
#pragma unroll
            for (int m2 = 0; m2 < 8; ++m2) rank += (g8[m2] > g8[n] || (g8[m2] == g8[n] && m2 < n)) ? 1 : 0;
            if (rank < 3 && n < u.own_blk) selm |= 1u << n; }
        __syncthreads();
    }
    for (int i = 0; i < nt; ++i) {
        const int tile = MODE == 0 ? u.t_lo + i : u.t_hi - 1 - i, st = i & 1, kb = tile * 64;
        if (i + 1 < nt) FA_LOAD(MODE == 0 ? tile + 1 : tile - 1);
        if (MODE == 0) {
            bool act = wact;
            if (u.causal && (kb > whi || kb + 63 <= wlo - u.window)) act = false;
            bool allowed = true;
            if (u.sel || u.kmean) { const int blk = tile >> u.sel_shift; allowed = (blk == u.own_blk) || ((selm >> blk) & 1u); if (!__any(allowed)) act = false; }
            if (act) {
                FA_QK(st);
                if (u.causal && (kb + 63 > wlo || kb <= whi - u.window)) {
                    const int dq = pq - kb - 4 * hi;
#pragma unroll
                    for (int r = 0; r < 16; ++r) { const int cc = (r & 3) + 8 * (r >> 2);
                        if ((unsigned)(dq - cc) >= (unsigned)u.window) p0[r] = NEG_INF;
                        if ((unsigned)(dq - cc - 32) >= (unsigned)u.window) p1[r] = NEG_INF; }
                }
                if (!allowed) {
#pragma unroll
                    for (int r = 0; r < 16; ++r) { p0[r] = NEG_INF; p1[r] = NEG_INF; } }
                float pm = fmaxf(p0[0], p1[0]);
#pragma unroll
                for (int r = 1; r < 16; ++r) pm = fmaxf(pm, fmaxf(p0[r], p1[r]));
                pm = xmax32(pm);
                if (__any((pm - m_run) * C2 > 11.5f)) {
                    const float mn = fmaxf(m_run, pm), alpha = __builtin_amdgcn_exp2f((m_run - mn) * C2); m_run = mn; l_run *= alpha;
#pragma unroll
                    for (int db = 0; db < 4; ++db)
#pragma unroll
                        for (int r = 0; r < 16; ++r) o[db][r] *= alpha; }
                const float mb = m_run * C2;
                float ps = 0.f;
#pragma unroll
                for (int r = 0; r < 16; ++r) { p0[r] = __builtin_amdgcn_exp2f(p0[r] * C2 - mb); p1[r] = __builtin_amdgcn_exp2f(p1[r] * C2 - mb); ps += p0[r] + p1[r]; }
                l_run += ps;
                P[0] = pack8(p0, 0); P[1] = pack8(p0, 8); P[2] = pack8(p1, 0); P[3] = pack8(p1, 8);
                FA_PV(st);
            }
        } else {
            if (wact && kb < whi && __any(carry > -110.0f)) {
                FA_QK(st);
                const int dq = pq - kb - 4 * hi;
                float own[8];
#define FA_SBG(PP, g, koff) do { float lr_[4], ls_[4]; \
                    _Pragma("unroll") for (int e = 0; e < 4; ++e) { const int cc = e + 8 * (g) + (koff); const float z = PP[4 * (g) + e] * ATT_SCALE; const float lg = __logf(1.0f + __expf(-fabsf(z))); \
                        const bool strict = dq - cc > 0; const float lr = fminf(z, 0.f) - lg - z; lr_[e] = strict ? lr : 0.f; ls_[e] = strict ? lr + z : NEG_INF; } \
                    PP[4 * (g) + 3] = ls_[3]; PP[4 * (g) + 2] = ls_[2] + lr_[3]; PP[4 * (g) + 1] = ls_[1] + (lr_[3] + lr_[2]); PP[4 * (g)] = ls_[0] + (lr_[3] + lr_[2] + lr_[1]); \
                    own[(g) + ((koff) ? 4 : 0)] = (lr_[3] + lr_[2]) + (lr_[1] + lr_[0]); } while (0)
                FA_SBG(p0, 0, 0); FA_SBG(p0, 1, 0); FA_SBG(p0, 2, 0); FA_SBG(p0, 3, 0); FA_SBG(p1, 0, 32); FA_SBG(p1, 1, 32); FA_SBG(p1, 2, 32); FA_SBG(p1, 3, 32);
#undef FA_SBG
                float oth[8];
#pragma unroll
                for (int g = 0; g < 8; ++g) oth[g] = xother32(own[g], hi);
                float suf = carry;
#pragma unroll
                for (int g = 7; g >= 0; --g) {
                    const float base = suf + (hi == 0 ? oth[g] : 0.f);
                    if (g >= 4) {
#pragma unroll
                        for (int e = 0; e < 4; ++e) p1[4 * (g - 4) + e] = __expf(p1[4 * (g - 4) + e] + base);
                    } else {
#pragma unroll
                        for (int e = 0; e < 4; ++e) p0[4 * g + e] = __expf(p0[4 * g + e] + base);
                    }
                    suf += own[g] + oth[g];
                }
                carry = suf;
                P[0] = pack8(p0, 0); P[1] = pack8(p0, 8); P[2] = pack8(p1, 0); P[3] = pack8(p1, 8);
                FA_PV(st);
            }
        }
        if (i + 1 < nt) FA_WRITE(st ^ 1);
        if (MODE == 1) {
            if (!__syncthreads_or((wact && carry > -110.0f) ? 1 : 0)) break;
        } else __syncthreads();
    }
    if (wact) {
        float inv = 1.0f;
        if (MODE == 0) { const float lt = xsum32(l_run); inv = lt > 0.f ? 1.0f / lt : 0.f;
            if (u.lse && hi == 0) u.lse[(size_t)row * u.lse_stride] = m_run * ATT_SCALE + __logf(fmaxf(lt, 1e-30f)); }
        bf16* op = u.o + (size_t)row * u.ostride + 4 * hi;
        if (MODE == 0 && u.comb_gl) {
            const bf16* gl = u.comb_gl + (size_t)row * u.comb_gls;
            const float g0 = 1.0f / (1.0f + __expf(-bf2f(gl[0]))), g1 = 1.0f / (1.0f + __expf(-bf2f(gl[1]))), g2 = inv / (1.0f + __expf(-bf2f(gl[2])));
            const bf16* pc = u.comb_oc + (size_t)row * 2048 + 4 * hi; const bf16* ps_ = u.comb_os + (size_t)row * 2048 + 4 * hi;
#pragma unroll
            for (int db = 0; db < 4; ++db)
#pragma unroll
                for (int g = 0; g < 4; ++g) { const u32x2 wc = *(const u32x2*)(pc + 32 * db + 8 * g), wsv = *(const u32x2*)(ps_ + 32 * db + 8 * g); u32x2 wv;
                    wv.x = cvtpk(g0 * bflo(wc.x) + g1 * bflo(wsv.x) + g2 * o[db][4 * g], g0 * bfhi(wc.x) + g1 * bfhi(wsv.x) + g2 * o[db][4 * g + 1]);
                    wv.y = cvtpk(g0 * bflo(wc.y) + g1 * bflo(wsv.y) + g2 * o[db][4 * g + 2], g0 * bfhi(wc.y) + g1 * bfhi(wsv.y) + g2 * o[db][4 * g + 3]);
                    *(u32x2*)(op + 32 * db + 8 * g) = wv; }
        } else {
#pragma unroll
        for (int db = 0; db < 4; ++db)
#pragma unroll
            for (int g = 0; g < 4; ++g) { u32x2 wv; wv.x = cvtpk(o[db][4 * g] * inv, o[db][4 * g + 1] * inv); wv.y = cvtpk(o[db][4 * g + 2] * inv, o[db][4 * g + 3] * inv);
                *(u32x2*)(op + 32 * db + 8 * g) = wv; }
        }
    }
}

__device__ __forceinline__ void cmp_unit(const Ctx& c, const bf16* Yq  , int ldy, const bf16* Kc, const bf16* Vct, bf16* OCrow  , unsigned* SELrow  , int tt) {
    const int tid = c.tid, lane = c.lane, w = c.wave, r32 = lane & 31, hi = lane >> 5;
    LAS unsigned char* L = c.lds;
    const int tok = 8 * w + (r32 >> 2), hh = r32 & 3, t = 64 * tt + tok;
    struct { const bf16* k; int kstride; const bf16* v; int vstride; } u; u.k = Kc; u.kstride = 128; u.v = Vct; u.vstride = 128;
    bf16x8 q[8];
    { const bf16* qp = Yq + (size_t)tok * ldy + hh * 128 + hi * 8;
#pragma unroll
      for (int d0 = 0; d0 < 8; ++d0) q[d0] = *(const bf16x8*)(qp + 16 * d0); }
    const int sr = tid >> 4, sc = tid & 15, vr = tid >> 3, vc = tid & 7;
    const int kw0 = sr * 256 + ((sc * 16) ^ ((sr & 15) << 4)), vw0 = KT_BYTES + 256 * sr + 16 * (sc ^ (((sr & 3) << 2) | ((sr >> 2) & 3)));
    FA_VTR_SETUP();
    v4u kq0, kq1, vq0, vq1;
    __syncthreads();
    FA_LOAD(0); FA_WRITE(0); FA_LOAD(1); FA_WRITE(1);
    __syncthreads();
    f32x16 p0, p1, s00, s01;
    FA_QK(0); s00 = p0; s01 = p1;
    FA_QK(1);
    const int nmax = (t - 31) >> 4;
    { const int nb = 4 * hi;
#pragma unroll
      for (int r = 0; r < 16; ++r) { const int cc = (r & 3) + 8 * (r >> 2) + nb;
          if (cc > nmax) s00[r] = NEG_INF; if (cc + 32 > nmax) s01[r] = NEG_INF; if (cc + 64 > nmax) p0[r] = NEG_INF; if (cc + 96 > nmax || cc + 96 > 126) p1[r] = NEG_INF; } }
    float pm = NEG_INF;
#pragma unroll
    for (int r = 0; r < 16; ++r) pm = fmaxf(pm, fmaxf(fmaxf(s00[r], s01[r]), fmaxf(p0[r], p1[r])));
    pm = xmax32(pm);
    const float mb = (pm == NEG_INF ? 0.f : pm) * C2;
    float ps = 0.f;
#pragma unroll
    for (int r = 0; r < 16; ++r) { s00[r] = __builtin_amdgcn_exp2f(s00[r] * C2 - mb); s01[r] = __builtin_amdgcn_exp2f(s01[r] * C2 - mb); p0[r] = __builtin_amdgcn_exp2f(p0[r] * C2 - mb); p1[r] = __builtin_amdgcn_exp2f(p1[r] * C2 - mb);
        ps += (s00[r] + s01[r]) + (p0[r] + p1[r]); }
    ps = xsum32(ps);
    const float inv = 1.0f / fmaxf(ps, 1e-30f);
#pragma unroll
    for (int r = 0; r < 16; ++r) { s00[r] *= inv; s01[r] *= inv; p0[r] *= inv; p1[r] *= inv; }
    f32x16 o[4] = {f32x16{}, f32x16{}, f32x16{}, f32x16{}}; bf16x8 P[4];
    P[0] = pack8(s00, 0); P[1] = pack8(s00, 8); P[2] = pack8(s01, 0); P[3] = pack8(s01, 8); FA_PV(0);
    P[0] = pack8(p0, 0); P[1] = pack8(p0, 8); P[2] = pack8(p1, 0); P[3] = pack8(p1, 8); FA_PV(1);
    { bf16* op = OCrow + (size_t)tok * 2048 + hh * 128 + 4 * hi;
#pragma unroll
      for (int db = 0; db < 4; ++db)
#pragma unroll
          for (int g = 0; g < 4; ++g) { u32x2 wv; wv.x = cvtpk(o[db][4 * g], o[db][4 * g + 1]); wv.y = cvtpk(o[db][4 * g + 2], o[db][4 * g + 3]); *(u32x2*)(op + 32 * db + 8 * g) = wv; } }
    float cs[16], cl[16];
#pragma unroll
    for (int rq = 0; rq < 4; ++rq) {
        cs[rq] = (s00[4 * rq] + s00[4 * rq + 1]) + (s00[4 * rq + 2] + s00[4 * rq + 3]); cl[rq] = s00[4 * rq + 3];
        cs[4 + rq] = (s01[4 * rq] + s01[4 * rq + 1]) + (s01[4 * rq + 2] + s01[4 * rq + 3]); cl[4 + rq] = s01[4 * rq + 3];
        cs[8 + rq] = (p0[4 * rq] + p0[4 * rq + 1]) + (p0[4 * rq + 2] + p0[4 * rq + 3]); cl[8 + rq] = p0[4 * rq + 3];
        cs[12 + rq] = (p1[4 * rq] + p1[4 * rq + 1]) + (p1[4 * rq + 2] + p1[4 * rq + 3]); cl[12 + rq] = p1[4 * rq + 3]; }
#pragma unroll
    for (int k = 0; k < 16; ++k) { cs[k] += __shfl_xor(cs[k], 1); cs[k] += __shfl_xor(cs[k], 2); cl[k] += __shfl_xor(cl[k], 1); cl[k] += __shfl_xor(cl[k], 2); }
    float impE[16], impO[16];
    { float ocs[16], ocl[16];
#pragma unroll
      for (int k = 0; k < 16; ++k) { ocs[k] = xother32(cs[k], hi); ocl[k] = xother32(cl[k], hi); }
#pragma unroll
      for (int k = 0; k < 16; ++k) { const float ecs = hi ? ocs[k] : cs[k], ocs_ = hi ? cs[k] : ocs[k], clO = hi ? ocl[k] : cl[k];
          float clE = 0.f; if (k > 0) clE = hi ? cl[k - 1] : ocl[k - 1];
          impE[k] = ecs + clE; impO[k] = ocs_ + clO; } }
    LAS float* tab = (LAS float*)(L + 2 * STAGE) + (8 * w + (r32 >> 2)) * 32;
    if (hh == 0 && hi == 0) {
#pragma unroll
        for (int k = 0; k < 16; ++k) { const int je = 2 * k, jo = 2 * k + 1;
            const float ve = (je == 0 || je == tt) ? __builtin_inff() : (je <= tt ? impE[k] : NEG_INF), vo = (jo == tt) ? __builtin_inff() : (jo <= tt ? impO[k] : NEG_INF);
            tab[je] = ve; tab[jo] = vo; } }
    LDS_FENCE();
    const int a4 = 4 * (hh + 4 * hi);
    const f32x4 vj = *(const LAS f32x4*)(tab + a4);
    int rk0 = 0, rk1 = 0, rk2 = 0, rk3 = 0;
#pragma unroll
    for (int i4 = 0; i4 < 8; ++i4) { const f32x4 vi = *(const LAS f32x4*)(tab + 4 * i4);
#pragma unroll
        for (int e = 0; e < 4; ++e) { const float x = vi[e]; const int i = 4 * i4 + e;
            rk0 += (x > vj.x || (x == vj.x && i < a4 + 0)) ? 1 : 0; rk1 += (x > vj.y || (x == vj.y && i < a4 + 1)) ? 1 : 0;
            rk2 += (x > vj.z || (x == vj.z && i < a4 + 2)) ? 1 : 0; rk3 += (x > vj.w || (x == vj.w && i < a4 + 3)) ? 1 : 0; } }
    unsigned m = 0u;
    if (rk0 < 16 && a4 + 0 <= tt) m |= 1u << (a4 + 0); if (rk1 < 16 && a4 + 1 <= tt) m |= 1u << (a4 + 1); if (rk2 < 16 && a4 + 2 <= tt) m |= 1u << (a4 + 2); if (rk3 < 16 && a4 + 3 <= tt) m |= 1u << (a4 + 3);
    m |= (unsigned)__shfl_xor((int)m, 1); m |= (unsigned)__shfl_xor((int)m, 2); m |= (unsigned)__shfl_xor((int)m, 32);
    if (hh == 0 && hi == 0) SELrow[tok] = m;
    LDS_FENCE();
}
#undef FA_LOAD
#undef FA_WRITE
#undef FA_QK
#undef FA_PV
#undef FA_TRRD
#undef FA_VTR_SETUP
#undef FA_SB0
}


__device__ __forceinline__ void cmp_bias(const Ctx& c, const float* pe_k, const float* pe_v, const float* phi_k, const float* phi_v, float* cbias) {
    for (int it = c.gw; it < 256; it += c.ngw) {
        const int which = it >> 7, e = it & 127; const float* pe = which ? pe_v : pe_k; const float* phi = which ? phi_v : phi_k; float s = 0.f;
        for (int k = c.lane; k < 4096; k += 64) s += pe[k] * phi[(size_t)k * 128 + e];
        s = wsum(s); if (c.lane == 0) cbias[it] = s;
    }
}
__device__ __forceinline__ void cmp_mfma(const Ctx& c, const bf16* Y, const bf16* PHIKT, const bf16* PHIVT, float* KCR4, float* VCR4) {
    const int lane = c.lane, r32 = lane & 31, hi = lane >> 5;
    for (int it = c.gw; it < 2048; it += c.ngw) {
        const int lq = it & 3, eb = (it >> 2) & 3, nt = (it >> 4) & 3, bg = (it >> 6) & 15, which = it >> 10, b = bg >> 2, g = bg & 3;
        const int n = (32 * nt + r32) < 126 ? (32 * nt + r32) : 126;
        const bf16* arow = Y + ((size_t)b * T + 16 * n + 8 * lq) * EVEN_LD + (which ? C_VC : C_KC) + g * 128 + hi * 8;
        const bf16* brow = (which ? PHIVT : PHIKT) + (size_t)(32 * eb + r32) * 4096 + (8 * lq) * 128 + hi * 8;
        fa::f32x16 acc = {};
        fa::bf16x8 a0[8], b0[8], a1[8], b1[8];
#define CM_LOAD(l, A_, B_) do { _Pragma("unroll") for (int s8 = 0; s8 < 8; ++s8) { A_[s8] = *(const fa::bf16x8*)(arow + (size_t)(l) * EVEN_LD + 16 * s8); B_[s8] = *(const fa::bf16x8*)(brow + (l) * 128 + 16 * s8); } __builtin_amdgcn_sched_barrier(0); } while (0)
#define CM_MMA(A_, B_) do { _Pragma("unroll") for (int s8 = 0; s8 < 8; ++s8) acc = __builtin_amdgcn_mfma_f32_32x32x16_bf16(A_[s8], B_[s8], acc, 0, 0, 0); __builtin_amdgcn_sched_barrier(0); } while (0)
        CM_LOAD(0, a0, b0);
#pragma unroll 1
        for (int l = 0; l < 8; l += 2) {
            CM_LOAD(l + 1, a1, b1); CM_MMA(a0, b0);
            if (l + 2 < 8) CM_LOAD(l + 2, a0, b0);
            CM_MMA(a1, b1);
        }
#undef CM_LOAD
#undef CM_MMA
        float* dst = (which ? VCR4 : KCR4) + (size_t)lq * (16 * 128 * 128) + ((size_t)bg * 128 + 32 * nt) * 128 + 32 * eb + r32;
#pragma unroll
        for (int r = 0; r < 16; ++r) { const int nn = (r & 3) + 8 * (r >> 2) + 4 * hi; if (32 * nt + nn < 127) dst[nn * 128] = acc[r]; }
    }
}
__device__ __forceinline__ void vt_pass(const Ctx& c, const bf16* Ysrc, int ld, int col0, int nheads, bf16* VT, int NH, int head0, int TL, int dil_mode) {
    LAS unsigned char* scr = c.lds + c.wave * 16384; const int lane = c.lane; const int npb = TL / 32, items = NB * nheads * npb;
    for (int it = c.gw; it < items; it += c.ngw) {
        const int pb = it % npb, bh = it / npb, hh = bh % nheads, b = bh / nheads;
        const int r = dil_mode ? (hh < 8 ? 1 : (hh < 16 ? 4 : 16)) : 1, CL = TL / r, pp0 = 32 * pb, cls = pp0 / CL, i0 = pp0 - cls * CL, tok0 = cls + r * i0;
        const bf16* src = Ysrc + ((size_t)b * TL + tok0) * ld + col0 + hh * 128;
#pragma unroll
        for (int k = 0; k < 8; ++k) { const int ci = lane + 64 * k, rr = ci >> 4, ch = ci & 15; const v4u w = *(const v4u*)(src + (size_t)rr * r * ld + ch * 8);
            LAS unsigned* d2 = (LAS unsigned*)(scr + rr * 264 + ch * 16); d2[0] = w.x; d2[1] = w.y; d2[2] = w.z; d2[3] = w.w; }
        LDS_FENCE();
        bf16* dst = VT + ((size_t)(b * NH + head0 + hh) * 128) * TL + pp0;
#pragma unroll
        for (int k = 0; k < 8; ++k) { const int ci = lane + 64 * k, d = ci >> 2, q4 = ci & 3; const LAS bf16* s = (const LAS bf16*)(scr + (8 * q4) * 264 + 2 * d);
            v4u o; o.x = (unsigned)s[0] | ((unsigned)s[132] << 16); o.y = (unsigned)s[2 * 132] | ((unsigned)s[3 * 132] << 16); o.z = (unsigned)s[4 * 132] | ((unsigned)s[5 * 132] << 16); o.w = (unsigned)s[6 * 132] | ((unsigned)s[7 * 132] << 16);
            *(v4u*)(dst + (size_t)d * TL + 8 * q4) = o; }
        LDS_FENCE();
    }
}
__device__ __forceinline__ void moba_sel_row(const Ctx& c, LAS float* qs, const bf16* Y, const float* kmean, unsigned* SELM, int b, int h, int t) {
    const int lane = c.lane; const size_t row = (size_t)b * T + t;
    load_q(qs, Y + row * EVEN_LD + C_MQ + h * 128, lane);
    const int cur = t >> 8;
    float gate = NEG_INF;
    if (lane < cur) { const float* km = kmean + ((size_t)(b * 16 + h) * 8 + lane) * 128; float s = 0.f; for (int d = 0; d < 128; ++d) s += qs[d] * km[d]; gate = s; }
    int rank = 0;
    for (int m2 = 0; m2 < 8; ++m2) { const float gm = rdlane(gate, m2); rank += (gm > gate || (gm == gate && m2 < lane)) ? 1 : 0; }
    const unsigned selmask = (unsigned)__ballot((lane < cur) && (rank < 3));
    if (lane == 0) SELM[(size_t)(b * 16 + h) * T + t] = selmask;
}
__device__ __forceinline__ void nsa_cmp_item(const Ctx& c, LAS float* qs, LAS float* ps, const bf16* Y, const bf16* KCN, const bf16* VCN, bf16* OC, unsigned* SELN, int b, int g, int t) {
    const int lane = c.lane; const size_t row = (size_t)b * T + t;
    const bf16* Kc = KCN + (size_t)(b * 4 + g) * 128 * 128; const bf16* Vc = VCN + (size_t)(b * 4 + g) * 128 * 128;
    float P0 = 0.f, P1 = 0.f;
    const int n0 = lane, n1 = 64 + lane; const bool v0 = 16 * n0 + 31 <= t, v1 = (n1 < 127) && (16 * n1 + 31 <= t);
#pragma unroll 1
    for (int hh = 0; hh < 4; ++hh) {
        const int h = g * 4 + hh;
        load_q(qs, Y + row * EVEN_LD + C_NQ + h * 128, lane);
        float s0 = dot128(qs, Kc + (v0 ? n0 : 0) * 128) * ATT_SCALE, s1 = dot128(qs, Kc + (v1 ? n1 : 0) * 128) * ATT_SCALE;
        if (!v0) s0 = NEG_INF; if (!v1) s1 = NEG_INF;
        const float m = wmax(fmaxf(s0, s1)); float a0 = 0.f, a1 = 0.f;
        if (m != NEG_INF) {
            float p0 = __expf(s0 - m), p1 = __expf(s1 - m);
            const float inv = 1.0f / fmaxf(wsum(p0 + p1), 1e-30f);
            p0 *= inv; p1 *= inv; P0 += p0; P1 += p1;
            pv_accum(a0, a1, p0, n0 * 128, Vc, lane); pv_accum(a0, a1, p1, (v1 ? n1 : 0) * 128, Vc, lane);
        }
        *(unsigned*)(OC + row * 2048 + h * 128 + 2 * lane) = pk2(a0, a1);
    }
    LDS_FENCE(); ps[lane] = P0; ps[64 + lane] = P1; LDS_FENCE();
    float imp = 0.f;
    if (lane < 32) { for (int n = 4 * lane - 1; n <= 4 * lane + 3; ++n) if (n >= 0 && n < 127) imp += ps[n]; }
    const int cur = t >> 6;
    const float v = (lane >= 32) ? NEG_INF : ((lane == cur || lane == 0) ? __builtin_inff() : (lane <= cur ? imp : NEG_INF));
    int rank = 0;
    for (int m2 = 0; m2 < 32; ++m2) { const float vm = rdlane(v, m2); rank += (vm > v || (vm == v && m2 < lane)) ? 1 : 0; }
    const unsigned selmask = (unsigned)__ballot(lane < 32 && lane <= cur && rank < 16);
    if (lane == 0) SELN[(size_t)(b * 4 + g) * T + t] = selmask;
}
__device__ __forceinline__ void nsa_combine(const Ctx& c, const bf16* Y, const bf16* OC, const bf16* OS, const bf16* OW, bf16* O) {
    const int lane = c.lane;
    for (int it = c.gw; it < MTOK * 16; it += c.ngw) {
        const int row = it >> 4, h = it & 15; const size_t off = (size_t)row * 2048 + h * 128 + 2 * lane;
        const bf16* gl = Y + (size_t)row * EVEN_LD + C_GL + h * 3;
        const float g0 = 1.0f / (1.0f + __expf(-bf2f(gl[0]))), g1 = 1.0f / (1.0f + __expf(-bf2f(gl[1]))), g2 = 1.0f / (1.0f + __expf(-bf2f(gl[2])));
        const unsigned wc = *(const unsigned*)(OC + off), wsv = *(const unsigned*)(OS + off), ww = *(const unsigned*)(OW + off);
        *(unsigned*)(O + (size_t)row * DM + 2048 + h * 128 + 2 * lane) = pk2(g0 * bflo(wc) + g1 * bflo(wsv) + g2 * bflo(ww), g0 * bfhi(wc) + g1 * bfhi(wsv) + g2 * bfhi(ww));
    }
}
__device__ __forceinline__ void dil_combine(const Ctx& c, const bf16* OG, const float* LSE, bf16* O) {
    const int lane = c.lane;
    for (int it = c.gw; it < MTOK * 8; it += c.ngw) {
        const int row = it >> 3, hd = it & 7; const size_t off = (size_t)row * 1024 + hd * 128 + 2 * lane;
        const float l0 = LSE[(size_t)row * 8 + hd], l1 = LSE[(size_t)MTOK * 8 + (size_t)row * 8 + hd], l2 = LSE[(size_t)2 * MTOK * 8 + (size_t)row * 8 + hd];
        const float mx = fmaxf(l0, fmaxf(l1, l2)); const float w0 = __expf(l0 - mx), w1 = __expf(l1 - mx), w2 = __expf(l2 - mx), iw = 1.0f / (w0 + w1 + w2);
        const unsigned a = *(const unsigned*)(OG + off), bq = *(const unsigned*)(OG + (size_t)MTOK * 1024 + off), cq = *(const unsigned*)(OG + (size_t)2 * MTOK * 1024 + off);
        *(unsigned*)(O + (size_t)row * DM + 3072 + hd * 128 + 2 * lane) = pk2((w0 * bflo(a) + w1 * bflo(bq) + w2 * bflo(cq)) * iw, (w0 * bfhi(a) + w1 * bfhi(bq) + w2 * bfhi(cq)) * iw);
    }
}
__device__ __forceinline__ int snake(int round, int b, int G) { return (round & 1) ? round * G + (G - 1 - b) : round * G + b; }

struct Args { const float* in[31]; float* out; unsigned char* ws; int ph_lo, ph_hi; };
#if MK_ONE_LAUNCH
#define GRID_BAR() xcd_barrier(bar)
#else
#define GRID_BAR() do { } while (0)
#endif
#define IN(k) (lo <= (k) && (k) < hi)
#define SEAM(k) do { if (IN(k) && IN((k) + 1)) GRID_BAR(); if (PROBE_MASK != 0ull) { const unsigned long long now_ = __builtin_amdgcn_s_memrealtime(); if ((PROBE_MASK >> (k)) & 1ull) pacc += now_ - pprev; pprev = now_; } } while (0)
template <int layer>
__device__ __forceinline__ void run_layer(const Args& args, const Ctx& c, const XcdBarrier& bar, const int lo, const int hi, unsigned long long& pprev, unsigned long long& pacc) {
    unsigned char* ws = args.ws;
    const float* x_in = args.in[0]; const float* mem = args.in[1]; const int* positions = (const int*)args.in[2];
    float* ropec = (float*)(ws + WS_ROPE); float* ropes = ropec + MTOK * 64;
    float* kmean = (float*)(ws + WS_KMEAN); float* KCR = (float*)(ws + WS_QP); float* VCR = (float*)(ws + WS_QP + 4 * MiB);
    bf16* KCN = (bf16*)(ws + WS_KCN); bf16* VCN = (bf16*)(ws + WS_VCN); bf16* MEMN = (bf16*)(ws + WS_MEMN);
    bf16* QX = (bf16*)(ws + WS_QX); bf16* KVX = (bf16*)(ws + WS_KVX); bf16* OX = (bf16*)(ws + WS_OX);
    bf16* WQ_T = (bf16*)(ws + WS_WQ); bf16* WKV_T = (bf16*)(ws + WS_WKV); bf16* WO_T = (bf16*)(ws + WS_WO); bf16* WOUT_T = (bf16*)(ws + WS_WOUT);
    bf16* WIN_T = (bf16*)(ws + (layer == 0 ? WS_WIN : WS_WIN1)); bf16* WGU_T = (bf16*)(ws + WS_WGU); bf16* WD_T = (bf16*)(ws + (layer == 0 ? WS_WD : WS_WD1));
    float* X = (float*)(ws + WS_X); bf16* H = (bf16*)(ws + WS_H); bf16* O = (bf16*)(ws + WS_O); bf16* Y = (bf16*)(ws + WS_Y); bf16* HID = Y;
    LAS float* qs = (LAS float*)(c.lds + c.wave * 16384); LAS float* ps = qs + 128;
    float* SSQ = (float*)(ws + WS_CTL) + CW_SSQ;
    float* QP = (float*)(ws + WS_QP); bf16* MEMN2 = (bf16*)(ws + WS_MEMN2); bf16* KVX2 = (bf16*)(ws + WS_KVX2); bf16* WKV2 = (bf16*)(ws + WS_WKV2); bf16* KVXL = KVX2 + (size_t)layer * 1024 * 2048;
    bf16* PHIKT = (bf16*)(ws + WS_PHIK); bf16* PHIVT = (bf16*)(ws + WS_PHIV); float* CBIAS = (float*)(ws + WS_CBIAS);
    bf16* VT = (bf16*)(ws + WS_VT); bf16* PART = (bf16*)(ws + WS_PART); bf16* VTX = (bf16*)(ws + WS_VTX); unsigned* SELM = (unsigned*)(ws + WS_SELM); unsigned* SELN = (unsigned*)(ws + WS_SELN);
    constexpr int pb = layer * NPL; constexpr bool even = (layer & 1) == 0;
    const int e_rem1 = ((MTOK / 256) * (EVEN_LD / 256)) % c.G, e_ns1 = e_rem1 ? (c.G - e_rem1 - 32 > 0 ? c.G - e_rem1 - 32 : 0) : 0;
    const int e_rem2 = ((MTOK / 256) * (GU_ROWS / 256)) % c.G, e_ns2 = e_rem2 ? c.G - e_rem2 : 0;
    const int e_it1 = e_ns1 * 8 * EARLY_N1, e_it2 = e_it1 + e_ns2 * 8 * EARLY_N2;
#if FUSE_HEADNORM
#define WIN1_RM RmHeads{0x0FFFFFF000000000ull, 0ull}
#else
#define WIN1_RM RmId{0}
#endif

        const int LDY = even ? EVEN_LD : ODD_LD;
        const float* xcur = layer == 0 ? x_in : X;
        if (IN(pb + 0)) REPS(pb + 0) {
#if FUSE_HEADNORM
            if (even) conv_weight(c, args.in[4], DM, EVEN_N, EVEN_LD, WIN_T, RmHeads{0x330ff00ffffull, 0ull}, layer == 0 ? nullptr : args.in[3] + layer * DM); else conv_weight(c, args.in[16], DM, ODD_LD, ODD_LD, WIN_T, RmHeads{0x0FFFFFF000000000ull, 0ull}, layer == 0 ? nullptr : args.in[3] + layer * DM, layer == 1 ? e_it2 : 0);
#else
            if (even) conv_weight(c, args.in[4], DM, EVEN_N, EVEN_LD, WIN_T, RmId{0}, layer == 0 ? nullptr : args.in[3] + layer * DM); else conv_weight(c, args.in[16], DM, ODD_LD, ODD_LD, WIN_T, RmId{0}, layer == 0 ? nullptr : args.in[3] + layer * DM, layer == 1 ? e_it2 : 0);
#endif
            conv_weight(c, even ? args.in[5] : args.in[17], DM, DM, DM, WOUT_T, RmId{0});
            conv_weight(c, args.in[22] + (size_t)layer * DM * XW, DM, XW, XW, WQ_T, RmId{0}, args.in[20] + layer * DM);
            if constexpr (layer == 0) { conv_weight(c, args.in[23], DM, 2 * XW, 2 * XW, WKV2, RmId{0}); conv_weight(c, args.in[23] + (size_t)DM * 2 * XW, DM, 2 * XW, 2 * XW, WKV2, RmId{1024}); }
            conv_weight(c, args.in[24] + (size_t)layer * XW * DM, XW, DM, DM, WO_T, RmId{0});
            conv_weight(c, args.in[28] + (size_t)layer * DM * FFN, DM, FFN, FFN, WGU_T, RmGU{0}, args.in[27] + layer * DM);
            conv_weight(c, args.in[29] + (size_t)layer * DM * FFN, DM, FFN, FFN, WGU_T, RmGU{1}, args.in[27] + layer * DM);
            conv_weight(c, args.in[30] + (size_t)layer * FFN * DM, FFN, DM, DM, WD_T, RmId{0});
            if (layer == 0) rope_table(c, positions, ropec, ropes);
            if constexpr (even) { conv_weight(c, args.in[14], 4096, 128, 128, PHIKT, RmId{0}); conv_weight(c, args.in[15], 4096, 128, 128, PHIVT, RmId{0}); cmp_bias(c, args.in[12], args.in[13], args.in[14], args.in[15], CBIAS); }
            if constexpr (layer == 0) { rmsnorm_rows(c, mem, args.in[21], MEMN2, MEM_ROWS); rmsnorm_rows(c, mem, args.in[21] + DM, MEMN2 + (size_t)MEM_ROWS * DM, MEM_ROWS); }
            if constexpr (layer == 0) rmsnorm_rows(c, xcur, args.in[3] + layer * DM, H, MTOK);
        }
        SEAM(pb + 0);
        if (IN(pb + 1)) REPS(pb + 1) {
            pg8::Gemm g{H, WIN_T, MTOK, LDY, DM, DM}; pg8::StaticOrder S; S.init(MTOK, LDY, c.G, (int)blockIdx.x);
#if FUSE_HEADNORM
            pg8::HeadSpec hs{};
            if (even) { hs.lo[0] = 0; hs.hi[0] = 8; hs.g[0] = args.in[6]; hs.lo[1] = 8; hs.hi[1] = 16; hs.g[1] = args.in[7]; hs.lo[2] = 24; hs.hi[2] = 32; hs.g[2] = args.in[8]; hs.lo[3] = 36; hs.hi[3] = 38; hs.g[3] = args.in[10]; hs.lo[4] = 40; hs.hi[4] = 42; hs.g[4] = args.in[11]; }
            else { hs.lo[0] = 36; hs.hi[0] = 48; hs.g[0] = args.in[18]; hs.lo[1] = 48; hs.hi[1] = 60; hs.g[1] = args.in[19]; }
            pg8::EpiYHeads E{Y, LDY, layer == 0 ? nullptr : SSQ + (size_t)((layer - 1) * 3 + 2) * MTOK, hs, ropec, ropes, (LAS float*)(c.lds + 132096)};
            pg8::gemm_phase<pg8::EpiYHeads, pg8::StaticOrder, true, true>(c.lds, g, S, E);
#else
            pg8::EpiBf16P E{Y, LDY, layer == 0 ? nullptr : SSQ + (size_t)((layer - 1) * 3 + 2) * MTOK};
            pg8::gemm_phase<pg8::EpiBf16P, pg8::StaticOrder, true, true>(c.lds, g, S, E);
#endif
            if constexpr (layer == 0) {
                pg8::Gemm g2{MEMN2, WKV2, 2 * MEM_ROWS, 2 * 1024, DM, DM}; pg8::DiagOrder S2; S2.init(2, 4, 4, c.G, c.G - 1 - (int)blockIdx.x); pg8::EpiBf16P E2{KVX2, 2048, nullptr};
                pg8::gemm_phase<pg8::EpiBf16P, pg8::DiagOrder, true, true>(c.lds, g2, S2, E2);
                const int j1 = (int)blockIdx.x - e_rem1;
                if (j1 >= 0 && j1 < e_ns1) { __syncthreads(); conv_weight<decltype(WIN1_RM), EARLY_NT != 0>(c, args.in[16], DM, ODD_LD, ODD_LD, (bf16*)(ws + WS_WIN1), WIN1_RM, args.in[3] + DM, 0, e_it1, j1 * 8 + c.wave, e_ns1 * 8); }
            }
        }
        SEAM(pb + 1);
        if constexpr (even || !FUSE_HEADNORM) {
        if (IN(pb + 2)) REPS(pb + 2) {
            if (even) {
#if !FUSE_HEADNORM
                headnorm_bf16(c, Y, EVEN_LD, C_MQ, 16, MTOK, args.in[6], ropec, ropes);
                headnorm_bf16(c, Y, EVEN_LD, C_MK, 16, MTOK, args.in[7], ropec, ropes);
                headnorm_bf16(c, Y, EVEN_LD, C_NQ, 16, MTOK, args.in[8], ropec, ropes);
                headnorm_bf16(c, Y, EVEN_LD, C_KS, 4, MTOK, args.in[10], ropec, ropes);
                headnorm_bf16(c, Y, EVEN_LD, C_KW, 4, MTOK, args.in[11], ropec, ropes);
#endif
                cmp_mfma(c, Y, PHIKT, PHIVT, KCR, VCR);
#if FUSE_HEADNORM
                moba_kmean(c, Y, kmean);
#endif
            } else {
#if !FUSE_HEADNORM
                headnorm_bf16(c, Y, ODD_LD, C_DQ, 24, MTOK, args.in[18], ropec, ropes);
                headnorm_bf16(c, Y, ODD_LD, C_DK, 24, MTOK, args.in[19], ropec, ropes);
#endif
            }
        }
        SEAM(pb + 2);
        }
        if constexpr (even) {
            if (IN(pb + 3)) REPS(pb + 3) { cmp_finish(c, KCR, VCR, CBIAS, KCN, VCN, args.in[9], ropec, ropes); if (!FUSE_HEADNORM) moba_kmean(c, Y, kmean); }
            SEAM(pb + 3);
            if (IN(pb + 4)) REPS(pb + 4) {
#if FA_EVEN
                for (int idx = (int)blockIdx.x; idx < NB * 4 * 32; idx += c.G) { const int tt = 31 - (idx >> 4), bg = idx & 15, b = bg >> 2, g = bg & 3; const size_t r0 = (size_t)b * T + 64 * tt;
                    fa::cmp_unit(c, Y + r0 * EVEN_LD + C_NQ + 4 * g * 128, EVEN_LD, KCN + (size_t)bg * 128 * 128, VCN + (size_t)bg * 128 * 128, PART + r0 * 2048 + 4 * g * 128, SELN + (size_t)bg * T + 64 * tt, tt); }
#endif
            }
            SEAM(pb + 4);
        }
        if (IN(pb + 5)) REPS(pb + 5) {
            if constexpr (even && !FA_EVEN) {
                for (int it = c.gw; it < NB * 16 * T; it += c.ngw) { const int bh = it >> 11; moba_row(c, qs, Y, kmean, O, bh >> 4, bh & 15, spread_t(it)); }
                for (int it = c.gw; it < NB * 4 * T; it += c.ngw) { const int bg = it >> 11; nsa_item(c, qs, ps, Y, KCN, VCN, O, bg >> 2, bg & 3, spread_t(it)); }
            } else if constexpr (!even && !FA_ODD) {
                for (int it = c.gw; it < NB * 24 * T; it += c.ngw) { const int bh = it >> 11; sb_row(c, qs, Y, O, bh / 24, bh % 24, spread_t(it)); }
                for (int it = c.gw; it < NB * 8 * T; it += c.ngw) { const int bh = it >> 11; dil_row(c, qs, Y, O, bh >> 3, bh & 7, spread_t(it)); }
            } else if constexpr (even) {
                bf16* OS = PART + (size_t)MTOK * 2048; bf16* OW = PART + (size_t)2 * MTOK * 2048;
                for (int blk = (int)blockIdx.x; blk < 256; blk += c.G)
#pragma unroll 1
                for (int round = 0; round < 3; ++round) {
                    const int xcd = blk & 7, slot = blk >> 3;
#pragma unroll 1
                    for (int half = 0; half < 2; ++half) {
                        fa::Unit u; u.qp = nullptr; u.qgain = nullptr; u.qssq = nullptr; u.qps = 0; u.comb_gl = nullptr; u.comb_oc = nullptr; u.comb_os = nullptr; u.comb_gls = 0; u.kmean = nullptr; u.lse = nullptr; u.lse_stride = 0; u.causal = 1; u.nrows = 256; u.qstride = EVEN_LD; u.kstride = EVEN_LD; u.vstride = EVEN_LD; u.sel_stride = 1; u.t_lo = 0; u.window = 1 << 30;
                        u.sel = nullptr; u.sel_shift = 0; u.own_blk = -1;
                        if (round == 0) {
                            const int fam = xcd * 8 + (slot >> 2), pr = slot & 3, qb = half ? pr : 7 - pr, b = fam >> 4, h = fam & 15; const size_t r0 = (size_t)b * T + 256 * qb;
                            u.pos0 = 256 * qb; u.t_hi = 4 * qb + 4;
                            u.q = Y + r0 * EVEN_LD + C_MQ + h * 128; u.k = Y + (size_t)b * T * EVEN_LD + C_MK + h * 128; u.v = Y + (size_t)b * T * EVEN_LD + C_MV + h * 128;
                            u.o = O + r0 * DM + h * 128; u.ostride = DM; u.kmean = kmean + (size_t)(b * 16 + h) * 8 * 128; u.sel_shift = 2; u.own_blk = qb;
                        } else {
                            const int fam = xcd * 2 + (slot >> 4), j = slot & 15, hh = j >> 2, pr = j & 3, b = fam >> 2, g = fam & 3, h = g * 4 + hh;
                            const int qb = half ? pr : 7 - pr; const size_t r0 = (size_t)b * T + 256 * qb;
                            u.pos0 = 256 * qb; u.t_hi = 4 * qb + 4; u.q = Y + r0 * EVEN_LD + C_NQ + h * 128; u.ostride = 2048;
                            if (round == 1) { u.k = Y + (size_t)b * T * EVEN_LD + C_KS + g * 128; u.v = Y + (size_t)b * T * EVEN_LD + C_VS + g * 128; u.o = OS + r0 * 2048 + h * 128; u.sel = SELN + (size_t)(b * 4 + g) * T + 256 * qb; }
                            else { u.k = Y + (size_t)b * T * EVEN_LD + C_KW + g * 128; u.v = Y + (size_t)b * T * EVEN_LD + C_VW + g * 128; u.t_lo = qb >= 2 ? 4 * qb - 8 : 0; u.window = 512;
                                u.o = O + r0 * DM + 2048 + h * 128; u.ostride = DM; u.comb_oc = PART + r0 * 2048 + h * 128; u.comb_os = OS + r0 * 2048 + h * 128; u.comb_gl = Y + r0 * EVEN_LD + C_GL + h * 3; u.comb_gls = EVEN_LD; }
                        }
                        fa::run_unit<0>(c, u);
                    }
                }
            } else {
                float* LSE = (float*)(ws + WS_LSE);
                if constexpr (!FA_SB) { for (int it = c.gw; it < NB * 24 * T; it += c.ngw) { const int bh = it >> 11; sb_row(c, qs, Y, O, bh / 24, bh % 24, spread_t(it)); } }
                if constexpr (!FA_DIL) { for (int it = c.gw; it < NB * 8 * T; it += c.ngw) { const int bh = it >> 11; dil_row(c, qs, Y, O, bh >> 3, bh & 7, spread_t(it)); } }
                for (int round = 0; round < 7 * 256 / c.G + 1; ++round) {
                    const int idx = snake(round, (int)blockIdx.x, c.G); if (idx >= 1792) continue;
                    if (!FA_SB && idx < 768) continue;
                    if (!FA_DIL && idx >= 768) continue;
#ifdef PROBE_SKIP_DIL
                    if (idx >= 768) continue;
#endif
#ifdef PROBE_SKIP_SB
                    if (idx < 768) continue;
#endif
                    fa::Unit u; u.qp = nullptr; u.qgain = nullptr; u.qssq = nullptr; u.qps = 0; u.comb_gl = nullptr; u.comb_oc = nullptr; u.comb_os = nullptr; u.comb_gls = 0; u.kmean = nullptr; u.lse = nullptr; u.lse_stride = 0; u.causal = 1; u.nrows = 256; u.qstride = ODD_LD; u.kstride = ODD_LD; u.vstride = ODD_LD; u.sel = nullptr; u.sel_stride = 0; u.sel_shift = 0; u.own_blk = -1; u.t_lo = 0; u.window = 1 << 30;
                    if (idx < 768) {
                        const int qb = 7 - idx / 96, bh = idx % 96, b = bh / 24, h = bh % 24; const size_t r0 = (size_t)b * T + 256 * qb;
                        u.pos0 = 256 * qb; u.t_hi = 4 * qb + 4;
                        u.q = Y + r0 * ODD_LD + C_SQ + h * 128; u.k = Y + (size_t)b * T * ODD_LD + C_SK + h * 128; u.v = Y + (size_t)b * T * ODD_LD + C_SV + h * 128; u.o = O + r0 * DM + h * 128; u.ostride = DM;
                        fa::run_unit<1>(c, u);
                    } else {
                        int gi, r, b, hd, cls, un;
                        if (idx < 1024) { const int j = idx - 768; gi = 0; r = 1; un = j & 7; hd = (j >> 3) & 7; b = j >> 6; cls = 0; }
                        else if (idx < 1280) { const int j = idx - 1024; gi = 1; r = 4; un = j & 1; cls = (j >> 1) & 3; hd = (j >> 3) & 7; b = j >> 6; }
                        else { const int j = idx - 1280; gi = 2; r = 16; un = 0; cls = j & 15; hd = (j >> 4) & 7; b = j >> 7; }
                        const int nd = gi * 8 + hd, CL = T / r; const size_t tok0 = (size_t)b * T + cls + (size_t)r * 256 * un;
                        u.nrows = CL < 256 ? CL : 256; u.pos0 = 256 * un; u.t_lo = un > 0 ? 4 * un - 2 : 0; u.t_hi = (4 * un + 4) < CL / 64 ? (4 * un + 4) : CL / 64; u.window = 129;
                        u.qstride = r * ODD_LD; u.kstride = r * ODD_LD; u.vstride = r * ODD_LD;
                        u.q = Y + tok0 * ODD_LD + C_DQ + nd * 128; u.k = Y + ((size_t)b * T + cls) * ODD_LD + C_DK + nd * 128; u.v = Y + ((size_t)b * T + cls) * ODD_LD + C_DV + nd * 128;
                        u.o = PART + (size_t)gi * MTOK * 1024 + tok0 * 1024 + hd * 128; u.ostride = r * 1024; u.lse = LSE + (size_t)gi * MTOK * 8 + tok0 * 8 + hd; u.lse_stride = r * 8;
                        fa::run_unit<0>(c, u);
                    }
                }
            }
        }
        SEAM(pb + 5);
        if constexpr (!even) {
            if (IN(pb + 6)) REPS(pb + 6) { if constexpr (FA_ODD && FA_DIL) dil_combine(c, PART, (const float*)(ws + WS_LSE), O); }
            SEAM(pb + 6);
        }
        if (IN(pb + 7)) REPS(pb + 7) {
            pg8::Gemm g{O, WOUT_T, MTOK, DM, DM, DM}; pg8::StaticOrder S; S.init(MTOK, DM, c.G, (int)blockIdx.x);
#if RES_BF16
            if constexpr (layer == 0) { pg8::EpiResBf16N<float> E{x_in, DM, H, SSQ + (size_t)(layer * 3 + 0) * MTOK}; pg8::gemm_phase<pg8::EpiResBf16N<float>, pg8::StaticOrder, true, true>(c.lds, g, S, E); }
            else { pg8::EpiResBf16N<bf16> E{H, DM, H, SSQ + (size_t)(layer * 3 + 0) * MTOK}; pg8::gemm_phase<pg8::EpiResBf16N<bf16>, pg8::StaticOrder, true, true>(c.lds, g, S, E); }
#else
            pg8::EpiResF32N E{xcur, X, DM, H, SSQ + (size_t)(layer * 3 + 0) * MTOK};
            pg8::gemm_phase<pg8::EpiResF32N, pg8::StaticOrder, true, true>(c.lds, g, S, E);
#endif
        }
        SEAM(pb + 7);
        if (IN(pb + 9)) REPS(pb + 9) {
            pg8::Gemm g{H, WQ_T, MTOK, XW, DM, DM / 4}; pg8::SplitKOrder S; S.init(MTOK, XW, 4, c.G, (int)blockIdx.x); pg8::EpiF32Part E{QP, XW, (size_t)MTOK * XW};
            pg8::gemm_phase<pg8::EpiF32Part, pg8::SplitKOrder, true, true>(c.lds, g, S, E);
            headnorm_bf16(c, KVXL, 2048, layer * 1024, 4, MEM_ROWS, args.in[26] + layer * HD, nullptr, nullptr);
        }
        SEAM(pb + 9);
        if (IN(pb + 11)) REPS(pb + 11) {
            if constexpr (!FA_XATTN) { for (int it = c.gw; it < NB * 4 * T; it += c.ngw) { const int bh = it >> 11; xattn_row(c, qs, QX, KVX, OX, bh >> 2, bh & 3, it & (T - 1)); } }
            else for (int idx = (int)blockIdx.x; idx < 128; idx += c.G) {
                const int qb = idx & 7, bh = idx >> 3, b = bh >> 2, h = bh & 3; const size_t r0 = (size_t)b * T + 256 * qb;
                fa::Unit u; u.qp = nullptr; u.qgain = nullptr; u.qssq = nullptr; u.qps = 0; u.comb_gl = nullptr; u.comb_oc = nullptr; u.comb_os = nullptr; u.comb_gls = 0; u.kmean = nullptr; u.lse = nullptr; u.lse_stride = 0; u.causal = 0; u.nrows = 256; u.qstride = XW; u.kstride = 2048; u.vstride = 2048; u.sel = nullptr; u.sel_stride = 0; u.sel_shift = 0; u.own_blk = -1;
                u.t_lo = 0; u.t_hi = 4; u.window = 1 << 30; u.pos0 = 0;
                u.q = nullptr; u.qp = QP + r0 * XW + h * 128; u.qps = (size_t)MTOK * XW; u.qgain = args.in[25] + layer * HD; u.qssq = SSQ + (size_t)(layer * 3 + 0) * MTOK + r0; u.k = KVXL + (size_t)b * MEM_LEN * 2048 + layer * 1024 + h * 128; u.v = KVXL + (size_t)b * MEM_LEN * 2048 + layer * 1024 + XW + h * 128; u.o = OX + r0 * XW + h * 128; u.ostride = XW;
                fa::run_unit<0>(c, u);
            }
        }
        SEAM(pb + 11);
        if (IN(pb + 12)) REPS(pb + 12) {
            pg8::Gemm g{OX, WO_T, MTOK, DM, XW, XW}; pg8::StaticOrder S; S.init(MTOK, DM, c.G, (int)blockIdx.x);
#if RES_BF16
            pg8::EpiResBf16N<bf16> E{H, DM, H, SSQ + (size_t)(layer * 3 + 1) * MTOK}; pg8::gemm_phase<pg8::EpiResBf16N<bf16>, pg8::StaticOrder, true, true>(c.lds, g, S, E);
#else
            pg8::EpiResF32N E{X, X, DM, H, SSQ + (size_t)(layer * 3 + 1) * MTOK};
            pg8::gemm_phase<pg8::EpiResF32N, pg8::StaticOrder, true, true>(c.lds, g, S, E);
#endif
        }
        SEAM(pb + 12);
        if (IN(pb + 14)) REPS(pb + 14) {
            pg8::Gemm g{H, WGU_T, MTOK, GU_ROWS, DM, DM}; pg8::StaticOrder S; S.init(MTOK, GU_ROWS, c.G, (int)blockIdx.x);
            pg8::EpiSwiGLU E{HID, FFN, SSQ + (size_t)(layer * 3 + 1) * MTOK};
            pg8::gemm_phase<pg8::EpiSwiGLU, pg8::StaticOrder, true, true>(c.lds, g, S, E);
            if constexpr (layer == 0) { const int j2 = (int)blockIdx.x - e_rem2;
                if (e_ns2 > 0 && j2 >= 0) { __syncthreads(); conv_weight<decltype(WIN1_RM), EARLY_NT != 0>(c, args.in[16], DM, ODD_LD, ODD_LD, (bf16*)(ws + WS_WIN1), WIN1_RM, args.in[3] + DM, e_it1, e_it2, j2 * 8 + c.wave, e_ns2 * 8); } }
        }
        SEAM(pb + 14);
        if (IN(pb + 15)) REPS(pb + 15) {
            pg8::Gemm g{HID, WD_T, MTOK, DM, FFN, FFN}; pg8::StaticOrder S; S.init(MTOK, DM, c.G, (int)blockIdx.x);
#if RES_BF16
            if constexpr (layer == 1) { pg8::EpiOutBf16Res E{H, args.out, DM}; pg8::gemm_phase<pg8::EpiOutBf16Res, pg8::StaticOrder, true, true>(c.lds, g, S, E); }
            else { pg8::EpiResBf16N<bf16> E{H, DM, H, SSQ + (size_t)(layer * 3 + 2) * MTOK}; pg8::gemm_phase<pg8::EpiResBf16N<bf16>, pg8::StaticOrder, true, true>(c.lds, g, S, E); }
#else
            if constexpr (layer == 1) { pg8::EpiResF32 E{X, args.out, DM}; pg8::gemm_phase<pg8::EpiResF32, pg8::StaticOrder, true, true>(c.lds, g, S, E); }
            else { pg8::EpiResF32N E{X, X, DM, H, SSQ + (size_t)(layer * 3 + 2) * MTOK}; pg8::gemm_phase<pg8::EpiResF32N, pg8::StaticOrder, true, true>(c.lds, g, S, E); }
#endif
        }
        if constexpr (layer == 0) { if (PROBE_MASK != 0ull) SEAM(pb + 15); } else if (PROBE_MASK != 0ull) { GRID_BAR(); const unsigned long long now_ = __builtin_amdgcn_s_memrealtime(); if ((PROBE_MASK >> (pb + 15)) & 1ull) pacc += now_ - pprev; pprev = now_; }
}
__global__ void __launch_bounds__(NWAVES * 64, 2) fwd(Args args) {
    extern __shared__ __attribute__((aligned(16))) unsigned char lds_raw[];
    Ctx c; c.lds = (LAS unsigned char*)lds_raw; c.tid = threadIdx.x; c.lane = c.tid & 63; c.wave = __builtin_amdgcn_readfirstlane(c.tid >> 6);
    c.G = gridDim.x; c.gw = blockIdx.x * NWAVES + c.wave; c.ngw = c.G * NWAVES;
    unsigned* ctl = (unsigned*)(args.ws + WS_CTL);
    for (int u = c.tid; u < (LDS_BYTES - LDSCTL_OFF) / 4; u += NWAVES * 64) ((LAS unsigned*)(c.lds + LDSCTL_OFF))[u] = 0u;
    __syncthreads();
#if MK_ONE_LAUNCH
    XcdBarrier bar = xcd_barrier_post(ctl + CW_BAR, (volatile LAS unsigned*)(c.lds + MISC_OFF + 32));
#else
    XcdBarrier bar; bar.bar = ctl + CW_BAR; bar.x = 0; bar.st = nullptr;
#endif
    const int lo = args.ph_lo, hi = args.ph_hi;
    unsigned long long pprev = 0ull, pacc = 0ull;
    if (PROBE_MASK != 0ull) pprev = __builtin_amdgcn_s_memrealtime();
    run_layer<0>(args, c, bar, lo, hi, pprev, pacc);
    run_layer<1>(args, c, bar, lo, hi, pprev, pacc);
    if (PROBE_MASK != 0ull) { GRID_BAR(); if (blockIdx.x == 0 && c.tid == 0) args.out[0] += ((float)pacc * 0.01f - PROBE_OFF) * PROBE_SCALE; }
}
#undef IN
#undef SEAM

extern "C" void kernel_launch(void* const* d_in, const int* in_sizes, int n_in, void* d_out, int out_size, void* d_ws, size_t ws_size, hipStream_t stream) {
    static int grid = 0;
    if (grid == 0) {
        if (n_in != 31 || out_size != MTOK * DM || ws_size < WS_END) { fprintf(stderr, "kernel_launch: unexpected shapes (n_in %d, out %d, ws %zu)\n", n_in, out_size, ws_size); grid = -1; return; }
        int dev = 0, cus = 0;
        if (hipGetDevice(&dev) != hipSuccess || hipDeviceGetAttribute(&cus, hipDeviceAttributeMultiprocessorCount, dev) != hipSuccess) { grid = -1; return; }
        if (hipFuncSetAttribute((const void*)fwd, hipFuncAttributeMaxDynamicSharedMemorySize, LDS_BYTES) != hipSuccess) { fprintf(stderr, "kernel_launch: hipFuncSetAttribute failed\n"); grid = -1; return; }
        int per_cu = 0;
        if (hipOccupancyMaxActiveBlocksPerMultiprocessor(&per_cu, (const void*)fwd, NWAVES * 64, LDS_BYTES) != hipSuccess || per_cu < 1) fprintf(stderr, "kernel_launch: occupancy query reports %d\n", per_cu);
        (void)hipGetLastError();
        grid = cus;
    }
    if (grid < 0) return;
    (void)hipMemsetAsync((char*)d_ws + WS_CTL, 0, CTL_ZERO_BYTES, stream);
#ifdef EXTRA_MEMSET
    (void)hipMemsetAsync((char*)d_ws + WS_END, 0, 256, stream);
#endif
    Args a{};
    for (int i = 0; i < 31; ++i) a.in[i] = (const float*)d_in[i];
    a.out = (float*)d_out; a.ws = (unsigned char*)d_ws;
#if MK_ONE_LAUNCH
    a.ph_lo = 0; a.ph_hi = NPH;
    hipLaunchKernelGGL(fwd, dim3(grid), dim3(NWAVES * 64), LDS_BYTES, stream, a);
#else
    for (int ph = 0; ph < NPH; ++ph) {
        if (ph == 3 + NPL || ph == 4 + NPL || ph == 6 || (ph % NPL) == 8 || (ph % NPL) == 10 || (ph % NPL) == 13) continue;
        a.ph_lo = ph; a.ph_hi = ph + 1;
        hipLaunchKernelGGL(fwd, dim3(grid), dim3(NWAVES * 64), LDS_BYTES, stream, a);
    }
#endif
}
```

```cpp
#define MK_ONE_LAUNCH 1
#define RES_BF16 1
#define FUSE_HEADNORM 1
#define EARLY_N1 16
#define EARLY_N2 16
#include <hip/hip_runtime.h>
#include <cstdio>
#include <cstdint>
namespace pg8 {
#define PG8_LAS __attribute__((address_space(3)))
typedef unsigned short bf16_t;
typedef short bf16x8 __attribute__((ext_vector_type(8)));
typedef float f32x4 __attribute__((ext_vector_type(4)));
typedef unsigned u32x4 __attribute__((ext_vector_type(4)));
constexpr int BM = 256, BK = 64, HALF = 128, HTB = HALF * BK * 2  , STAGE_BYTES = 8 * HTB, NXCD = 8, WGM = 8;

__host__ __device__ __forceinline__ int lds_byte(int r, int c) { const int st = (r >> 4) * 2 + (c >> 5), rr = r & 15, cc = c & 31, ob = rr * 64 + cc * 2; return st * 1024 + (ob ^ (((ob >> 9) & 1) << 5)); }
__host__ __device__ __forceinline__ void stage_rc(int b, int& R, int& C) { const int st = b / 1024, sb = b % 1024, swz = sb ^ (((sb >> 9) & 1) << 5); R = (st >> 1) * 16 + swz / 64; C = (st & 1) * 32 + (swz % 64) / 2; }
__host__ __device__ __forceinline__ int perm32(int rho) { const int n = rho >> 4, i = rho & 15; return 8 * (i >> 2) + 4 * n + (i & 3); }

struct Unit { int pm, pn, ks; };
struct Gemm { const bf16_t* A; const bf16_t* Bt; int M, N, K, KL; };

struct StaticOrder {
    int nM, nN, nwg, G, c;
    __host__ __device__ void init(int M, int N, int G_, int c_) { nM = M / BM; nN = N / BM; nwg = nM * nN; G = G_; c = c_; }
    __host__ __device__ bool next(int i, Unit& u) const {
        const long L = (long)i * G + c; if (L >= nwg) return false;
        int wgid = (int)L; { const int q = nwg / NXCD, r = nwg % NXCD, xcd = wgid % NXCD, off = wgid / NXCD; wgid = (xcd < r ? xcd * (q + 1) : r * (q + 1) + (xcd - r) * q) + off; }
        const int nig = WGM * nN, gid = wgid / nig, fm = gid * WGM, gsz = (nM - fm) < WGM ? (nM - fm) : WGM;
        u.pm = fm + ((wgid % nig) % gsz); u.pn = (wgid % nig) / gsz; u.ks = 0; return true;
    }
    __device__ __forceinline__ void a_ready(const Unit&) const {}
    __device__ __forceinline__ void done(const Unit&) const {}
};
struct SplitKOrder {
    int nN, nS, total, G, c;
    __host__ __device__ void init(int M, int N, int nS_, int G_, int c_) { nN = N / BM; nS = nS_; total = (M / BM) * nN * nS; G = G_; c = c_; }
    __host__ __device__ bool next(int i, Unit& u) const { const long L = (long)i * G + c; if (L >= total) return false; const int l = (int)L; u.ks = l % nS; const int r = l / nS; u.pn = r % nN; u.pm = r / nN; return true; }
    __device__ __forceinline__ void a_ready(const Unit&) const {}
    __device__ __forceinline__ void done(const Unit&) const {}
};
struct DiagOrder {
    int bm, bn, total, G, c;
    __host__ __device__ void init(int nblk, int bm_, int bn_, int G_, int c_) { bm = bm_; bn = bn_; total = nblk * bm * bn; G = G_; c = c_; }
    __host__ __device__ bool next(int i, Unit& u) const { const long L = (long)i * G + c; if (L >= total) return false; const int l = (int)L, blk = l / (bm * bn), r = l % (bm * bn); u.pm = blk * bm + r / bn; u.pn = blk * bn + r % bn; u.ks = 0; return true; }
    __device__ __forceinline__ void a_ready(const Unit&) const {}
    __device__ __forceinline__ void done(const Unit&) const {}
};

typedef float f32x2c_t __attribute__((ext_vector_type(2)));
typedef __bf16 bf16x2c_t __attribute__((ext_vector_type(2)));
__device__ __forceinline__ unsigned cvt_pk_bf16(float lo, float hi) { const f32x2c_t v = {lo, hi}; const bf16x2c_t b = __builtin_convertvector(v, bf16x2c_t); return __builtin_bit_cast(unsigned, b); }
typedef float f32x2 __attribute__((ext_vector_type(2)));
__device__ __forceinline__ float row_rstd(const float* ssq, int row) { return ssq ? 1.0f / sqrtf(ssq[row] * (1.0f / 4096.0f) + 1e-6f) : 1.0f; }
struct EpiBf16P {
    static constexpr bool PERM = true, AFTER_DRAIN = false;
    bf16_t* O; int ldc; const float* ssq;
    __device__ __forceinline__ void operator()(const f32x4 (&acc)[2][2][4][2], const Unit& u, int wr, int wc, int fr, int fq) const {
        const int row0 = u.pm * BM + wr * 64 + fr, col0 = u.pn * BM + wc * 32 + 8 * fq;
#pragma unroll
        for (int ai = 0; ai < 2; ++ai)
#pragma unroll
            for (int m = 0; m < 4; ++m) { bf16_t* rowp = O + (size_t)(row0 + ai * HALF + m * 16) * ldc + col0; const float rs = row_rstd(ssq, row0 + ai * HALF + m * 16);
#pragma unroll
                for (int bj = 0; bj < 2; ++bj) { const f32x4 v0 = acc[ai][bj][m][0] * rs, v1 = acc[ai][bj][m][1] * rs;
                    u32x4 w; w.x = cvt_pk_bf16(v0[0], v0[1]); w.y = cvt_pk_bf16(v0[2], v0[3]); w.z = cvt_pk_bf16(v1[0], v1[1]); w.w = cvt_pk_bf16(v1[2], v1[3]);
                    *(u32x4*)(rowp + bj * HALF) = w; } }
    }
};
struct EpiResF32 {
    static constexpr bool PERM = true, AFTER_DRAIN = false;
    const float* base; float* out; int ldc;
    __device__ __forceinline__ void operator()(const f32x4 (&acc)[2][2][4][2], const Unit& u, int wr, int wc, int fr, int fq) const {
        const int row0 = u.pm * BM + wr * 64 + fr, col0 = u.pn * BM + wc * 32 + 8 * fq;
#pragma unroll
        for (int ai = 0; ai < 2; ++ai)
#pragma unroll
            for (int m = 0; m < 4; ++m) { const size_t off = (size_t)(row0 + ai * HALF + m * 16) * ldc + col0;
#pragma unroll
                for (int bj = 0; bj < 2; ++bj) { const f32x4 b0 = *(const f32x4*)(base + off + bj * HALF), b1 = *(const f32x4*)(base + off + bj * HALF + 4);
                    *(f32x4*)(out + off + bj * HALF) = b0 + acc[ai][bj][m][0]; *(f32x4*)(out + off + bj * HALF + 4) = b1 + acc[ai][bj][m][1]; }
                asm volatile("" ::: "memory"); }
    }
};
__device__ __forceinline__ float silu_mul(float g, float u) { return g * __builtin_amdgcn_rcpf(1.0f + __builtin_amdgcn_exp2f(-1.4426950408889634f * g)) * u; }
struct EpiSwiGLU {
    static constexpr bool PERM = true, AFTER_DRAIN = false;
    bf16_t* O; int ldc; const float* ssq;
    __device__ __forceinline__ void operator()(const f32x4 (&acc)[2][2][4][2], const Unit& u, int wr, int wc, int fr, int fq) const {
        const int row0 = u.pm * BM + wr * 64 + fr, col0 = u.pn * HALF + wc * 32 + 8 * fq;
#pragma unroll
        for (int ai = 0; ai < 2; ++ai)
#pragma unroll
            for (int m = 0; m < 4; ++m) { bf16_t* rowp = O + (size_t)(row0 + ai * HALF + m * 16) * ldc + col0; const float rs = row_rstd(ssq, row0 + ai * HALF + m * 16);
                const f32x4 g0 = acc[ai][0][m][0] * rs, g1 = acc[ai][0][m][1] * rs, u0 = acc[ai][1][m][0] * rs, u1 = acc[ai][1][m][1] * rs;
                u32x4 w; w.x = cvt_pk_bf16(silu_mul(g0[0], u0[0]), silu_mul(g0[1], u0[1])); w.y = cvt_pk_bf16(silu_mul(g0[2], u0[2]), silu_mul(g0[3], u0[3]));
                w.z = cvt_pk_bf16(silu_mul(g1[0], u1[0]), silu_mul(g1[1], u1[1])); w.w = cvt_pk_bf16(silu_mul(g1[2], u1[2]), silu_mul(g1[3], u1[3]));
                *(u32x4*)rowp = w; }
    }
};
struct EpiF32Part {
    static constexpr bool PERM = false, AFTER_DRAIN = false;
    float* P; int ldc; size_t part_stride;
    __device__ __forceinline__ void operator()(const f32x4 (&acc)[2][2][4][2], const Unit& u, int wr, int wc, int fr, int fq) const {
        const int row0 = u.pm * BM + wr * 64 + fr, col0 = u.pn * BM + wc * 32 + 4 * fq; float* base = P + (size_t)u.ks * part_stride;
#pragma unroll
        for (int ai = 0; ai < 2; ++ai)
#pragma unroll
            for (int m = 0; m < 4; ++m) { const size_t off = (size_t)(row0 + ai * HALF + m * 16) * ldc + col0;
#pragma unroll
                for (int bj = 0; bj < 2; ++bj)
#pragma unroll
                    for (int n = 0; n < 2; ++n) *(f32x4*)(base + off + bj * HALF + n * 16) = acc[ai][bj][m][n]; }
    }
};
struct EpiResF32N {
    static constexpr bool PERM = true, AFTER_DRAIN = false;
    const float* base; float* out; int ldc; bf16_t* xb; float* ssq;
    __device__ __forceinline__ void operator()(const f32x4 (&acc)[2][2][4][2], const Unit& u, int wr, int wc, int fr, int fq) const {
        const int row0 = u.pm * BM + wr * 64 + fr, col0 = u.pn * BM + wc * 32 + 8 * fq;
#pragma unroll
        for (int ai = 0; ai < 2; ++ai)
#pragma unroll
            for (int m = 0; m < 4; ++m) { const int row = row0 + ai * HALF + m * 16; const size_t off = (size_t)row * ldc + col0; float sq = 0.f;
#pragma unroll
                for (int bj = 0; bj < 2; ++bj) {
                    const f32x4 v0 = *(const f32x4*)(base + off + bj * HALF) + acc[ai][bj][m][0], v1 = *(const f32x4*)(base + off + bj * HALF + 4) + acc[ai][bj][m][1];
                    *(f32x4*)(out + off + bj * HALF) = v0; *(f32x4*)(out + off + bj * HALF + 4) = v1;
                    sq += ((v0[0] * v0[0] + v0[1] * v0[1]) + (v0[2] * v0[2] + v0[3] * v0[3])) + ((v1[0] * v1[0] + v1[1] * v1[1]) + (v1[2] * v1[2] + v1[3] * v1[3]));
                    u32x4 w; w.x = cvt_pk_bf16(v0[0], v0[1]); w.y = cvt_pk_bf16(v0[2], v0[3]); w.z = cvt_pk_bf16(v1[0], v1[1]); w.w = cvt_pk_bf16(v1[2], v1[3]); *(u32x4*)(xb + off + bj * HALF) = w; }
                sq += __shfl_xor(sq, 16); sq += __shfl_xor(sq, 32);
                if (fq == 0) atomicAdd(ssq + row, sq);
                asm volatile("" ::: "memory"); }
    }
};
template <class TB> struct EpiResBf16N {
    static constexpr bool PERM = true, AFTER_DRAIN = false;
    const TB* base; int ldc; bf16_t* xb; float* ssq;
    __device__ __forceinline__ void operator()(const f32x4 (&acc)[2][2][4][2], const Unit& u, int wr, int wc, int fr, int fq) const {
        const int row0 = u.pm * BM + wr * 64 + fr, col0 = u.pn * BM + wc * 32 + 8 * fq;
#pragma unroll
        for (int ai = 0; ai < 2; ++ai)
#pragma unroll
            for (int m = 0; m < 4; ++m) { const int row = row0 + ai * HALF + m * 16; const size_t off = (size_t)row * ldc + col0; float sq = 0.f;
#pragma unroll
                for (int bj = 0; bj < 2; ++bj) { f32x4 v0, v1;
                    if constexpr (sizeof(TB) == 4) { v0 = *(const f32x4*)((const float*)base + off + bj * HALF); v1 = *(const f32x4*)((const float*)base + off + bj * HALF + 4); }
                    else { const u32x4 b = *(const u32x4*)((const bf16_t*)base + off + bj * HALF);
                        v0 = (f32x4){__builtin_bit_cast(float, b.x << 16), __builtin_bit_cast(float, b.x & 0xffff0000u), __builtin_bit_cast(float, b.y << 16), __builtin_bit_cast(float, b.y & 0xffff0000u)};
                        v1 = (f32x4){__builtin_bit_cast(float, b.z << 16), __builtin_bit_cast(float, b.z & 0xffff0000u), __builtin_bit_cast(float, b.w << 16), __builtin_bit_cast(float, b.w & 0xffff0000u)}; }
                    v0 += acc[ai][bj][m][0]; v1 += acc[ai][bj][m][1];
                    u32x4 w; w.x = cvt_pk_bf16(v0[0], v0[1]); w.y = cvt_pk_bf16(v0[2], v0[3]); w.z = cvt_pk_bf16(v1[0], v1[1]); w.w = cvt_pk_bf16(v1[2], v1[3]); *(u32x4*)(xb + off + bj * HALF) = w;
                    const float r0 = __builtin_bit_cast(float, w.x << 16), r1 = __builtin_bit_cast(float, w.x & 0xffff0000u), r2 = __builtin_bit_cast(float, w.y << 16), r3 = __builtin_bit_cast(float, w.y & 0xffff0000u);
                    const float r4 = __builtin_bit_cast(float, w.z << 16), r5 = __builtin_bit_cast(float, w.z & 0xffff0000u), r6 = __builtin_bit_cast(float, w.w << 16), r7 = __builtin_bit_cast(float, w.w & 0xffff0000u);
                    sq += ((r0 * r0 + r1 * r1) + (r2 * r2 + r3 * r3)) + ((r4 * r4 + r5 * r5) + (r6 * r6 + r7 * r7)); }
                sq += __shfl_xor(sq, 16); sq += __shfl_xor(sq, 32);
                if (fq == 0) atomicAdd(ssq + row, sq);
                asm volatile("" ::: "memory"); }
    }
};
struct EpiOutBf16Res {
    static constexpr bool PERM = true, AFTER_DRAIN = false;
    const bf16_t* base; float* out; int ldc;
    __device__ __forceinline__ void operator()(const f32x4 (&acc)[2][2][4][2], const Unit& u, int wr, int wc, int fr, int fq) const {
        const int row0 = u.pm * BM + wr * 64 + fr, col0 = u.pn * BM + wc * 32 + 8 * fq;
#pragma unroll
        for (int ai = 0; ai < 2; ++ai)
#pragma unroll
            for (int m = 0; m < 4; ++m) { const size_t off = (size_t)(row0 + ai * HALF + m * 16) * ldc + col0;
#pragma unroll
                for (int bj = 0; bj < 2; ++bj) { const u32x4 b = *(const u32x4*)(base + off + bj * HALF);
                    const f32x4 v0 = (f32x4){__builtin_bit_cast(float, b.x << 16), __builtin_bit_cast(float, b.x & 0xffff0000u), __builtin_bit_cast(float, b.y << 16), __builtin_bit_cast(float, b.y & 0xffff0000u)};
                    const f32x4 v1 = (f32x4){__builtin_bit_cast(float, b.z << 16), __builtin_bit_cast(float, b.z & 0xffff0000u), __builtin_bit_cast(float, b.w << 16), __builtin_bit_cast(float, b.w & 0xffff0000u)};
                    *(f32x4*)(out + off + bj * HALF) = v0 + acc[ai][bj][m][0]; *(f32x4*)(out + off + bj * HALF + 4) = v1 + acc[ai][bj][m][1]; }
                asm volatile("" ::: "memory"); }
    }
};
struct HeadSpec { int lo[5], hi[5]; const float* g[5]; };
struct EpiYHeads {
    static constexpr bool PERM = true, AFTER_DRAIN = false;
    bf16_t* O; int ldc; const float* ssq; HeadSpec hs; const float* ct; const float* st; PG8_LAS float* tab;
    __device__ __forceinline__ void operator()(const f32x4 (&acc)[2][2][4][2], const Unit& u, int wr, int wc, int fr, int fq) const {
        const float* gain = nullptr;
#pragma unroll
        for (int k = 0; k < 5; ++k) if (u.pn >= hs.lo[k] && u.pn < hs.hi[k]) gain = hs.g[k];
        const int row0 = u.pm * BM + wr * 64 + fr;
        if (gain == nullptr) {
            const int col0 = u.pn * BM + wc * 32 + 8 * fq;
#pragma unroll
            for (int ai = 0; ai < 2; ++ai)
#pragma unroll
                for (int m = 0; m < 4; ++m) { bf16_t* rowp = O + (size_t)(row0 + ai * HALF + m * 16) * ldc + col0; const float rs = row_rstd(ssq, row0 + ai * HALF + m * 16);
#pragma unroll
                    for (int bj = 0; bj < 2; ++bj) { const f32x4 v0 = acc[ai][bj][m][0] * rs, v1 = acc[ai][bj][m][1] * rs;
                        u32x4 w; w.x = cvt_pk_bf16(v0[0], v0[1]); w.y = cvt_pk_bf16(v0[2], v0[3]); w.z = cvt_pk_bf16(v1[0], v1[1]); w.w = cvt_pk_bf16(v1[2], v1[3]);
                        *(u32x4*)(rowp + bj * HALF) = w; } }
            return;
        }
        const int lr0 = wr * 64 + fr;
#pragma unroll
        for (int ai = 0; ai < 2; ++ai)
#pragma unroll
            for (int m = 0; m < 4; ++m) { const float rs = row_rstd(ssq, row0 + ai * HALF + m * 16); float sq = 0.f;
#pragma unroll
                for (int bj = 0; bj < 2; ++bj)
#pragma unroll
                    for (int n = 0; n < 2; ++n) { const f32x4 v = acc[ai][bj][m][n] * rs; sq += (v[0] * v[0] + v[1] * v[1]) + (v[2] * v[2] + v[3] * v[3]); }
                sq += __shfl_xor(sq, 16); sq += __shfl_xor(sq, 32);
                if (fq == 0) tab[(ai * HALF + lr0 + m * 16) * 4 + wc] = sq; }
        asm volatile("s_waitcnt lgkmcnt(0)" ::: "memory"); __builtin_amdgcn_s_barrier(); asm volatile("" ::: "memory");
        const int dlo = 32 * (wc & 1) + 8 * fq, head = wc >> 1;
        const f32x4 ga0 = *(const f32x4*)(gain + dlo), ga1 = *(const f32x4*)(gain + dlo + 4), gb0 = *(const f32x4*)(gain + 64 + dlo), gb1 = *(const f32x4*)(gain + 64 + dlo + 4);
#pragma unroll
        for (int ai = 0; ai < 2; ++ai)
#pragma unroll
            for (int m = 0; m < 4; ++m) { const int row = row0 + ai * HALF + m * 16;
                const float own = tab[(ai * HALF + lr0 + m * 16) * 4 + wc], other = tab[(ai * HALF + lr0 + m * 16) * 4 + (wc ^ 1)];
                const float sc = row_rstd(ssq, row) / sqrtf(((wc & 1) ? other + own : own + other) * (1.0f / 128.0f) + 1e-6f);
                const f32x4 c0 = *(const f32x4*)(ct + (size_t)row * 64 + dlo), c1 = *(const f32x4*)(ct + (size_t)row * 64 + dlo + 4), s0 = *(const f32x4*)(st + (size_t)row * 64 + dlo), s1 = *(const f32x4*)(st + (size_t)row * 64 + dlo + 4);
                const f32x4 a0 = acc[ai][0][m][0] * sc * ga0, a1 = acc[ai][0][m][1] * sc * ga1, b0 = acc[ai][1][m][0] * sc * gb0, b1 = acc[ai][1][m][1] * sc * gb1;
                const f32x4 y10 = a0 * c0 - b0 * s0, y11 = a1 * c1 - b1 * s1, y20 = a0 * s0 + b0 * c0, y21 = a1 * s1 + b1 * c1;
                bf16_t* rowp = O + (size_t)row * ldc + u.pn * BM + head * 128 + dlo;
                u32x4 w; w.x = cvt_pk_bf16(y10[0], y10[1]); w.y = cvt_pk_bf16(y10[2], y10[3]); w.z = cvt_pk_bf16(y11[0], y11[1]); w.w = cvt_pk_bf16(y11[2], y11[3]); *(u32x4*)rowp = w;
                u32x4 w2; w2.x = cvt_pk_bf16(y20[0], y20[1]); w2.y = cvt_pk_bf16(y20[2], y20[3]); w2.z = cvt_pk_bf16(y21[0], y21[1]); w2.w = cvt_pk_bf16(y21[2], y21[3]); *(u32x4*)(rowp + 64) = w2;
                asm volatile("" ::: "memory"); }
    }
};
template <class Epi, class Sched, bool ALIGN_EPI = false, bool SP2 = false>
__device__ __forceinline__ void gemm_phase(PG8_LAS unsigned char* lds, const Gemm g, const Sched& S, const Epi& E) {
    const int tid = threadIdx.x, wid = __builtin_amdgcn_readfirstlane(tid >> 6), lane = tid & 63, wr = wid >> 2, wc = wid & 3, fr = lane & 15, fq = lane >> 4;
    const int K = g.K, nt = g.KL / BK;
    unsigned voffA[2], voffB[2];
#pragma unroll
    for (int i = 0; i < 2; ++i) { int R, C; stage_rc(tid * 16 + i * 8192, R, C); const int Rb = Epi::PERM ? ((R & ~31) + perm32(R & 31)) : R;
        voffA[i] = (unsigned)(R * K + C) * 2u; voffB[i] = (unsigned)(Rb * K + C) * 2u; }
    const size_t kstep = (size_t)(BK * 2);
    const size_t hstep = (size_t)HALF * K * 2;
    const size_t tstep = 2 * hstep;
    const unsigned ldsw = (unsigned)wid * 1024u;
    const int aoff = lds_byte(wr * 64 + fr, fq * 8), boff = lds_byte(wc * 32 + fr, fq * 8);
#define PG8_SA(b, h) (((b) * 2 + (h)) * HTB)
#define PG8_SB(b, h) ((4 + (b) * 2 + (h)) * HTB)
#define PG8_STAGE(bufoff, gbase, voff) do { _Pragma("unroll") for (int _i = 0; _i < 2; ++_i) \
        __builtin_amdgcn_global_load_lds((const unsigned*)((const char*)(gbase) + (voff)[_i]), (PG8_LAS unsigned*)(lds + (bufoff) + ldsw + _i * 8192), 16, 0, 0); } while (0)
#define PG8_LDA(dst, b, h) do { _Pragma("unroll") for (int m = 0; m < 4; ++m) _Pragma("unroll") for (int k = 0; k < 2; ++k) dst[m][k] = *(const PG8_LAS bf16x8*)(lds + PG8_SA(b, h) + aoff + m * 2048 + k * 1024); } while (0)
#define PG8_LDB(dst, b, h) do { _Pragma("unroll") for (int n = 0; n < 2; ++n) _Pragma("unroll") for (int k = 0; k < 2; ++k) dst[n][k] = *(const PG8_LAS bf16x8*)(lds + PG8_SB(b, h) + boff + n * 2048 + k * 1024); } while (0)
#define PG8_MMA(ai, bj, At, Bt) do { __builtin_amdgcn_s_setprio(1); _Pragma("unroll") for (int m = 0; m < 4; ++m) _Pragma("unroll") for (int n = 0; n < 2; ++n) _Pragma("unroll") for (int k = 0; k < 2; ++k) \
        acc[ai][bj][m][n] = __builtin_amdgcn_mfma_f32_16x16x32_bf16(Bt[n][k], At[m][k], acc[ai][bj][m][n], 0, 0, 0); __builtin_amdgcn_s_setprio(0); } while (0)
#define PG8_WAIT_V(n) asm volatile("s_waitcnt vmcnt(" #n ")" ::: "memory")
#define PG8_WAIT_L(n) asm volatile("s_waitcnt lgkmcnt(" #n ")" ::: "memory")
#define PG8_BAR __builtin_amdgcn_s_barrier()
#define PG8_SCHED __builtin_amdgcn_sched_barrier(0)
    Unit cur, nxt; int ui = 0;
    if (!S.next(0, cur)) return;
    f32x4 acc[2][2][4][2];
#pragma unroll
    for (int a = 0; a < 2; ++a)
#pragma unroll
        for (int b = 0; b < 2; ++b)
#pragma unroll
            for (int m = 0; m < 4; ++m)
#pragma unroll
                for (int n = 0; n < 2; ++n) acc[a][b][m][n] = (f32x4){0.f, 0.f, 0.f, 0.f};
    bf16x8 At[4][2], B0[2][2], B1[2][2];
    const size_t ksb = (size_t)g.KL * 2;
    const char* cA = (const char*)g.A + (size_t)cur.pm * tstep + (size_t)cur.ks * ksb; const char* cB = (const char*)g.Bt + (size_t)cur.pn * tstep + (size_t)cur.ks * ksb;
    S.a_ready(cur);
    if constexpr (SP2) {
        PG8_STAGE(PG8_SB(0, 0), cB, voffB); PG8_STAGE(PG8_SB(0, 1), cB + hstep, voffB); PG8_STAGE(PG8_SA(0, 0), cA, voffA); PG8_STAGE(PG8_SA(0, 1), cA + hstep, voffA);
        if (wr == 1) PG8_BAR;
        PG8_WAIT_V(2); PG8_BAR;
        PG8_STAGE(PG8_SB(1, 0), cB + kstep, voffB); PG8_STAGE(PG8_SA(1, 0), cA + kstep, voffA); PG8_STAGE(PG8_SB(1, 1), cB + hstep + kstep, voffB);
        PG8_WAIT_V(6); PG8_BAR;
    } else {
        PG8_STAGE(PG8_SB(0, 0), cB, voffB); PG8_STAGE(PG8_SA(0, 0), cA, voffA); PG8_STAGE(PG8_SB(0, 1), cB + hstep, voffB); PG8_STAGE(PG8_SA(0, 1), cA + hstep, voffA);
        if (wr == 1) PG8_BAR;
        PG8_WAIT_V(4); PG8_BAR;
        PG8_STAGE(PG8_SB(1, 0), cB + kstep, voffB); PG8_STAGE(PG8_SA(1, 0), cA + kstep, voffA); PG8_STAGE(PG8_SB(1, 1), cB + hstep + kstep, voffB);
        PG8_WAIT_V(6); PG8_BAR;
    }
    for (;;) {
        const bool has_next = S.next(ui + 1, nxt);
        const char* nA = has_next ? (const char*)g.A + (size_t)nxt.pm * tstep + (size_t)nxt.ks * ksb : cA; const char* nB = has_next ? (const char*)g.Bt + (size_t)nxt.pn * tstep + (size_t)nxt.ks * ksb : cB;
        for (int t = 0; t < nt; t += 2) {
            const bool last = (t == nt - 2);
            const char* a1 = cA + (size_t)(t + 1) * kstep;
            const char* a2 = last ? nA : cA + (size_t)(t + 2) * kstep; const char* b2 = last ? nB : cB + (size_t)(t + 2) * kstep;
            const char* a3 = a2 + kstep; const char* b3 = b2 + kstep;
            if (last && has_next) S.a_ready(nxt);
            if constexpr (SP2) {
            PG8_LDB(B0, 0, 0); PG8_LDB(B1, 0, 1); PG8_SCHED; PG8_LDA(At, 0, 0); PG8_STAGE(PG8_SA(1, 1), a1 + hstep, voffA);
            PG8_WAIT_V(8); PG8_WAIT_L(0); PG8_BAR; PG8_MMA(0, 0, At, B0); PG8_MMA(0, 1, At, B1); PG8_BAR; PG8_SCHED;
            PG8_LDA(At, 0, 1); PG8_STAGE(PG8_SB(0, 0), b2, voffB); PG8_STAGE(PG8_SB(0, 1), b2 + hstep, voffB); PG8_STAGE(PG8_SA(0, 0), a2, voffA);
            PG8_WAIT_V(8); PG8_WAIT_L(0); PG8_BAR; PG8_MMA(1, 0, At, B0); PG8_MMA(1, 1, At, B1); PG8_BAR; PG8_SCHED;
            PG8_LDB(B0, 1, 0); PG8_LDB(B1, 1, 1); PG8_SCHED; PG8_LDA(At, 1, 0); PG8_STAGE(PG8_SA(0, 1), a2 + hstep, voffA);
            PG8_WAIT_V(8); PG8_WAIT_L(0); PG8_BAR; PG8_MMA(0, 0, At, B0); PG8_MMA(0, 1, At, B1); PG8_BAR; PG8_SCHED;
            PG8_LDA(At, 1, 1); PG8_STAGE(PG8_SB(1, 0), b3, voffB); PG8_STAGE(PG8_SB(1, 1), b3 + hstep, voffB); PG8_STAGE(PG8_SA(1, 0), a3, voffA);
            PG8_WAIT_V(8); PG8_WAIT_L(0); PG8_BAR; PG8_MMA(1, 0, At, B0); PG8_MMA(1, 1, At, B1); PG8_BAR; PG8_SCHED;
            } else {
            PG8_LDB(B0, 0, 0); PG8_SCHED; PG8_LDA(At, 0, 0); PG8_STAGE(PG8_SA(1, 1), a1 + hstep, voffA);
            PG8_WAIT_L(8); PG8_BAR; PG8_WAIT_L(0); PG8_MMA(0, 0, At, B0); PG8_BAR; PG8_SCHED;
            PG8_LDB(B1, 0, 1); PG8_STAGE(PG8_SB(0, 0), b2, voffB);
            PG8_BAR; PG8_WAIT_L(0); PG8_MMA(0, 1, At, B1); PG8_BAR;
            PG8_LDA(At, 0, 1); PG8_STAGE(PG8_SA(0, 0), a2, voffA);
            PG8_BAR; PG8_WAIT_L(0); PG8_MMA(1, 0, At, B0); PG8_BAR; PG8_SCHED;
            PG8_STAGE(PG8_SB(0, 1), b2 + hstep, voffB);
            PG8_WAIT_V(6); PG8_BAR; PG8_MMA(1, 1, At, B1); PG8_BAR;
            PG8_LDB(B0, 1, 0); PG8_SCHED; PG8_LDA(At, 1, 0); PG8_STAGE(PG8_SA(0, 1), a2 + hstep, voffA);
            PG8_WAIT_L(8); PG8_BAR; PG8_WAIT_L(0); PG8_MMA(0, 0, At, B0); PG8_BAR; PG8_SCHED;
            PG8_LDB(B1, 1, 1); PG8_STAGE(PG8_SB(1, 0), b3, voffB);
            PG8_BAR; PG8_WAIT_L(0); PG8_MMA(0, 1, At, B1); PG8_BAR;
            PG8_LDA(At, 1, 1); PG8_STAGE(PG8_SA(1, 0), a3, voffA);
            PG8_BAR; PG8_WAIT_L(0); PG8_MMA(1, 0, At, B0); PG8_BAR; PG8_SCHED;
            PG8_STAGE(PG8_SB(1, 1), b3 + hstep, voffB);
            PG8_WAIT_V(6); PG8_BAR; PG8_MMA(1, 1, At, B1); PG8_BAR;
            }
        }
        if constexpr (ALIGN_EPI) { if (wr == 0) PG8_BAR; }
        if constexpr (!Epi::AFTER_DRAIN) { E(acc, cur, wr, wc, fr, fq); S.done(cur); }
        if (!has_next) break;
#pragma unroll
        for (int a = 0; a < 2; ++a)
#pragma unroll
            for (int b = 0; b < 2; ++b)
#pragma unroll
                for (int m = 0; m < 4; ++m)
#pragma unroll
                    for (int n = 0; n < 2; ++n) acc[a][b][m][n] = (f32x4){0.f, 0.f, 0.f, 0.f};
        cur = nxt; cA = nA; cB = nB; ++ui;
        if constexpr (ALIGN_EPI) { if (wr == 1) PG8_BAR; }
    }
    PG8_WAIT_V(0);
    if constexpr (!ALIGN_EPI) { if (wr == 0) PG8_BAR; }
    PG8_BAR;
    if constexpr (Epi::AFTER_DRAIN) { E.fused(acc, cur, wr, wc, fr, fq, lds, wid, lane); S.done(cur); }
#undef PG8_SA
#undef PG8_SB
#undef PG8_STAGE
#undef PG8_LDA
#undef PG8_LDB
#undef PG8_MMA
#undef PG8_WAIT_V
#undef PG8_WAIT_L
#undef PG8_BAR
#undef PG8_SCHED
}
}
#define GAS __attribute__((address_space(1)))
#define LAS __attribute__((address_space(3)))
typedef unsigned short bf16;
typedef unsigned v4u __attribute__((ext_vector_type(4)));
typedef float f32x4 __attribute__((ext_vector_type(4)));
constexpr int NB = 4, T = 2048, DM = 4096, MTOK = NB * T, HD = 128;
constexpr int EVEN_N = 11312, EVEN_LD = 11520, ODD_LD = 18432, FFN = 11008, GU_ROWS = 2 * FFN;
constexpr int MEM_LEN = 256, MEM_ROWS = NB * MEM_LEN, XW = 512;
constexpr float NORM_EPS = 1e-6f;
constexpr float ATT_SCALE = 0.08838834764831845f;
#define NEG_INF (-__builtin_inff())
constexpr int C_MQ = 0, C_MK = 2048, C_MV = 4096, C_NQ = 6144, C_KC = 8192, C_VC = 8704, C_KS = 9216, C_VS = 9728, C_KW = 10240, C_VW = 10752, C_GL = 11264;
constexpr int C_SQ = 0, C_SK = 3072, C_SV = 6144, C_DQ = 9216, C_DK = 12288, C_DV = 15360;
constexpr size_t MiB = 1u << 20;
constexpr size_t WS_CTL = 0, CTL_ZERO_BYTES = 256 * 1024;
constexpr size_t WS_ROPE = 1 * MiB;
constexpr size_t WS_KMEAN = 5 * MiB;
constexpr size_t WS_KCR = 6 * MiB, WS_VCR = 7 * MiB;
constexpr size_t WS_KCN = 8 * MiB, WS_VCN = 9 * MiB;
constexpr size_t WS_MEMN = 10 * MiB;
constexpr size_t WS_QX = 18 * MiB;
constexpr size_t WS_KVX = 26 * MiB;
constexpr size_t WS_OX = 28 * MiB;
constexpr size_t WS_WQ = 36 * MiB, WS_WKV = 40 * MiB, WS_WO = 48 * MiB, WS_WOUT = 52 * MiB, WS_WIN = 84 * MiB, WS_WGU = 228 * MiB, WS_WD = 400 * MiB;
constexpr size_t WS_X = 486 * MiB;
constexpr size_t WS_H = 614 * MiB;
constexpr size_t WS_O = 678 * MiB;
constexpr size_t WS_Y = 742 * MiB;
constexpr size_t WS_VT = 1030 * MiB;
constexpr size_t WS_PART = 1126 * MiB;
constexpr size_t WS_LSE = 1222 * MiB;
constexpr size_t WS_VTX = 1223 * MiB;
constexpr size_t WS_SELM = 5 * MiB + 256 * 1024, WS_SELN = 5 * MiB + 768 * 1024;
constexpr size_t WS_PHIK = 1224 * MiB, WS_PHIV = 1225 * MiB;
constexpr size_t WS_CBIAS = 5 * MiB + 896 * 1024;
constexpr size_t WS_QP = 1226 * MiB;
constexpr size_t WS_MEMN2 = 1290 * MiB;
constexpr size_t WS_KVX2 = 1306 * MiB;
constexpr size_t WS_WKV2 = 1314 * MiB;
constexpr size_t WS_WD1 = 1330 * MiB;
constexpr size_t WS_WIN1 = 1416 * MiB;
constexpr size_t WS_END = 1560 * MiB;
#ifndef EARLY_N1
#define EARLY_N1 20
#endif
#ifndef EARLY_N2
#define EARLY_N2 20
#endif
#ifndef EARLY_NT
#define EARLY_NT 1
#endif
#ifndef EARLY_N4
#define EARLY_N4 4
#endif
constexpr int CW_BAR = 4096;
constexpr int CW_SSQ = 16384;
constexpr int RING_BYTES = 131072, LDSCTL_OFF = RING_BYTES, MISC_OFF = LDSCTL_OFF + 320, LDS_BYTES = 147456;
constexpr int NWAVES = 8;
#ifndef MK_ONE_LAUNCH
#define MK_ONE_LAUNCH 0
#endif
constexpr int NPL = 16, NPH = 2 * NPL;
#ifndef DUP_PHASE
#define DUP_PHASE (-1)
#endif
#ifndef DUP_N
#define DUP_N 2
#endif
#define REPS(k) for (int rep_ = 0; rep_ < ((DUP_PHASE == (k)) ? DUP_N : 1); ++rep_)
#ifndef PROBE_MASK
#define PROBE_MASK 0ull
#endif
#ifndef PROBE_SCALE
#define PROBE_SCALE 1e-3f
#endif
#ifndef PROBE_OFF
#define PROBE_OFF 0.f
#endif
#ifndef FUSE_HEADNORM
#define FUSE_HEADNORM 0
#endif
#ifndef RES_BF16
#define RES_BF16 0
#endif
#ifndef FA_EVEN
#define FA_EVEN 1
#endif
#ifndef FA_ODD
#define FA_ODD 1
#endif
#ifndef FA_SB
#define FA_SB 1
#endif
#ifndef FA_DIL
#define FA_DIL 1
#endif
#ifndef FA_XATTN
#define FA_XATTN 1
#endif

__device__ __forceinline__ unsigned f2bf(float f) { unsigned u = __builtin_bit_cast(unsigned, f); return (u + 0x7fffu + ((u >> 16) & 1u)) >> 16; }
__device__ __forceinline__ unsigned pk2(float lo, float hi) { return f2bf(lo) | (f2bf(hi) << 16); }
__device__ __forceinline__ float bflo(unsigned w) { return __builtin_bit_cast(float, w << 16); }
__device__ __forceinline__ float bfhi(unsigned w) { return __builtin_bit_cast(float, w & 0xffff0000u); }
__device__ __forceinline__ float bf2f(bf16 b) { return __builtin_bit_cast(float, ((unsigned)b) << 16); }
__device__ __forceinline__ float wsum(float v) {
#pragma unroll
    for (int o = 1; o < 64; o <<= 1) v += __shfl_xor(v, o);
    return v; }
__device__ __forceinline__ float wmax(float v) {
#pragma unroll
    for (int o = 1; o < 64; o <<= 1) v = fmaxf(v, __shfl_xor(v, o));
    return v; }
__device__ __forceinline__ float rdlane(float v, int j) { return __builtin_bit_cast(float, __builtin_amdgcn_readlane(__builtin_bit_cast(int, v), j)); }
#define LDS_FENCE() do { asm volatile("s_waitcnt lgkmcnt(0)" ::: "memory"); __builtin_amdgcn_wave_barrier(); } while (0)

#define XB_TMO      128
#define XB_XCNT(j)  (256  + 64 * (j))
#define XB_XSUB(j)  (1280 + 64 * (j))
#define XB_XGEN(j)  (2304 + 64 * (j))
#define XB_TOP      3328
#define XB_TOPGEN   3392
#define XCD_BAR_WORDS 3456
#define XB_SPIN_CAP (1u << 18)

__device__ __forceinline__ unsigned xb_ld(unsigned* p)              { return __hip_atomic_load(p, __ATOMIC_RELAXED, __HIP_MEMORY_SCOPE_AGENT); }
__device__ __forceinline__ unsigned xb_add(unsigned* p, unsigned v) { return __hip_atomic_fetch_add(p, v, __ATOMIC_RELAXED, __HIP_MEMORY_SCOPE_AGENT); }
__device__ __forceinline__ unsigned xb_xcc_id() { return (unsigned)__builtin_amdgcn_s_getreg((3 << 11) | 20) & 0xFu; }
#define XB_SPIN(cond, bar) do { unsigned _sp = 0; while (cond) { __builtin_amdgcn_s_sleep(1); \
    if ((++_sp & 255u) == 0u) { if (xb_ld(&(bar)[XB_TMO])) break; if (_sp > XB_SPIN_CAP) { atomicAdd(&(bar)[XB_TMO], 1u); break; } } } } while (0)

struct XcdBarrier {
    unsigned* bar; unsigned x;
    volatile LAS unsigned* st;
};

__device__ __forceinline__ XcdBarrier xcd_barrier_post(unsigned* bar, volatile LAS unsigned* st) {
    XcdBarrier b; b.bar = bar; b.x = xb_xcc_id(); b.st = st;
    if (threadIdx.x == 0) (void)xb_add(&bar[XB_XCNT(b.x)], 1u);
    return b;
}
__device__ __forceinline__ void xcd_barrier_complete(unsigned* bar, unsigned x, unsigned& nloc, unsigned& nx) {
    const unsigned G = gridDim.x * gridDim.y * gridDim.z;
    unsigned sum, cnt, mine, sp = 0u;
    for (;;) {
        sum = 0u; cnt = 0u; mine = 0u;
#pragma unroll
        for (unsigned j = 0; j < 16; ++j) { const unsigned c = xb_ld(&bar[XB_XCNT(j)]); sum += c; cnt += (c > 0u) ? 1u : 0u; mine = (j == x) ? c : mine; }
        if (sum == G) break;
        __builtin_amdgcn_s_sleep(1);
        if ((++sp & 255u) == 0u) { if (xb_ld(&bar[XB_TMO])) break; if (sp > XB_SPIN_CAP) { atomicAdd(&bar[XB_TMO], 1u); break; } }
    }
    nloc = mine > 0u ? mine : 1u; nx = cnt > 0u ? cnt : 1u;
}

__device__ __forceinline__ void xcd_barrier(const XcdBarrier& b) {
    asm volatile("s_waitcnt vmcnt(0)" ::: "memory");
    __syncthreads();
    if (threadIdx.x == 0) {
        unsigned* bar = b.bar;
        __builtin_amdgcn_s_waitcnt(0);
        unsigned nloc = b.st[0], nx = b.st[1];
        if (nloc == 0u) { xcd_barrier_complete(bar, b.x, nloc, nx); b.st[0] = nloc; b.st[1] = nx; }
        const unsigned old = xb_add(&bar[XB_XSUB(b.x)], 1u);
        const unsigned gen = old / nloc;
        if (old + 1u == (gen + 1u) * nloc) {
            __builtin_amdgcn_fence(__ATOMIC_RELEASE, "agent");
            asm volatile("s_waitcnt vmcnt(0)" ::: "memory");
            const unsigned og = xb_add(&bar[XB_TOP], 1u);
            const unsigned tg = og / nx;
            if (og + 1u == (tg + 1u) * nx) xb_add(&bar[XB_TOPGEN], 1u);
            else XB_SPIN(xb_ld(&bar[XB_TOPGEN]) == tg, bar);
            __builtin_amdgcn_fence(__ATOMIC_ACQUIRE, "agent");
            xb_add(&bar[XB_XGEN(b.x)], 1u);
            asm volatile("s_waitcnt vmcnt(0)" ::: "memory");
        } else {
            XB_SPIN(xb_ld(&bar[XB_XGEN(b.x)]) == gen, bar);
            __builtin_amdgcn_fence(__ATOMIC_ACQUIRE, "agent");
            asm volatile("s_waitcnt vmcnt(0)" ::: "memory");
        }
    }
    __syncthreads();
}


struct Ctx { LAS unsigned char* lds; int tid, lane, wave, gw, ngw, G; };

struct RmId { int off; __device__ __forceinline__ int operator()(int n) const { return off + n; } };
struct RmHeads { unsigned long long m0, m1;
    __device__ __forceinline__ int operator()(int n) const { const int t = n >> 8; const bool hd = t < 64 ? ((m0 >> t) & 1ull) : ((m1 >> (t - 64)) & 1ull); if (!hd) return n;
        const int r = n & 255, hb = r >> 7, d = r & 127; return (n & ~255) + ((d >> 6) << 7) + hb * 64 + (d & 63); } };
struct RmGU { int up; __device__ __forceinline__ int operator()(int n) const { return (n >> 7) * 256 + up * 128 + (n & 127); } };
template <class RM, bool NT = false>
__device__ __forceinline__ void conv_weight(const Ctx& c, const float* W, int K, int N, int Npad, bf16* WT, RM rm, const float* kgain = nullptr, int it0 = 0, int it1 = -1, int gw = -1, int ngw = -1) {
    LAS float* scr = (LAS float*)(c.lds + c.wave * 16384);
    const int nblk = Npad / 32, items = it1 < 0 ? (K / 64) * nblk : it1, lane = c.lane; if (gw < 0) { gw = c.gw; ngw = c.ngw; }
    for (int it = it0 + gw; it < items; it += ngw) {
        const int kb = it / nblk, nb = it - kb * nblk, k0 = 64 * kb, n0 = 32 * nb;
        const int c4 = lane & 7; const bool ok = n0 + 4 * c4 < N;
        f32x4 wv[8];
#pragma unroll
        for (int i = 0; i < 8; ++i) { const int kk = 8 * i + (lane >> 3); wv[i] = ok ? (NT ? __builtin_nontemporal_load((const f32x4*)(W + (size_t)(k0 + kk) * N + n0 + 4 * c4)) : *(const f32x4*)(W + (size_t)(k0 + kk) * N + n0 + 4 * c4)) : (f32x4){0.f, 0.f, 0.f, 0.f}; }
#pragma unroll
        for (int i = 0; i < 8; ++i) { const int kk = 8 * i + (lane >> 3); const float kg = kgain ? kgain[k0 + kk] : 1.0f; LAS float* d = scr + kk * 33 + 4 * c4; d[0] = wv[i].x * kg; d[1] = wv[i].y * kg; d[2] = wv[i].z * kg; d[3] = wv[i].w * kg; }
        LDS_FENCE();
        const int ch = lane & 7, r0 = rm(n0);
#pragma unroll
        for (int j = 0; j < 4; ++j) { const int nn = (lane >> 3) + 8 * j; const LAS float* s = scr + (8 * ch) * 33 + nn;
            v4u o; o.x = pk2(s[0 * 33], s[1 * 33]); o.y = pk2(s[2 * 33], s[3 * 33]); o.z = pk2(s[4 * 33], s[5 * 33]); o.w = pk2(s[6 * 33], s[7 * 33]);
            *(v4u*)(WT + (size_t)(r0 + nn) * K + k0 + 8 * ch) = o; }
        LDS_FENCE();
    }
}
__device__ __forceinline__ void rmsnorm_rows(const Ctx& c, const float* X, const float* g, bf16* Hout, int nrows) {
    const int lane = c.lane;
    for (int m = c.gw; m < nrows; m += c.ngw) {
        const f32x4* xr = (const f32x4*)(X + (size_t)m * DM) + lane; f32x4 v[16]; float ss = 0.f;
#pragma unroll
        for (int j = 0; j < 16; ++j) { v[j] = xr[64 * j]; ss += (v[j].x * v[j].x + v[j].y * v[j].y) + (v[j].z * v[j].z + v[j].w * v[j].w); }
        const float rstd = 1.0f / sqrtf(wsum(ss) * (1.0f / DM) + NORM_EPS);
        const f32x4* gr = (const f32x4*)g + lane; unsigned long long* o8 = (unsigned long long*)(Hout + (size_t)m * DM) + lane;
#pragma unroll
        for (int j = 0; j < 16; ++j) { const f32x4 gg = gr[64 * j]; o8[64 * j] = (unsigned long long)pk2(v[j].x * rstd * gg.x, v[j].y * rstd * gg.y) | ((unsigned long long)pk2(v[j].z * rstd * gg.z, v[j].w * rstd * gg.w) << 32); }
    }
}
__device__ __forceinline__ void rope_table(const Ctx& c, const int* pos, float* ct, float* st) {
    for (int idx = c.gw * 64 + c.lane; idx < MTOK * 64; idx += c.ngw * 64) {
        const int row = idx >> 6, i = idx & 63;
        const float invf = exp2f(-(float)i * 0.20762050593046f);
        const float ang = (float)pos[row] * invf;
        double rev = (double)ang * 0.15915494309189535; rev -= floor(rev);
        const float r = (float)rev;
        ct[idx] = __builtin_amdgcn_cosf(r); st[idx] = __builtin_amdgcn_sinf(r);
    }
}
__device__ __forceinline__ void headnorm_one(float (&x)[8], int j, int row, const f32x4 ga, const f32x4 gb, const float* ct, const float* st) {
    float ss = 0.f;
#pragma unroll
    for (int e = 0; e < 8; ++e) ss += x[e] * x[e];
    ss += __shfl_xor(ss, 1); ss += __shfl_xor(ss, 2); ss += __shfl_xor(ss, 4); ss += __shfl_xor(ss, 8);
    const float rstd = 1.0f / sqrtf(ss * (1.0f / 128.0f) + NORM_EPS);
    x[0] *= rstd * ga.x; x[1] *= rstd * ga.y; x[2] *= rstd * ga.z; x[3] *= rstd * ga.w; x[4] *= rstd * gb.x; x[5] *= rstd * gb.y; x[6] *= rstd * gb.z; x[7] *= rstd * gb.w;
    if (ct) {
        const f32x4 ca = *(const f32x4*)(ct + (size_t)row * 64 + 8 * (j & 7)), cb = *(const f32x4*)(ct + (size_t)row * 64 + 8 * (j & 7) + 4);
        const f32x4 sa = *(const f32x4*)(st + (size_t)row * 64 + 8 * (j & 7)), sb = *(const f32x4*)(st + (size_t)row * 64 + 8 * (j & 7) + 4);
        const float cs[8] = {ca.x, ca.y, ca.z, ca.w, cb.x, cb.y, cb.z, cb.w}, sn[8] = {sa.x, sa.y, sa.z, sa.w, sb.x, sb.y, sb.z, sb.w};
#pragma unroll
        for (int e = 0; e < 8; ++e) { const float pr = __shfl_xor(x[e], 8); x[e] = (j < 8) ? (x[e] * cs[e] - pr * sn[e]) : (pr * sn[e] + x[e] * cs[e]); }
    }
}
__device__ __forceinline__ void headnorm_bf16(const Ctx& c, bf16* Y, int ld, int col0, int nh, int nrows, const float* gain, const float* ct, const float* st) {
    const int lane = c.lane, sub = lane >> 4, j = lane & 15; const int items = nrows * nh, stride = 4 * c.ngw;
    const f32x4 ga = *(const f32x4*)(gain + 8 * j), gb = *(const f32x4*)(gain + 8 * j + 4);
    for (int it = 4 * c.gw + sub; it < items; it += 2 * stride) {
        const int it2 = it + stride; const bool two = it2 < items;
        const int row = it / nh, hh = it - row * nh, row2 = two ? it2 / nh : row, hh2 = two ? it2 - row2 * nh : hh;
        bf16* p = Y + (size_t)row * ld + col0 + hh * 128 + 8 * j; bf16* p2 = Y + (size_t)row2 * ld + col0 + hh2 * 128 + 8 * j;
        const v4u w = *(const v4u*)p; const v4u w2 = *(const v4u*)p2;
        float x[8] = {bflo(w.x), bfhi(w.x), bflo(w.y), bfhi(w.y), bflo(w.z), bfhi(w.z), bflo(w.w), bfhi(w.w)};
        float y[8] = {bflo(w2.x), bfhi(w2.x), bflo(w2.y), bfhi(w2.y), bflo(w2.z), bfhi(w2.z), bflo(w2.w), bfhi(w2.w)};
        headnorm_one(x, j, row, ga, gb, ct, st); headnorm_one(y, j, row2, ga, gb, ct, st);
        v4u o; o.x = pk2(x[0], x[1]); o.y = pk2(x[2], x[3]); o.z = pk2(x[4], x[5]); o.w = pk2(x[6], x[7]); *(v4u*)p = o;
        if (two) { v4u o2; o2.x = pk2(y[0], y[1]); o2.y = pk2(y[2], y[3]); o2.z = pk2(y[4], y[5]); o2.w = pk2(y[6], y[7]); *(v4u*)p2 = o2; }
    }
}
__device__ __forceinline__ void headnorm_q4(const Ctx& c, const float* QP, bf16* QX, const float* gain, const float* ssq) {
    const int lane = c.lane, sub = lane >> 4, j = lane & 15;
    const f32x4 ga = *(const f32x4*)(gain + 8 * j), gb = *(const f32x4*)(gain + 8 * j + 4);
    for (int it = 4 * c.gw + sub; it < MTOK * 4; it += 4 * c.ngw) {
        const size_t off = (size_t)(it >> 2) * XW + (it & 3) * 128 + 8 * j;
        f32x4 a = *(const f32x4*)(QP + off), b = *(const f32x4*)(QP + off + 4);
#pragma unroll
        for (int ks = 1; ks < 4; ++ks) { a += *(const f32x4*)(QP + (size_t)ks * MTOK * XW + off); b += *(const f32x4*)(QP + (size_t)ks * MTOK * XW + off + 4); }
        { const float rs = 1.0f / sqrtf(ssq[it >> 2] * (1.0f / DM) + NORM_EPS); a *= rs; b *= rs; }
        float ss = (a.x * a.x + a.y * a.y) + (a.z * a.z + a.w * a.w) + (b.x * b.x + b.y * b.y) + (b.z * b.z + b.w * b.w);
        ss += __shfl_xor(ss, 1); ss += __shfl_xor(ss, 2); ss += __shfl_xor(ss, 4); ss += __shfl_xor(ss, 8);
        const float rstd = 1.0f / sqrtf(ss * (1.0f / 128.0f) + NORM_EPS);
        v4u o; o.x = pk2(a.x * rstd * ga.x, a.y * rstd * ga.y); o.y = pk2(a.z * rstd * ga.z, a.w * rstd * ga.w); o.z = pk2(b.x * rstd * gb.x, b.y * rstd * gb.y); o.w = pk2(b.z * rstd * gb.z, b.w * rstd * gb.w);
        *(v4u*)(QX + off) = o;
    }
}
__device__ __forceinline__ void cmp_finish(const Ctx& c, const float* KCR, const float* VCR, const float* cbias, bf16* KCN, bf16* VCT, const float* gain, const float* ct, const float* st) {
    constexpr size_t PS = 16 * 128 * 128;
    const int lane = c.lane; const float g1 = gain[lane], g2 = gain[lane + 64];
    for (int it = c.gw; it < 2 * 16 * 128; it += c.ngw) {
        const int which = it >> 11, r = it & 2047, bg = r >> 7, n = r & 127, b = bg >> 2;
        const size_t o = ((size_t)bg * 128 + n) * 128;
        if (which == 0) {
            if (n == 127) { KCN[o + lane] = 0; KCN[o + lane + 64] = 0; continue; }
            float x1 = ((KCR[o + lane] + KCR[PS + o + lane]) + (KCR[2 * PS + o + lane] + KCR[3 * PS + o + lane])) + cbias[lane], x2 = ((KCR[o + lane + 64] + KCR[PS + o + lane + 64]) + (KCR[2 * PS + o + lane + 64] + KCR[3 * PS + o + lane + 64])) + cbias[lane + 64];
            const float rstd = 1.0f / sqrtf(wsum(x1 * x1 + x2 * x2) * (1.0f / 128.0f) + NORM_EPS);
            x1 = x1 * rstd * g1; x2 = x2 * rstd * g2;
            const int row = b * T + 16 * n + 31; const float cs = ct[row * 64 + lane], sn = st[row * 64 + lane];
            KCN[o + lane] = (bf16)f2bf(x1 * cs - x2 * sn); KCN[o + lane + 64] = (bf16)f2bf(x1 * sn + x2 * cs);
        } else {
            const float v1 = n == 127 ? 0.f : ((VCR[o + lane] + VCR[PS + o + lane]) + (VCR[2 * PS + o + lane] + VCR[3 * PS + o + lane])) + cbias[128 + lane], v2 = n == 127 ? 0.f : ((VCR[o + lane + 64] + VCR[PS + o + lane + 64]) + (VCR[2 * PS + o + lane + 64] + VCR[3 * PS + o + lane + 64])) + cbias[128 + lane + 64];
            VCT[o + lane] = (bf16)f2bf(v1); VCT[o + lane + 64] = (bf16)f2bf(v2);
        }
    }
}
__device__ __forceinline__ void moba_kmean(const Ctx& c, const bf16* Y, float* kmean) {
    const int lane = c.lane;
    for (int it = c.gw; it < NB * 16 * 8; it += c.ngw) {
        const int b = it >> 7, h = (it >> 3) & 15, n = it & 7;
        const bf16* src = Y + ((size_t)b * T + 256 * n) * EVEN_LD + C_MK + h * 128 + 2 * lane;
        float a0 = 0.f, a1 = 0.f;
        for (int k = 0; k < 256; ++k) { const unsigned w = *(const unsigned*)(src + (size_t)k * EVEN_LD); a0 += bflo(w); a1 += bfhi(w); }
        float* dst = kmean + (size_t)it * 128 + 2 * lane; dst[0] = a0 * (1.0f / 256.0f); dst[1] = a1 * (1.0f / 256.0f);
    }
}

__device__ __forceinline__ float dot128(const LAS float* qs, const bf16* krow) {
    const v4u* kp = (const v4u*)krow; float s = 0.f;
#pragma unroll 4
    for (int cch = 0; cch < 16; ++cch) { const v4u w = kp[cch]; const LAS f32x4* q4 = (const LAS f32x4*)(qs + 8 * cch); const f32x4 qa = q4[0], qb = q4[1];
        s += qa.x * bflo(w.x) + qa.y * bfhi(w.x) + qa.z * bflo(w.y) + qa.w * bfhi(w.y) + qb.x * bflo(w.z) + qb.y * bfhi(w.z) + qb.z * bflo(w.w) + qb.w * bfhi(w.w); }
    return s;
}
__device__ __forceinline__ void load_q(LAS float* qs, const bf16* qrow, int lane) {
    LDS_FENCE();
    const unsigned w = *(const unsigned*)(qrow + 2 * lane); qs[2 * lane] = bflo(w); qs[2 * lane + 1] = bfhi(w);
    LDS_FENCE();
}
__device__ __forceinline__ void pv_accum(float& a0, float& a1, float p, int voff, const bf16* Vb, int lane) {
    for (int j = 0; j < 64; ++j) {
        const float pj = rdlane(p, j);
        if (pj != 0.f) { const int off = __builtin_amdgcn_readlane(voff, j); const unsigned w = *(const unsigned*)(Vb + (size_t)off + 2 * lane); a0 += pj * bflo(w); a1 += pj * bfhi(w); }
    }
}
struct SoftAcc { float m, l, a0, a1; };
__device__ __forceinline__ void sa_init(SoftAcc& S) { S.m = NEG_INF; S.l = 0.f; S.a0 = 0.f; S.a1 = 0.f; }
__device__ __forceinline__ void sa_chunk(SoftAcc& S, float s  , int voff, const bf16* Vb, int lane) {
    const float cm = wmax(s);
    if (cm == NEG_INF) return;
    const float mn = fmaxf(S.m, cm);
    const float p = __expf(s - mn), alpha = __expf(S.m - mn);
    S.l = S.l * alpha + wsum(p); S.a0 *= alpha; S.a1 *= alpha; S.m = mn;
    pv_accum(S.a0, S.a1, p, voff, Vb, lane);
}
__device__ __forceinline__ void moba_row(const Ctx& c, LAS float* qs, const bf16* Y, const float* kmean, bf16* O, int b, int h, int t) {
    const int lane = c.lane; const size_t row = (size_t)b * T + t; const bf16* Yb = Y + (size_t)b * T * EVEN_LD;
    load_q(qs, Y + row * EVEN_LD + C_MQ + h * 128, lane);
    const int cur = t >> 8;
    float gate = NEG_INF;
    if (lane < cur) { const float* km = kmean + ((size_t)(b * 16 + h) * 8 + lane) * 128; float s = 0.f; for (int d = 0; d < 128; ++d) s += qs[d] * km[d]; gate = s; }
    int rank = 0;
    for (int m2 = 0; m2 < 8; ++m2) { const float gm = rdlane(gate, m2); rank += (gm > gate || (gm == gate && m2 < lane)) ? 1 : 0; }
    const unsigned selmask = (unsigned)__ballot((lane < cur) && (rank < 3));
    SoftAcc S; sa_init(S);
    const bf16* Kb = Yb + C_MK + h * 128; const bf16* Vb = Yb + C_MV + h * 128;
    const int nch = (t >> 6) + 1;
    for (int kc = 0; kc < nch; ++kc) {
        const int n = kc >> 2;
        if (n < cur && !((selmask >> n) & 1u)) continue;
        const int key = kc * 64 + lane; const bool valid = key <= t; const int koff = (valid ? key : t) * EVEN_LD;
        float s = dot128(qs, Kb + koff) * ATT_SCALE; if (!valid) s = NEG_INF;
        sa_chunk(S, s, koff, Vb, lane);
    }
    const float inv = 1.0f / fmaxf(S.l, 1e-30f);
    *(unsigned*)(O + row * DM + h * 128 + 2 * lane) = pk2(S.a0 * inv, S.a1 * inv);
}
__device__ __forceinline__ void nsa_item(const Ctx& c, LAS float* qs, LAS float* ps, const bf16* Y, const bf16* KCN, const bf16* VCN, bf16* O, int b, int g, int t) {
    const int lane = c.lane; const size_t row = (size_t)b * T + t; const bf16* Yb = Y + (size_t)b * T * EVEN_LD;
    const bf16* Kc = KCN + (size_t)(b * 4 + g) * 128 * 128; const bf16* Vc = VCN + (size_t)(b * 4 + g) * 128 * 128;
    float oc0[4], oc1[4]; float P0 = 0.f, P1 = 0.f;
    const int n0 = lane, n1 = 64 + lane; const bool v0 = 16 * n0 + 31 <= t, v1 = (n1 < 127) && (16 * n1 + 31 <= t);
#pragma unroll
    for (int hh = 0; hh < 4; ++hh) {
        load_q(qs, Y + row * EVEN_LD + C_NQ + (g * 4 + hh) * 128, lane);
        float s0 = dot128(qs, Kc + (v0 ? n0 : 0) * 128) * ATT_SCALE, s1 = dot128(qs, Kc + (v1 ? n1 : 0) * 128) * ATT_SCALE;
        if (!v0) s0 = NEG_INF; if (!v1) s1 = NEG_INF;
        const float m = wmax(fmaxf(s0, s1)); float a0 = 0.f, a1 = 0.f;
        if (m != NEG_INF) {
            float p0 = __expf(s0 - m), p1 = __expf(s1 - m);
            const float inv = 1.0f / fmaxf(wsum(p0 + p1), 1e-30f);
            p0 *= inv; p1 *= inv; P0 += p0; P1 += p1;
            pv_accum(a0, a1, p0, n0 * 128, Vc, lane); pv_accum(a0, a1, p1, (v1 ? n1 : 0) * 128, Vc, lane);
        }
        oc0[hh] = a0; oc1[hh] = a1;
    }
    LDS_FENCE(); ps[lane] = P0; ps[64 + lane] = P1; LDS_FENCE();
    float imp = 0.f;
    if (lane < 32) { for (int n = 4 * lane - 1; n <= 4 * lane + 3; ++n) if (n >= 0 && n < 127) imp += ps[n]; }
    const int cur = t >> 6;
    const float v = (lane >= 32) ? NEG_INF : ((lane == cur || lane == 0) ? __builtin_inff() : (lane <= cur ? imp : NEG_INF));
    int rank = 0;
    for (int m2 = 0; m2 < 32; ++m2) { const float vm = rdlane(v, m2); rank += (vm > v || (vm == v && m2 < lane)) ? 1 : 0; }
    const unsigned selmask = (unsigned)__ballot(lane < 32 && lane <= cur && rank < 16);
    const bf16* Ks = Yb + C_KS + g * 128; const bf16* Vs = Yb + C_VS + g * 128; const bf16* Kw = Yb + C_KW + g * 128; const bf16* Vw = Yb + C_VW + g * 128;
#pragma unroll
    for (int hh = 0; hh < 4; ++hh) {
        const int h = g * 4 + hh;
        load_q(qs, Y + row * EVEN_LD + C_NQ + h * 128, lane);
        SoftAcc S; sa_init(S);
        for (int j = 0; j <= cur; ++j) {
            if (!((selmask >> j) & 1u)) continue;
            const int key = 64 * j + lane; const bool valid = key <= t; const int koff = (valid ? key : t) * EVEN_LD;
            float s = dot128(qs, Ks + koff) * ATT_SCALE; if (!valid) s = NEG_INF;
            sa_chunk(S, s, koff, Vs, lane);
        }
        SoftAcc W; sa_init(W);
        for (int c0 = 0; c0 < 512 && c0 <= t; c0 += 64) {
            const int key = t - c0 - lane; const bool valid = key >= 0; const int koff = (valid ? key : 0) * EVEN_LD;
            float s = dot128(qs, Kw + koff) * ATT_SCALE; if (!valid) s = NEG_INF;
            sa_chunk(W, s, koff, Vw, lane);
        }
        const bf16* gl = Y + row * EVEN_LD + C_GL + h * 3;
        const float g0 = 1.0f / (1.0f + __expf(-bf2f(gl[0]))), g1 = 1.0f / (1.0f + __expf(-bf2f(gl[1]))), g2 = 1.0f / (1.0f + __expf(-bf2f(gl[2])));
        const float is = 1.0f / fmaxf(S.l, 1e-30f), iw = 1.0f / fmaxf(W.l, 1e-30f);
        const float o0 = g0 * oc0[hh] + g1 * (S.a0 * is) + g2 * (W.a0 * iw), o1 = g0 * oc1[hh] + g1 * (S.a1 * is) + g2 * (W.a1 * iw);
        *(unsigned*)(O + row * DM + 2048 + h * 128 + 2 * lane) = pk2(o0, o1);
    }
}
__device__ __forceinline__ void sb_row(const Ctx& c, LAS float* qs, const bf16* Y, bf16* O, int b, int h, int t) {
    const int lane = c.lane; const size_t row = (size_t)b * T + t; const bf16* Yb = Y + (size_t)b * T * ODD_LD;
    load_q(qs, Y + row * ODD_LD + C_SQ + h * 128, lane);
    const bf16* Kb = Yb + C_SK + h * 128; const bf16* Vb = Yb + C_SV + h * 128;
    float carry = 0.f, a0 = 0.f, a1 = 0.f;
    for (int c0 = 0; c0 < t; c0 += 64) {
        const int key = t - 1 - c0 - lane; const bool valid = key >= 0; const int koff = (valid ? key : 0) * ODD_LD;
        const float z = dot128(qs, Kb + koff) * ATT_SCALE;
        const float L = __logf(1.0f + __expf(-fabsf(z)));
        const float lsp = fminf(z, 0.f) - L;
        const float lr = valid ? (lsp - z) : 0.f;
        float incl = lr;
#pragma unroll
        for (int o = 1; o < 64; o <<= 1) { const float u = __shfl_up(incl, o); if (lane >= o) incl += u; }
        const float a = valid ? __expf(lsp + carry + (incl - lr)) : 0.f;
        carry += rdlane(incl, 63);
        pv_accum(a0, a1, a, koff, Vb, lane);
    }
    *(unsigned*)(O + row * DM + h * 128 + 2 * lane) = pk2(a0, a1);
}
__device__ __forceinline__ void dil_row(const Ctx& c, LAS float* qs, const bf16* Y, bf16* O, int b, int hd, int t) {
    const int lane = c.lane; const size_t row = (size_t)b * T + t; const bf16* Yb = Y + (size_t)b * T * ODD_LD;
    float og0[3], og1[3], lse[3];
#pragma unroll
    for (int gi = 0; gi < 3; ++gi) {
        const int r = gi == 0 ? 1 : (gi == 1 ? 4 : 16), nd = gi * 8 + hd;
        load_q(qs, Y + row * ODD_LD + C_DQ + nd * 128, lane);
        const bf16* Kb = Yb + C_DK + nd * 128; const bf16* Vb = Yb + C_DV + nd * 128;
        SoftAcc S; sa_init(S);
        for (int c0 = 0; c0 < 129; c0 += 64) {
            const int ci = c0 + lane, key = t - r * ci; const bool valid = (ci <= 128) && key >= 0; const int koff = (valid ? key : 0) * ODD_LD;
            float s = dot128(qs, Kb + koff) * ATT_SCALE; if (!valid) s = NEG_INF;
            sa_chunk(S, s, koff, Vb, lane);
        }
        const float inv = 1.0f / fmaxf(S.l, 1e-30f);
        og0[gi] = S.a0 * inv; og1[gi] = S.a1 * inv; lse[gi] = S.m + __logf(fmaxf(S.l, 1e-30f));
    }
    const float mx = fmaxf(lse[0], fmaxf(lse[1], lse[2]));
    const float w0 = __expf(lse[0] - mx), w1 = __expf(lse[1] - mx), w2 = __expf(lse[2] - mx), iw = 1.0f / (w0 + w1 + w2);
    *(unsigned*)(O + row * DM + 3072 + hd * 128 + 2 * lane) = pk2((w0 * og0[0] + w1 * og0[1] + w2 * og0[2]) * iw, (w0 * og1[0] + w1 * og1[1] + w2 * og1[2]) * iw);
}
__device__ __forceinline__ void xattn_row(const Ctx& c, LAS float* qs, const bf16* QX, const bf16* KVX, bf16* OX, int b, int h, int t) {
    const int lane = c.lane; const size_t row = (size_t)b * T + t;
    load_q(qs, QX + row * XW + h * 128, lane);
    const bf16* Kb = KVX + (size_t)b * MEM_LEN * 1024 + h * 128; const bf16* Vb = Kb + 512;
    SoftAcc S; sa_init(S);
    for (int c0 = 0; c0 < MEM_LEN; c0 += 64) { const int koff = (c0 + lane) * 1024; const float s = dot128(qs, Kb + koff) * ATT_SCALE; sa_chunk(S, s, koff, Vb, lane); }
    const float inv = 1.0f / fmaxf(S.l, 1e-30f);
    *(unsigned*)(OX + row * XW + h * 128 + 2 * lane) = pk2(S.a0 * inv, S.a1 * inv);
}
__device__ __forceinline__ int spread_t(int i) { return ((i & (T - 1)) + (i >> 11) * 997) & (T - 1); }


namespace fa {
typedef short bf16x8 __attribute__((ext_vector_type(8)));
typedef short s16x4 __attribute__((ext_vector_type(4)));
typedef float f32x16 __attribute__((ext_vector_type(16)));
typedef unsigned u32x2 __attribute__((ext_vector_type(2)));
constexpr int KT_BYTES = 64 * 256, VT_BYTES = 64 * 256, STAGE = KT_BYTES + VT_BYTES;
constexpr float C2 = 0.08838834764831845f * 1.4426950408889634f;
struct Unit {
    const bf16* q; int qstride;
    const bf16* k; int kstride;
    const bf16* v; int vstride;
    bf16* o; int ostride;
    float* lse; int lse_stride;
    const unsigned* sel; int sel_stride;
    int pos0, t_lo, t_hi;
    int window, causal;
    int sel_shift, own_blk, nrows;
    const bf16* comb_oc; const bf16* comb_os; const bf16* comb_gl; int comb_gls;
    const float* qp; const float* qgain; const float* qssq;
    size_t qps;
    const float* kmean;
};
__device__ __forceinline__ unsigned cvtpk(float lo, float hi) { return pg8::cvt_pk_bf16(lo, hi); }
__device__ __forceinline__ float xmax32(float v) { return fmaxf(v, __shfl_xor(v, 32)); }
__device__ __forceinline__ float xsum32(float v) { return v + __shfl_xor(v, 32); }
__device__ __forceinline__ float xother32(float v, int) { return __shfl_xor(v, 32); }
__device__ __forceinline__ bf16x8 pack8(const f32x16& p, const int b) { v4u w = {cvtpk(p[b + 0], p[b + 1]), cvtpk(p[b + 2], p[b + 3]), cvtpk(p[b + 4], p[b + 5]), cvtpk(p[b + 6], p[b + 7])}; return __builtin_bit_cast(bf16x8, w); }

#define FA_LOAD(tile) do { const int kb_ = (tile) * 64; const bf16* kp_ = u.k + (size_t)(kb_ + sr) * u.kstride + sc * 8; kq0 = *(const v4u*)kp_; kq1 = *(const v4u*)(kp_ + (size_t)32 * u.kstride); \
        const bf16* vp_ = u.v + (size_t)(kb_ + sr) * u.vstride + sc * 8; vq0 = *(const v4u*)vp_; vq1 = *(const v4u*)(vp_ + (size_t)32 * u.vstride); } while (0)
#define FA_WRITE(st) do { LAS unsigned char* b_ = L + (st) * STAGE; *(LAS v4u*)(b_ + kw0) = kq0; *(LAS v4u*)(b_ + kw0 + 32 * 256) = kq1; \
        *(LAS v4u*)(b_ + vw0) = vq0; *(LAS v4u*)(b_ + vw0 + 32 * 256) = vq1; } while (0)
#define FA_SB0() __builtin_amdgcn_sched_barrier(0)
#define FA_QK(st) do { const LAS unsigned char* kl_ = L + (st) * STAGE; p0 = f32x16{}; p1 = f32x16{}; \
        _Pragma("unroll") for (int h_ = 0; h_ < 2; ++h_) { bf16x8 ka_[4], kb_[4]; \
            _Pragma("unroll") for (int d1 = 0; d1 < 4; ++d1) { const int cb_ = ((4 * h_ + d1) * 32 + hi * 16) ^ ((r32 & 15) << 4); ka_[d1] = *(const LAS bf16x8*)(kl_ + r32 * 256 + cb_); kb_[d1] = *(const LAS bf16x8*)(kl_ + (32 + r32) * 256 + cb_); } \
            FA_SB0(); \
            _Pragma("unroll") for (int d1 = 0; d1 < 4; ++d1) { p0 = __builtin_amdgcn_mfma_f32_32x32x16_bf16(ka_[d1], q[4 * h_ + d1], p0, 0, 0, 0); p1 = __builtin_amdgcn_mfma_f32_32x32x16_bf16(kb_[d1], q[4 * h_ + d1], p1, 0, 0, 0); } \
            FA_SB0(); } } while (0)
#define FA_TRRD(dst, addr, off) asm volatile("ds_read_b64_tr_b16 %0, %1 offset:%2" : "=&v"(dst) : "v"(addr), "i"(off) : "memory")
#define FA_PV(st) do { const int so_ = (st) * STAGE; \
        _Pragma("unroll") for (int db = 0; db < 4; ++db) { const int a0_ = vtr[2 * db] + so_, a1_ = vtr[2 * db + 1] + so_; s16x4 l0_, h0_, l1_, h1_, l2_, h2_, l3_, h3_; \
            FA_TRRD(l0_, a0_, 0); FA_TRRD(h0_, a1_, 0); FA_TRRD(l1_, a0_, 4096); FA_TRRD(h1_, a1_, 4096); FA_TRRD(l2_, a0_, 8192); FA_TRRD(h2_, a1_, 8192); FA_TRRD(l3_, a0_, 12288); FA_TRRD(h3_, a1_, 12288); \
            asm volatile("s_waitcnt lgkmcnt(0)" ::: "memory"); FA_SB0(); \
            o[db] = __builtin_amdgcn_mfma_f32_32x32x16_bf16((bf16x8){l0_[0], l0_[1], l0_[2], l0_[3], h0_[0], h0_[1], h0_[2], h0_[3]}, P[0], o[db], 0, 0, 0); \
            o[db] = __builtin_amdgcn_mfma_f32_32x32x16_bf16((bf16x8){l1_[0], l1_[1], l1_[2], l1_[3], h1_[0], h1_[1], h1_[2], h1_[3]}, P[1], o[db], 0, 0, 0); \
            o[db] = __builtin_amdgcn_mfma_f32_32x32x16_bf16((bf16x8){l2_[0], l2_[1], l2_[2], l2_[3], h2_[0], h2_[1], h2_[2], h2_[3]}, P[2], o[db], 0, 0, 0); \
            o[db] = __builtin_amdgcn_mfma_f32_32x32x16_bf16((bf16x8){l3_[0], l3_[1], l3_[2], l3_[3], h3_[0], h3_[1], h3_[2], h3_[3]}, P[3], o[db], 0, 0, 0); \
            FA_SB0(); } } while (0)
#define FA_VTR_SETUP() int vtr[8]; { const int q_ = (lane & 15) >> 2, p_ = lane & 3, ch_ = (lane >> 4) & 1; const int lb_ = (int)(unsigned)(size_t)L; \
        _Pragma("unroll") for (int db = 0; db < 4; ++db) { _Pragma("unroll") for (int s_ = 0; s_ < 2; ++s_) { const int row_ = 8 * s_ + 4 * hi + q_, chunk_ = 4 * db + 2 * ch_ + (p_ >> 1); \
            vtr[2 * db + s_] = lb_ + KT_BYTES + 256 * row_ + 16 * (chunk_ ^ (((row_ & 3) << 2) | ((row_ >> 2) & 3))) + 8 * (p_ & 1); } } }

template <int MODE>
__device__ __forceinline__ void run_unit(const Ctx& c, const Unit& u) {
    const int tid = c.tid, lane = c.lane, w = c.wave, r32 = lane & 31, hi = lane >> 5;
    LAS unsigned char* L = c.lds;
    const int row = 32 * w + r32; const bool wact = 32 * w < u.nrows;
    bf16x8 q[8];
    if (MODE == 0 && u.qp) {
        const float* bp = u.qp + (size_t)row * 512 + hi * 8; f32x4 va[8], vb[8]; float ss = 0.f;
        const float rsx = 1.0f / sqrtf(u.qssq[row] * (1.0f / 4096.0f) + 1e-6f);
#pragma unroll
        for (int d0 = 0; d0 < 8; ++d0) { f32x4 a = *(const f32x4*)(bp + 16 * d0), b = *(const f32x4*)(bp + 16 * d0 + 4);
#pragma unroll
            for (int ks = 1; ks < 4; ++ks) { a += *(const f32x4*)(bp + ks * u.qps + 16 * d0); b += *(const f32x4*)(bp + ks * u.qps + 16 * d0 + 4); }
            a *= rsx; b *= rsx; va[d0] = a; vb[d0] = b; ss += ((a.x * a.x + a.y * a.y) + (a.z * a.z + a.w * a.w)) + ((b.x * b.x + b.y * b.y) + (b.z * b.z + b.w * b.w)); }
        ss = xsum32(ss);
        const float rstd = 1.0f / sqrtf(ss * (1.0f / 128.0f) + 1e-6f);
#pragma unroll
        for (int d0 = 0; d0 < 8; ++d0) { const f32x4 ga = *(const f32x4*)(u.qgain + 16 * d0 + hi * 8), gb = *(const f32x4*)(u.qgain + 16 * d0 + hi * 8 + 4); const f32x4 a = va[d0] * rstd * ga, b = vb[d0] * rstd * gb;
            v4u wq; wq.x = cvtpk(a.x, a.y); wq.y = cvtpk(a.z, a.w); wq.z = cvtpk(b.x, b.y); wq.w = cvtpk(b.z, b.w); q[d0] = __builtin_bit_cast(bf16x8, wq); }
    } else { const bf16* qp = u.q + (size_t)(wact ? row : 0) * u.qstride + hi * 8;
#pragma unroll
      for (int d0 = 0; d0 < 8; ++d0) q[d0] = *(const bf16x8*)(qp + 16 * d0); }
    const int pq = u.pos0 + row, wlo = u.pos0 + 32 * w, whi = wlo + 31;
    unsigned selm = 0xffffffffu; if (u.sel && wact) selm = u.sel[(size_t)row * u.sel_stride];
    const int sr = tid >> 4, sc = tid & 15, vr = tid >> 3, vc = tid & 7;
    const int kw0 = sr * 256 + ((sc * 16) ^ ((sr & 15) << 4)), vw0 = KT_BYTES + 256 * sr + 16 * (sc ^ (((sr & 3) << 2) | ((sr >> 2) & 3)));
    FA_VTR_SETUP();
    v4u kq0, kq1, vq0, vq1;
    f32x16 o[4] = {f32x16{}, f32x16{}, f32x16{}, f32x16{}}; f32x16 p0, p1; bf16x8 P[4];
    float m_run = -1e30f, l_run = 0.f, carry = 0.f;
    const int nt = u.t_hi - u.t_lo;
    __syncthreads();
    if (nt > 0) { FA_LOAD(MODE == 0 ? u.t_lo : u.t_hi - 1); FA_WRITE(0); }
    if (MODE == 0 && u.kmean) {
        const int grow = tid >> 5, gd4 = (tid & 31) * 4, gn = grow & 7; const f32x4 km = *(const f32x4*)(u.kmean + gn * 128 + gd4);
        unsigned h0 = f2bf(km.x), h1 = f2bf(km.y), h2 = f2bf(km.z), h3 = f2bf(km.w);
        if (grow >> 3) { h0 = f2bf(km.x - bflo(h0)); h1 = f2bf(km.y - bflo(h1)); h2 = f2bf(km.z - bflo(h2)); h3 = f2bf(km.w - bflo(h3)); }
        *(LAS u32x2*)(L + STAGE + grow * 256 + ((gd4 * 2) ^ ((grow & 15) << 4))) = (u32x2){h0 | (h1 << 16), h2 | (h3 << 16)};
    }
    __syncthreads();
    if (MODE == 0 && u.kmean) {
        FA_QK(1);
        float gown[4], g8[8];
#pragma unroll
        for (int e = 0; e < 4; ++e) gown[e] = p0[e] + p0[4 + e];
#pragma unroll
        for (int e = 0; e < 4; ++e) { const float go = xother32(gown[e], hi); g8[e] = hi ? go : gown[e]; g8[4 + e] = hi ? gown[e] : go; }
#pragma unroll
        for (int n = 0; n < 8; ++n) if (n >= u.own_blk) g8[n] = NEG_INF;
        selm = 0u;
#pragma unroll
        for (int n = 0; n < 8; ++n) { int rank = 0;
#pragma unroll
            for (int m2 = 0; m2 < 8; ++m2) rank += (g8[m2] > g8[n] || (g8[m2] == g8[n] && m2 < n)) ? 1 : 0;
            if (rank < 3 && n < u.own_blk) selm |= 1u << n; }
        __syncthreads();
    }
    for (int i = 0; i < nt; ++i) {
        const int tile = MODE == 0 ? u.t_lo + i : u.t_hi - 1 - i, st = i & 1, kb = tile * 64;
        if (i + 1 < nt) FA_LOAD(MODE == 0 ? tile + 1 : tile - 1);
        if (MODE == 0) {
            bool act = wact;
            if (u.causal && (kb > whi || kb + 63 <= wlo - u.window)) act = false;
            bool allowed = true;
            if (u.sel || u.kmean) { const int blk = tile >> u.sel_shift; allowed = (blk == u.own_blk) || ((selm >> blk) & 1u); if (!__any(allowed)) act = false; }
            if (act) {
                FA_QK(st);
                if (u.causal && (kb + 63 > wlo || kb <= whi - u.window)) {
                    const int dq = pq - kb - 4 * hi;
#pragma unroll
                    for (int r = 0; r < 16; ++r) { const int cc = (r & 3) + 8 * (r >> 2);
                        if ((unsigned)(dq - cc) >= (unsigned)u.window) p0[r] = NEG_INF;
                        if ((unsigned)(dq - cc - 32) >= (unsigned)u.window) p1[r] = NEG_INF; }
                }
                if (!allowed) {
#pragma unroll
                    for (int r = 0; r < 16; ++r) { p0[r] = NEG_INF; p1[r] = NEG_INF; } }
                float pm = fmaxf(p0[0], p1[0]);
#pragma unroll
                for (int r = 1; r < 16; ++r) pm = fmaxf(pm, fmaxf(p0[r], p1[r]));
                pm = xmax32(pm);
                if (__any((pm - m_run) * C2 > 11.5f)) {
                    const float mn = fmaxf(m_run, pm), alpha = __builtin_amdgcn_exp2f((m_run - mn) * C2); m_run = mn; l_run *= alpha;
#pragma unroll
                    for (int db = 0; db < 4; ++db)
#pragma unroll
                        for (int r = 0; r < 16; ++r) o[db][r] *= alpha; }
                const float mb = m_run * C2;
                float ps = 0.f;
#pragma unroll
                for (int r = 0; r < 16; ++r) { p0[r] = __builtin_amdgcn_exp2f(p0[r] * C2 - mb); p1[r] = __builtin_amdgcn_exp2f(p1[r] * C2 - mb); ps += p0[r] + p1[r]; }
                l_run += ps;
                P[0] = pack8(p0, 0); P[1] = pack8(p0, 8); P[2] = pack8(p1, 0); P[3] = pack8(p1, 8);
                FA_PV(st);
            }
        } else {
            if (wact && kb < whi && __any(carry > -110.0f)) {
                FA_QK(st);
                const int dq = pq - kb - 4 * hi;
                float own[8];
#define FA_SBG(PP, g, koff) do { float lr_[4], ls_[4]; \
                    _Pragma("unroll") for (int e = 0; e < 4; ++e) { const int cc = e + 8 * (g) + (koff); const float z = PP[4 * (g) + e] * ATT_SCALE; const float lg = __logf(1.0f + __expf(-fabsf(z))); \
                        const bool strict = dq - cc > 0; const float lr = fminf(z, 0.f) - lg - z; lr_[e] = strict ? lr : 0.f; ls_[e] = strict ? lr + z : NEG_INF; } \
                    PP[4 * (g) + 3] = ls_[3]; PP[4 * (g) + 2] = ls_[2] + lr_[3]; PP[4 * (g) + 1] = ls_[1] + (lr_[3] + lr_[2]); PP[4 * (g)] = ls_[0] + (lr_[3] + lr_[2] + lr_[1]); \
                    own[(g) + ((koff) ? 4 : 0)] = (lr_[3] + lr_[2]) + (lr_[1] + lr_[0]); } while (0)
                FA_SBG(p0, 0, 0); FA_SBG(p0, 1, 0); FA_SBG(p0, 2, 0); FA_SBG(p0, 3, 0); FA_SBG(p1, 0, 32); FA_SBG(p1, 1, 32); FA_SBG(p1, 2, 32); FA_SBG(p1, 3, 32);
#undef FA_SBG
                float oth[8];
#pragma unroll
                for (int g = 0; g < 8; ++g) oth[g] = xother32(own[g], hi);
                float suf = carry;
#pragma unroll
                for (int g = 7; g >= 0; --g) {
                    const float base = suf + (hi == 0 ? oth[g] : 0.f);
                    if (g >= 4) {
#pragma unroll
                        for (int e = 0; e < 4; ++e) p1[4 * (g - 4) + e] = __expf(p1[4 * (g - 4) + e] + base);
                    } else {
#pragma unroll
                        for (int e = 0; e < 4; ++e) p0[4 * g + e] = __expf(p0[4 * g + e] + base);
                    }
                    suf += own[g] + oth[g];
                }
                carry = suf;
                P[0] = pack8(p0, 0); P[1] = pack8(p0, 8); P[2] = pack8(p1, 0); P[3] = pack8(p1, 8);
                FA_PV(st);
            }
        }
        if (i + 1 < nt) FA_WRITE(st ^ 1);
        if (MODE == 1) {
            if (!__syncthreads_or((wact && carry > -110.0f) ? 1 : 0)) break;
        } else __syncthreads();
    }
    if (wact) {
        float inv = 1.0f;
        if (MODE == 0) { const float lt = xsum32(l_run); inv = lt > 0.f ? 1.0f / lt : 0.f;
            if (u.lse && hi == 0) u.lse[(size_t)row * u.lse_stride] = m_run * ATT_SCALE + __logf(fmaxf(lt, 1e-30f)); }
        bf16* op = u.o + (size_t)row * u.ostride + 4 * hi;
        if (MODE == 0 && u.comb_gl) {
            const bf16* gl = u.comb_gl + (size_t)row * u.comb_gls;
            const float g0 = 1.0f / (1.0f + __expf(-bf2f(gl[0]))), g1 = 1.0f / (1.0f + __expf(-bf2f(gl[1]))), g2 = inv / (1.0f + __expf(-bf2f(gl[2])));
            const bf16* pc = u.comb_oc + (size_t)row * 2048 + 4 * hi; const bf16* ps_ = u.comb_os + (size_t)row * 2048 + 4 * hi;
#pragma unroll
            for (int db = 0; db < 4; ++db)
#pragma unroll
                for (int g = 0; g < 4; ++g) { const u32x2 wc = *(const u32x2*)(pc + 32 * db + 8 * g), wsv = *(const u32x2*)(ps_ + 32 * db + 8 * g); u32x2 wv;
                    wv.x = cvtpk(g0 * bflo(wc.x) + g1 * bflo(wsv.x) + g2 * o[db][4 * g], g0 * bfhi(wc.x) + g1 * bfhi(wsv.x) + g2 * o[db][4 * g + 1]);
                    wv.y = cvtpk(g0 * bflo(wc.y) + g1 * bflo(wsv.y) + g2 * o[db][4 * g + 2], g0 * bfhi(wc.y) + g1 * bfhi(wsv.y) + g2 * o[db][4 * g + 3]);
                    *(u32x2*)(op + 32 * db + 8 * g) = wv; }
        } else {
#pragma unroll
        for (int db = 0; db < 4; ++db)
#pragma unroll
            for (int g = 0; g < 4; ++g) { u32x2 wv; wv.x = cvtpk(o[db][4 * g] * inv, o[db][4 * g + 1] * inv); wv.y = cvtpk(o[db][4 * g + 2] * inv, o[db][4 * g + 3] * inv);
                *(u32x2*)(op + 32 * db + 8 * g) = wv; }
        }
    }
}

__device__ __forceinline__ void cmp_unit(const Ctx& c, const bf16* Yq  , int ldy, const bf16* Kc, const bf16* Vct, bf16* OCrow  , unsigned* SELrow  , int tt) {
    const int tid = c.tid, lane = c.lane, w = c.wave, r32 = lane & 31, hi = lane >> 5;
    LAS unsigned char* L = c.lds;
    const int tok = 8 * w + (r32 >> 2), hh = r32 & 3, t = 64 * tt + tok;
    struct { const bf16* k; int kstride; const bf16* v; int vstride; } u; u.k = Kc; u.kstride = 128; u.v = Vct; u.vstride = 128;
    bf16x8 q[8];
    { const bf16* qp = Yq + (size_t)tok * ldy + hh * 128 + hi * 8;
#pragma unroll
      for (int d0 = 0; d0 < 8; ++d0) q[d0] = *(const bf16x8*)(qp + 16 * d0); }
    const int sr = tid >> 4, sc = tid & 15, vr = tid >> 3, vc = tid & 7;
    const int kw0 = sr * 256 + ((sc * 16) ^ ((sr & 15) << 4)), vw0 = KT_BYTES + 256 * sr + 16 * (sc ^ (((sr & 3) << 2) | ((sr >> 2) & 3)));
    FA_VTR_SETUP();
    v4u kq0, kq1, vq0, vq1;
    __syncthreads();
    FA_LOAD(0); FA_WRITE(0); FA_LOAD(1); FA_WRITE(1);
    __syncthreads();
    f32x16 p0, p1, s00, s01;
    FA_QK(0); s00 = p0; s01 = p1;
    FA_QK(1);
    const int nmax = (t - 31) >> 4;
    { const int nb = 4 * hi;
#pragma unroll
      for (int r = 0; r < 16; ++r) { const int cc = (r & 3) + 8 * (r >> 2) + nb;
          if (cc > nmax) s00[r] = NEG_INF; if (cc + 32 > nmax) s01[r] = NEG_INF; if (cc + 64 > nmax) p0[r] = NEG_INF; if (cc + 96 > nmax || cc + 96 > 126) p1[r] = NEG_INF; } }
    float pm = NEG_INF;
#pragma unroll
    for (int r = 0; r < 16; ++r) pm = fmaxf(pm, fmaxf(fmaxf(s00[r], s01[r]), fmaxf(p0[r], p1[r])));
    pm = xmax32(pm);
    const float mb = (pm == NEG_INF ? 0.f : pm) * C2;
    float ps = 0.f;
#pragma unroll
    for (int r = 0; r < 16; ++r) { s00[r] = __builtin_amdgcn_exp2f(s00[r] * C2 - mb); s01[r] = __builtin_amdgcn_exp2f(s01[r] * C2 - mb); p0[r] = __builtin_amdgcn_exp2f(p0[r] * C2 - mb); p1[r] = __builtin_amdgcn_exp2f(p1[r] * C2 - mb);
        ps += (s00[r] + s01[r]) + (p0[r] + p1[r]); }
    ps = xsum32(ps);
    const float inv = 1.0f / fmaxf(ps, 1e-30f);
#pragma unroll
    for (int r = 0; r < 16; ++r) { s00[r] *= inv; s01[r] *= inv; p0[r] *= inv; p1[r] *= inv; }
    f32x16 o[4] = {f32x16{}, f32x16{}, f32x16{}, f32x16{}}; bf16x8 P[4];
    P[0] = pack8(s00, 0); P[1] = pack8(s00, 8); P[2] = pack8(s01, 0); P[3] = pack8(s01, 8); FA_PV(0);
    P[0] = pack8(p0, 0); P[1] = pack8(p0, 8); P[2] = pack8(p1, 0); P[3] = pack8(p1, 8); FA_PV(1);
    { bf16* op = OCrow + (size_t)tok * 2048 + hh * 128 + 4 * hi;
#pragma unroll
      for (int db = 0; db < 4; ++db)
#pragma unroll
          for (int g = 0; g < 4; ++g) { u32x2 wv; wv.x = cvtpk(o[db][4 * g], o[db][4 * g + 1]); wv.y = cvtpk(o[db][4 * g + 2], o[db][4 * g + 3]); *(u32x2*)(op + 32 * db + 8 * g) = wv; } }
    float cs[16], cl[16];
#pragma unroll
    for (int rq = 0; rq < 4; ++rq) {
        cs[rq] = (s00[4 * rq] + s00[4 * rq + 1]) + (s00[4 * rq + 2] + s00[4 * rq + 3]); cl[rq] = s00[4 * rq + 3];
        cs[4 + rq] = (s01[4 * rq] + s01[4 * rq + 1]) + (s01[4 * rq + 2] + s01[4 * rq + 3]); cl[4 + rq] = s01[4 * rq + 3];
        cs[8 + rq] = (p0[4 * rq] + p0[4 * rq + 1]) + (p0[4 * rq + 2] + p0[4 * rq + 3]); cl[8 + rq] = p0[4 * rq + 3];
        cs[12 + rq] = (p1[4 * rq] + p1[4 * rq + 1]) + (p1[4 * rq + 2] + p1[4 * rq + 3]); cl[12 + rq] = p1[4 * rq + 3]; }
#pragma unroll
    for (int k = 0; k < 16; ++k) { cs[k] += __shfl_xor(cs[k], 1); cs[k] += __shfl_xor(cs[k], 2); cl[k] += __shfl_xor(cl[k], 1); cl[k] += __shfl_xor(cl[k], 2); }
    float impE[16], impO[16];
    { float ocs[16], ocl[16];
#pragma unroll
      for (int k = 0; k < 16; ++k) { ocs[k] = xother32(cs[k], hi); ocl[k] = xother32(cl[k], hi); }
#pragma unroll
      for (int k = 0; k < 16; ++k) { const float ecs = hi ? ocs[k] : cs[k], ocs_ = hi ? cs[k] : ocs[k], clO = hi ? ocl[k] : cl[k];
          float clE = 0.f; if (k > 0) clE = hi ? cl[k - 1] : ocl[k - 1];
          impE[k] = ecs + clE; impO[k] = ocs_ + clO; } }
    LAS float* tab = (LAS float*)(L + 2 * STAGE) + (8 * w + (r32 >> 2)) * 32;
    if (hh == 0 && hi == 0) {
#pragma unroll
        for (int k = 0; k < 16; ++k) { const int je = 2 * k, jo = 2 * k + 1;
            const float ve = (je == 0 || je == tt) ? __builtin_inff() : (je <= tt ? impE[k] : NEG_INF), vo = (jo == tt) ? __builtin_inff() : (jo <= tt ? impO[k] : NEG_INF);
            tab[je] = ve; tab[jo] = vo; } }
    LDS_FENCE();
    const int a4 = 4 * (hh + 4 * hi);
    const f32x4 vj = *(const LAS f32x4*)(tab + a4);
    int rk0 = 0, rk1 = 0, rk2 = 0, rk3 = 0;
#pragma unroll
    for (int i4 = 0; i4 < 8; ++i4) { const f32x4 vi = *(const LAS f32x4*)(tab + 4 * i4);
#pragma unroll
        for (int e = 0; e < 4; ++e) { const float x = vi[e]; const int i = 4 * i4 + e;
            rk0 += (x > vj.x || (x == vj.x && i < a4 + 0)) ? 1 : 0; rk1 += (x > vj.y || (x == vj.y && i < a4 + 1)) ? 1 : 0;
            rk2 += (x > vj.z || (x == vj.z && i < a4 + 2)) ? 1 : 0; rk3 += (x > vj.w || (x == vj.w && i < a4 + 3)) ? 1 : 0; } }
    unsigned m = 0u;
    if (rk0 < 16 && a4 + 0 <= tt) m |= 1u << (a4 + 0); if (rk1 < 16 && a4 + 1 <= tt) m |= 1u << (a4 + 1); if (rk2 < 16 && a4 + 2 <= tt) m |= 1u << (a4 + 2); if (rk3 < 16 && a4 + 3 <= tt) m |= 1u << (a4 + 3);
    m |= (unsigned)__shfl_xor((int)m, 1); m |= (unsigned)__shfl_xor((int)m, 2); m |= (unsigned)__shfl_xor((int)m, 32);
    if (hh == 0 && hi == 0) SELrow[tok] = m;
    LDS_FENCE();
}
#undef FA_LOAD
#undef FA_WRITE
#undef FA_QK
#undef FA_PV
#undef FA_TRRD
#undef FA_VTR_SETUP
#undef FA_SB0
}


__device__ __forceinline__ void cmp_bias(const Ctx& c, const float* pe_k, const float* pe_v, const float* phi_k, const float* phi_v, float* cbias) {
    for (int it = c.gw; it < 256; it += c.ngw) {
        const int which = it >> 7, e = it & 127; const float* pe = which ? pe_v : pe_k; const float* phi = which ? phi_v : phi_k; float s = 0.f;
        for (int k = c.lane; k < 4096; k += 64) s += pe[k] * phi[(size_t)k * 128 + e];
        s = wsum(s); if (c.lane == 0) cbias[it] = s;
    }
}
__device__ __forceinline__ void cmp_mfma(const Ctx& c, const bf16* Y, const bf16* PHIKT, const bf16* PHIVT, float* KCR4, float* VCR4) {
    const int lane = c.lane, r32 = lane & 31, hi = lane >> 5;
    for (int it = c.gw; it < 2048; it += c.ngw) {
        const int lq = it & 3, eb = (it >> 2) & 3, nt = (it >> 4) & 3, bg = (it >> 6) & 15, which = it >> 10, b = bg >> 2, g = bg & 3;
        const int n = (32 * nt + r32) < 126 ? (32 * nt + r32) : 126;
        const bf16* arow = Y + ((size_t)b * T + 16 * n + 8 * lq) * EVEN_LD + (which ? C_VC : C_KC) + g * 128 + hi * 8;
        const bf16* brow = (which ? PHIVT : PHIKT) + (size_t)(32 * eb + r32) * 4096 + (8 * lq) * 128 + hi * 8;
        fa::f32x16 acc = {};
        fa::bf16x8 a0[8], b0[8], a1[8], b1[8];
#define CM_LOAD(l, A_, B_) do { _Pragma("unroll") for (int s8 = 0; s8 < 8; ++s8) { A_[s8] = *(const fa::bf16x8*)(arow + (size_t)(l) * EVEN_LD + 16 * s8); B_[s8] = *(const fa::bf16x8*)(brow + (l) * 128 + 16 * s8); } __builtin_amdgcn_sched_barrier(0); } while (0)
#define CM_MMA(A_, B_) do { _Pragma("unroll") for (int s8 = 0; s8 < 8; ++s8) acc = __builtin_amdgcn_mfma_f32_32x32x16_bf16(A_[s8], B_[s8], acc, 0, 0, 0); __builtin_amdgcn_sched_barrier(0); } while (0)
        CM_LOAD(0, a0, b0);
#pragma unroll 1
        for (int l = 0; l < 8; l += 2) {
            CM_LOAD(l + 1, a1, b1); CM_MMA(a0, b0);
            if (l + 2 < 8) CM_LOAD(l + 2, a0, b0);
            CM_MMA(a1, b1);
        }
#undef CM_LOAD
#undef CM_MMA
        float* dst = (which ? VCR4 : KCR4) + (size_t)lq * (16 * 128 * 128) + ((size_t)bg * 128 + 32 * nt) * 128 + 32 * eb + r32;
#pragma unroll
        for (int r = 0; r < 16; ++r) { const int nn = (r & 3) + 8 * (r >> 2) + 4 * hi; if (32 * nt + nn < 127) dst[nn * 128] = acc[r]; }
    }
}
__device__ __forceinline__ void vt_pass(const Ctx& c, const bf16* Ysrc, int ld, int col0, int nheads, bf16* VT, int NH, int head0, int TL, int dil_mode) {
    LAS unsigned char* scr = c.lds + c.wave * 16384; const int lane = c.lane; const int npb = TL / 32, items = NB * nheads * npb;
    for (int it = c.gw; it < items; it += c.ngw) {
        const int pb = it % npb, bh = it / npb, hh = bh % nheads, b = bh / nheads;
        const int r = dil_mode ? (hh < 8 ? 1 : (hh < 16 ? 4 : 16)) : 1, CL = TL / r, pp0 = 32 * pb, cls = pp0 / CL, i0 = pp0 - cls * CL, tok0 = cls + r * i0;
        const bf16* src = Ysrc + ((size_t)b * TL + tok0) * ld + col0 + hh * 128;
#pragma unroll
        for (int k = 0; k < 8; ++k) { const int ci = lane + 64 * k, rr = ci >> 4, ch = ci & 15; const v4u w = *(const v4u*)(src + (size_t)rr * r * ld + ch * 8);
            LAS unsigned* d2 = (LAS unsigned*)(scr + rr * 264 + ch * 16); d2[0] = w.x; d2[1] = w.y; d2[2] = w.z; d2[3] = w.w; }
        LDS_FENCE();
        bf16* dst = VT + ((size_t)(b * NH + head0 + hh) * 128) * TL + pp0;
#pragma unroll
        for (int k = 0; k < 8; ++k) { const int ci = lane + 64 * k, d = ci >> 2, q4 = ci & 3; const LAS bf16* s = (const LAS bf16*)(scr + (8 * q4) * 264 + 2 * d);
            v4u o; o.x = (unsigned)s[0] | ((unsigned)s[132] << 16); o.y = (unsigned)s[2 * 132] | ((unsigned)s[3 * 132] << 16); o.z = (unsigned)s[4 * 132] | ((unsigned)s[5 * 132] << 16); o.w = (unsigned)s[6 * 132] | ((unsigned)s[7 * 132] << 16);
            *(v4u*)(dst + (size_t)d * TL + 8 * q4) = o; }
        LDS_FENCE();
    }
}
__device__ __forceinline__ void moba_sel_row(const Ctx& c, LAS float* qs, const bf16* Y, const float* kmean, unsigned* SELM, int b, int h, int t) {
    const int lane = c.lane; const size_t row = (size_t)b * T + t;
    load_q(qs, Y + row * EVEN_LD + C_MQ + h * 128, lane);
    const int cur = t >> 8;
    float gate = NEG_INF;
    if (lane < cur) { const float* km = kmean + ((size_t)(b * 16 + h) * 8 + lane) * 128; float s = 0.f; for (int d = 0; d < 128; ++d) s += qs[d] * km[d]; gate = s; }
    int rank = 0;
    for (int m2 = 0; m2 < 8; ++m2) { const float gm = rdlane(gate, m2); rank += (gm > gate || (gm == gate && m2 < lane)) ? 1 : 0; }
    const unsigned selmask = (unsigned)__ballot((lane < cur) && (rank < 3));
    if (lane == 0) SELM[(size_t)(b * 16 + h) * T + t] = selmask;
}
__device__ __forceinline__ void nsa_cmp_item(const Ctx& c, LAS float* qs, LAS float* ps, const bf16* Y, const bf16* KCN, const bf16* VCN, bf16* OC, unsigned* SELN, int b, int g, int t) {
    const int lane = c.lane; const size_t row = (size_t)b * T + t;
    const bf16* Kc = KCN + (size_t)(b * 4 + g) * 128 * 128; const bf16* Vc = VCN + (size_t)(b * 4 + g) * 128 * 128;
    float P0 = 0.f, P1 = 0.f;
    const int n0 = lane, n1 = 64 + lane; const bool v0 = 16 * n0 + 31 <= t, v1 = (n1 < 127) && (16 * n1 + 31 <= t);
#pragma unroll 1
    for (int hh = 0; hh < 4; ++hh) {
        const int h = g * 4 + hh;
        load_q(qs, Y + row * EVEN_LD + C_NQ + h * 128, lane);
        float s0 = dot128(qs, Kc + (v0 ? n0 : 0) * 128) * ATT_SCALE, s1 = dot128(qs, Kc + (v1 ? n1 : 0) * 128) * ATT_SCALE;
        if (!v0) s0 = NEG_INF; if (!v1) s1 = NEG_INF;
        const float m = wmax(fmaxf(s0, s1)); float a0 = 0.f, a1 = 0.f;
        if (m != NEG_INF) {
            float p0 = __expf(s0 - m), p1 = __expf(s1 - m);
            const float inv = 1.0f / fmaxf(wsum(p0 + p1), 1e-30f);
            p0 *= inv; p1 *= inv; P0 += p0; P1 += p1;
            pv_accum(a0, a1, p0, n0 * 128, Vc, lane); pv_accum(a0, a1, p1, (v1 ? n1 : 0) * 128, Vc, lane);
        }
        *(unsigned*)(OC + row * 2048 + h * 128 + 2 * lane) = pk2(a0, a1);
    }
    LDS_FENCE(); ps[lane] = P0; ps[64 + lane] = P1; LDS_FENCE();
    float imp = 0.f;
    if (lane < 32) { for (int n = 4 * lane - 1; n <= 4 * lane + 3; ++n) if (n >= 0 && n < 127) imp += ps[n]; }
    const int cur = t >> 6;
    const float v = (lane >= 32) ? NEG_INF : ((lane == cur || lane == 0) ? __builtin_inff() : (lane <= cur ? imp : NEG_INF));
    int rank = 0;
    for (int m2 = 0; m2 < 32; ++m2) { const float vm = rdlane(v, m2); rank += (vm > v || (vm == v && m2 < lane)) ? 1 : 0; }
    const unsigned selmask = (unsigned)__ballot(lane < 32 && lane <= cur && rank < 16);
    if (lane == 0) SELN[(size_t)(b * 4 + g) * T + t] = selmask;
}
__device__ __forceinline__ void nsa_combine(const Ctx& c, const bf16* Y, const bf16* OC, const bf16* OS, const bf16* OW, bf16* O) {
    const int lane = c.lane;
    for (int it = c.gw; it < MTOK * 16; it += c.ngw) {
        const int row = it >> 4, h = it & 15; const size_t off = (size_t)row * 2048 + h * 128 + 2 * lane;
        const bf16* gl = Y + (size_t)row * EVEN_LD + C_GL + h * 3;
        const float g0 = 1.0f / (1.0f + __expf(-bf2f(gl[0]))), g1 = 1.0f / (1.0f + __expf(-bf2f(gl[1]))), g2 = 1.0f / (1.0f + __expf(-bf2f(gl[2])));
        const unsigned wc = *(const unsigned*)(OC + off), wsv = *(const unsigned*)(OS + off), ww = *(const unsigned*)(OW + off);
        *(unsigned*)(O + (size_t)row * DM + 2048 + h * 128 + 2 * lane) = pk2(g0 * bflo(wc) + g1 * bflo(wsv) + g2 * bflo(ww), g0 * bfhi(wc) + g1 * bfhi(wsv) + g2 * bfhi(ww));
    }
}
__device__ __forceinline__ void dil_combine(const Ctx& c, const bf16* OG, const float* LSE, bf16* O) {
    const int lane = c.lane;
    for (int it = c.gw; it < MTOK * 8; it += c.ngw) {
        const int row = it >> 3, hd = it & 7; const size_t off = (size_t)row * 1024 + hd * 128 + 2 * lane;
        const float l0 = LSE[(size_t)row * 8 + hd], l1 = LSE[(size_t)MTOK * 8 + (size_t)row * 8 + hd], l2 = LSE[(size_t)2 * MTOK * 8 + (size_t)row * 8 + hd];
        const float mx = fmaxf(l0, fmaxf(l1, l2)); const float w0 = __expf(l0 - mx), w1 = __expf(l1 - mx), w2 = __expf(l2 - mx), iw = 1.0f / (w0 + w1 + w2);
        const unsigned a = *(const unsigned*)(OG + off), bq = *(const unsigned*)(OG + (size_t)MTOK * 1024 + off), cq = *(const unsigned*)(OG + (size_t)2 * MTOK * 1024 + off);
        *(unsigned*)(O + (size_t)row * DM + 3072 + hd * 128 + 2 * lane) = pk2((w0 * bflo(a) + w1 * bflo(bq) + w2 * bflo(cq)) * iw, (w0 * bfhi(a) + w1 * bfhi(bq) + w2 * bfhi(cq)) * iw);
    }
}
__device__ __forceinline__ int snake(int round, int b, int G) { return (round & 1) ? round * G + (G - 1 - b) : round * G + b; }

struct Args { const float* in[31]; float* out; unsigned char* ws; int ph_lo, ph_hi; };
#if MK_ONE_LAUNCH
#define GRID_BAR() xcd_barrier(bar)
#else
#define GRID_BAR() do { } while (0)
#endif
#define IN(k) (lo <= (k) && (k) < hi)
#define SEAM(k) do { if (IN(k) && IN((k) + 1)) GRID_BAR(); if (PROBE_MASK != 0ull) { const unsigned long long now_ = __builtin_amdgcn_s_memrealtime(); if ((PROBE_MASK >> (k)) & 1ull) pacc += now_ - pprev; pprev = now_; } } while (0)
template <int layer>
__device__ __forceinline__ void run_layer(const Args& args, const Ctx& c, const XcdBarrier& bar, const int lo, const int hi, unsigned long long& pprev, unsigned long long& pacc) {
    unsigned char* ws = args.ws;
    const float* x_in = args.in[0]; const float* mem = args.in[1]; const int* positions = (const int*)args.in[2];
    float* ropec = (float*)(ws + WS_ROPE); float* ropes = ropec + MTOK * 64;
    float* kmean = (float*)(ws + WS_KMEAN); float* KCR = (float*)(ws + WS_QP); float* VCR = (float*)(ws + WS_QP + 4 * MiB);
    bf16* KCN = (bf16*)(ws + WS_KCN); bf16* VCN = (bf16*)(ws + WS_VCN); bf16* MEMN = (bf16*)(ws + WS_MEMN);
    bf16* QX = (bf16*)(ws + WS_QX); bf16* KVX = (bf16*)(ws + WS_KVX); bf16* OX = (bf16*)(ws + WS_OX);
    bf16* WQ_T = (bf16*)(ws + WS_WQ); bf16* WKV_T = (bf16*)(ws + WS_WKV); bf16* WO_T = (bf16*)(ws + WS_WO); bf16* WOUT_T = (bf16*)(ws + WS_WOUT);
    bf16* WIN_T = (bf16*)(ws + (layer == 0 ? WS_WIN : WS_WIN1)); bf16* WGU_T = (bf16*)(ws + WS_WGU); bf16* WD_T = (bf16*)(ws + (layer == 0 ? WS_WD : WS_WD1));
    float* X = (float*)(ws + WS_X); bf16* H = (bf16*)(ws + WS_H); bf16* O = (bf16*)(ws + WS_O); bf16* Y = (bf16*)(ws + WS_Y); bf16* HID = Y;
    LAS float* qs = (LAS float*)(c.lds + c.wave * 16384); LAS float* ps = qs + 128;
    float* SSQ = (float*)(ws + WS_CTL) + CW_SSQ;
    float* QP = (float*)(ws + WS_QP); bf16* MEMN2 = (bf16*)(ws + WS_MEMN2); bf16* KVX2 = (bf16*)(ws + WS_KVX2); bf16* WKV2 = (bf16*)(ws + WS_WKV2); bf16* KVXL = KVX2 + (size_t)layer * 1024 * 2048;
    bf16* PHIKT = (bf16*)(ws + WS_PHIK); bf16* PHIVT = (bf16*)(ws + WS_PHIV); float* CBIAS = (float*)(ws + WS_CBIAS);
    bf16* VT = (bf16*)(ws + WS_VT); bf16* PART = (bf16*)(ws + WS_PART); bf16* VTX = (bf16*)(ws + WS_VTX); unsigned* SELM = (unsigned*)(ws + WS_SELM); unsigned* SELN = (unsigned*)(ws + WS_SELN);
    constexpr int pb = layer * NPL; constexpr bool even = (layer & 1) == 0;
    const int e_rem1 = ((MTOK / 256) * (EVEN_LD / 256)) % c.G, e_ns1 = e_rem1 ? (c.G - e_rem1 - 32 > 0 ? c.G - e_rem1 - 32 : 0) : 0;
    const int e_rem2 = ((MTOK / 256) * (GU_ROWS / 256)) % c.G, e_ns2 = e_rem2 ? c.G - e_rem2 : 0;
    const int e_ns3 = c.G > 128 ? c.G - 128 : 0, e_it3x = e_ns3 * 8 * EARLY_N4;
    const int e_it1 = e_ns1 * 8 * EARLY_N1, e_it2 = e_it1 + e_ns2 * 8 * EARLY_N2;
#if FUSE_HEADNORM
#define WIN1_RM RmHeads{0x0FFFFFF000000000ull, 0ull}
#else
#define WIN1_RM RmId{0}
#endif

        const int LDY = even ? EVEN_LD : ODD_LD;
        const float* xcur = layer == 0 ? x_in : X;
        if (IN(pb + 0)) REPS(pb + 0) {
#if FUSE_HEADNORM
            if (even) conv_weight(c, args.in[4], DM, EVEN_N, EVEN_LD, WIN_T, RmHeads{0x330ff00ffffull, 0ull}, layer == 0 ? nullptr : args.in[3] + layer * DM); else conv_weight(c, args.in[16], DM, ODD_LD, ODD_LD, WIN_T, RmHeads{0x0FFFFFF000000000ull, 0ull}, layer == 0 ? nullptr : args.in[3] + layer * DM, layer == 1 ? e_it2 + e_it3x : 0);
#else
            if (even) conv_weight(c, args.in[4], DM, EVEN_N, EVEN_LD, WIN_T, RmId{0}, layer == 0 ? nullptr : args.in[3] + layer * DM); else conv_weight(c, args.in[16], DM, ODD_LD, ODD_LD, WIN_T, RmId{0}, layer == 0 ? nullptr : args.in[3] + layer * DM, layer == 1 ? e_it2 + e_it3x : 0);
#endif
            conv_weight(c, even ? args.in[5] : args.in[17], DM, DM, DM, WOUT_T, RmId{0});
            conv_weight(c, args.in[22] + (size_t)layer * DM * XW, DM, XW, XW, WQ_T, RmId{0}, args.in[20] + layer * DM);
            if constexpr (layer == 0) { conv_weight(c, args.in[23], DM, 2 * XW, 2 * XW, WKV2, RmId{0}); conv_weight(c, args.in[23] + (size_t)DM * 2 * XW, DM, 2 * XW, 2 * XW, WKV2, RmId{1024}); }
            conv_weight(c, args.in[24] + (size_t)layer * XW * DM, XW, DM, DM, WO_T, RmId{0});
            conv_weight(c, args.in[28] + (size_t)layer * DM * FFN, DM, FFN, FFN, WGU_T, RmGU{0}, args.in[27] + layer * DM);
            conv_weight(c, args.in[29] + (size_t)layer * DM * FFN, DM, FFN, FFN, WGU_T, RmGU{1}, args.in[27] + layer * DM);
            conv_weight(c, args.in[30] + (size_t)layer * FFN * DM, FFN, DM, DM, WD_T, RmId{0}, nullptr, layer == 1 ? e_it3x : 0);
            if (layer == 0) rope_table(c, positions, ropec, ropes);
            if constexpr (even) { conv_weight(c, args.in[14], 4096, 128, 128, PHIKT, RmId{0}); conv_weight(c, args.in[15], 4096, 128, 128, PHIVT, RmId{0}); cmp_bias(c, args.in[12], args.in[13], args.in[14], args.in[15], CBIAS); }
            if constexpr (layer == 0) { rmsnorm_rows(c, mem, args.in[21], MEMN2, MEM_ROWS); rmsnorm_rows(c, mem, args.in[21] + DM, MEMN2 + (size_t)MEM_ROWS * DM, MEM_ROWS); }
            if constexpr (layer == 0) rmsnorm_rows(c, xcur, args.in[3] + layer * DM, H, MTOK);
        }
        SEAM(pb + 0);
        if (IN(pb + 1)) REPS(pb + 1) {
            pg8::Gemm g{H, WIN_T, MTOK, LDY, DM, DM}; pg8::StaticOrder S; S.init(MTOK, LDY, c.G, (int)blockIdx.x);
#if FUSE_HEADNORM
            pg8::HeadSpec hs{};
            if (even) { hs.lo[0] = 0; hs.hi[0] = 8; hs.g[0] = args.in[6]; hs.lo[1] = 8; hs.hi[1] = 16; hs.g[1] = args.in[7]; hs.lo[2] = 24; hs.hi[2] = 32; hs.g[2] = args.in[8]; hs.lo[3] = 36; hs.hi[3] = 38; hs.g[3] = args.in[10]; hs.lo[4] = 40; hs.hi[4] = 42; hs.g[4] = args.in[11]; }
            else { hs.lo[0] = 36; hs.hi[0] = 48; hs.g[0] = args.in[18]; hs.lo[1] = 48; hs.hi[1] = 60; hs.g[1] = args.in[19]; }
            pg8::EpiYHeads E{Y, LDY, layer == 0 ? nullptr : SSQ + (size_t)((layer - 1) * 3 + 2) * MTOK, hs, ropec, ropes, (LAS float*)(c.lds + 132096)};
            pg8::gemm_phase<pg8::EpiYHeads, pg8::StaticOrder, true, true>(c.lds, g, S, E);
#else
            pg8::EpiBf16P E{Y, LDY, layer == 0 ? nullptr : SSQ + (size_t)((layer - 1) * 3 + 2) * MTOK};
            pg8::gemm_phase<pg8::EpiBf16P, pg8::StaticOrder, true, true>(c.lds, g, S, E);
#endif
            if constexpr (layer == 0) {
                pg8::Gemm g2{MEMN2, WKV2, 2 * MEM_ROWS, 2 * 1024, DM, DM}; pg8::DiagOrder S2; S2.init(2, 4, 4, c.G, c.G - 1 - (int)blockIdx.x); pg8::EpiBf16P E2{KVX2, 2048, nullptr};
                pg8::gemm_phase<pg8::EpiBf16P, pg8::DiagOrder, true, true>(c.lds, g2, S2, E2);
                const int j1 = (int)blockIdx.x - e_rem1;
                if (j1 >= 0 && j1 < e_ns1) { __syncthreads(); conv_weight<decltype(WIN1_RM), EARLY_NT != 0>(c, args.in[16], DM, ODD_LD, ODD_LD, (bf16*)(ws + WS_WIN1), WIN1_RM, args.in[3] + DM, 0, e_it1, j1 * 8 + c.wave, e_ns1 * 8); }
            }
        }
        SEAM(pb + 1);
        if constexpr (even || !FUSE_HEADNORM) {
        if (IN(pb + 2)) REPS(pb + 2) {
            if (even) {
#if !FUSE_HEADNORM
                headnorm_bf16(c, Y, EVEN_LD, C_MQ, 16, MTOK, args.in[6], ropec, ropes);
                headnorm_bf16(c, Y, EVEN_LD, C_MK, 16, MTOK, args.in[7], ropec, ropes);
                headnorm_bf16(c, Y, EVEN_LD, C_NQ, 16, MTOK, args.in[8], ropec, ropes);
                headnorm_bf16(c, Y, EVEN_LD, C_KS, 4, MTOK, args.in[10], ropec, ropes);
                headnorm_bf16(c, Y, EVEN_LD, C_KW, 4, MTOK, args.in[11], ropec, ropes);
#endif
                cmp_mfma(c, Y, PHIKT, PHIVT, KCR, VCR);
#if FUSE_HEADNORM
                moba_kmean(c, Y, kmean);
#endif
            } else {
#if !FUSE_HEADNORM
                headnorm_bf16(c, Y, ODD_LD, C_DQ, 24, MTOK, args.in[18], ropec, ropes);
                headnorm_bf16(c, Y, ODD_LD, C_DK, 24, MTOK, args.in[19], ropec, ropes);
#endif
            }
        }
        SEAM(pb + 2);
        }
        if constexpr (even) {
            if (IN(pb + 3)) REPS(pb + 3) { cmp_finish(c, KCR, VCR, CBIAS, KCN, VCN, args.in[9], ropec, ropes); if (!FUSE_HEADNORM) moba_kmean(c, Y, kmean); }
            SEAM(pb + 3);
            if (IN(pb + 4)) REPS(pb + 4) {
#if FA_EVEN
                for (int idx = (int)blockIdx.x; idx < NB * 4 * 32; idx += c.G) { const int tt = 31 - (idx >> 4), bg = idx & 15, b = bg >> 2, g = bg & 3; const size_t r0 = (size_t)b * T + 64 * tt;
                    fa::cmp_unit(c, Y + r0 * EVEN_LD + C_NQ + 4 * g * 128, EVEN_LD, KCN + (size_t)bg * 128 * 128, VCN + (size_t)bg * 128 * 128, PART + r0 * 2048 + 4 * g * 128, SELN + (size_t)bg * T + 64 * tt, tt); }
#endif
            }
            SEAM(pb + 4);
        }
        if (IN(pb + 5)) REPS(pb + 5) {
            if constexpr (even && !FA_EVEN) {
                for (int it = c.gw; it < NB * 16 * T; it += c.ngw) { const int bh = it >> 11; moba_row(c, qs, Y, kmean, O, bh >> 4, bh & 15, spread_t(it)); }
                for (int it = c.gw; it < NB * 4 * T; it += c.ngw) { const int bg = it >> 11; nsa_item(c, qs, ps, Y, KCN, VCN, O, bg >> 2, bg & 3, spread_t(it)); }
            } else if constexpr (!even && !FA_ODD) {
                for (int it = c.gw; it < NB * 24 * T; it += c.ngw) { const int bh = it >> 11; sb_row(c, qs, Y, O, bh / 24, bh % 24, spread_t(it)); }
                for (int it = c.gw; it < NB * 8 * T; it += c.ngw) { const int bh = it >> 11; dil_row(c, qs, Y, O, bh >> 3, bh & 7, spread_t(it)); }
            } else if constexpr (even) {
                bf16* OS = PART + (size_t)MTOK * 2048; bf16* OW = PART + (size_t)2 * MTOK * 2048;
                for (int blk = (int)blockIdx.x; blk < 256; blk += c.G)
#pragma unroll 1
                for (int round = 0; round < 3; ++round) {
                    const int xcd = blk & 7, slot = blk >> 3;
#pragma unroll 1
                    for (int half = 0; half < 2; ++half) {
                        fa::Unit u; u.qp = nullptr; u.qgain = nullptr; u.qssq = nullptr; u.qps = 0; u.comb_gl = nullptr; u.comb_oc = nullptr; u.comb_os = nullptr; u.comb_gls = 0; u.kmean = nullptr; u.lse = nullptr; u.lse_stride = 0; u.causal = 1; u.nrows = 256; u.qstride = EVEN_LD; u.kstride = EVEN_LD; u.vstride = EVEN_LD; u.sel_stride = 1; u.t_lo = 0; u.window = 1 << 30;
                        u.sel = nullptr; u.sel_shift = 0; u.own_blk = -1;
                        if (round == 0) {
                            const int fam = xcd * 8 + (slot >> 2), pr = slot & 3, qb = half ? pr : 7 - pr, b = fam >> 4, h = fam & 15; const size_t r0 = (size_t)b * T + 256 * qb;
                            u.pos0 = 256 * qb; u.t_hi = 4 * qb + 4;
                            u.q = Y + r0 * EVEN_LD + C_MQ + h * 128; u.k = Y + (size_t)b * T * EVEN_LD + C_MK + h * 128; u.v = Y + (size_t)b * T * EVEN_LD + C_MV + h * 128;
                            u.o = O + r0 * DM + h * 128; u.ostride = DM; u.kmean = kmean + (size_t)(b * 16 + h) * 8 * 128; u.sel_shift = 2; u.own_blk = qb;
                        } else {
                            const int fam = xcd * 2 + (slot >> 4), j = slot & 15, hh = j >> 2, pr = j & 3, b = fam >> 2, g = fam & 3, h = g * 4 + hh;
                            const int qb = half ? pr : 7 - pr; const size_t r0 = (size_t)b * T + 256 * qb;
                            u.pos0 = 256 * qb; u.t_hi = 4 * qb + 4; u.q = Y + r0 * EVEN_LD + C_NQ + h * 128; u.ostride = 2048;
                            if (round == 1) { u.k = Y + (size_t)b * T * EVEN_LD + C_KS + g * 128; u.v = Y + (size_t)b * T * EVEN_LD + C_VS + g * 128; u.o = OS + r0 * 2048 + h * 128; u.sel = SELN + (size_t)(b * 4 + g) * T + 256 * qb; }
                            else { u.k = Y + (size_t)b * T * EVEN_LD + C_KW + g * 128; u.v = Y + (size_t)b * T * EVEN_LD + C_VW + g * 128; u.t_lo = qb >= 2 ? 4 * qb - 8 : 0; u.window = 512;
                                u.o = O + r0 * DM + 2048 + h * 128; u.ostride = DM; u.comb_oc = PART + r0 * 2048 + h * 128; u.comb_os = OS + r0 * 2048 + h * 128; u.comb_gl = Y + r0 * EVEN_LD + C_GL + h * 3; u.comb_gls = EVEN_LD; }
                        }
                        fa::run_unit<0>(c, u);
                    }
                }
            } else {
                float* LSE = (float*)(ws + WS_LSE);
                if constexpr (!FA_SB) { for (int it = c.gw; it < NB * 24 * T; it += c.ngw) { const int bh = it >> 11; sb_row(c, qs, Y, O, bh / 24, bh % 24, spread_t(it)); } }
                if constexpr (!FA_DIL) { for (int it = c.gw; it < NB * 8 * T; it += c.ngw) { const int bh = it >> 11; dil_row(c, qs, Y, O, bh >> 3, bh & 7, spread_t(it)); } }
                for (int round = 0; round < 7 * 256 / c.G + 1; ++round) {
                    const int idx = snake(round, (int)blockIdx.x, c.G); if (idx >= 1792) continue;
                    if (!FA_SB && idx < 768) continue;
                    if (!FA_DIL && idx >= 768) continue;
#ifdef PROBE_SKIP_DIL
                    if (idx >= 768) continue;
#endif
#ifdef PROBE_SKIP_SB
                    if (idx < 768) continue;
#endif
                    fa::Unit u; u.qp = nullptr; u.qgain = nullptr; u.qssq = nullptr; u.qps = 0; u.comb_gl = nullptr; u.comb_oc = nullptr; u.comb_os = nullptr; u.comb_gls = 0; u.kmean = nullptr; u.lse = nullptr; u.lse_stride = 0; u.causal = 1; u.nrows = 256; u.qstride = ODD_LD; u.kstride = ODD_LD; u.vstride = ODD_LD; u.sel = nullptr; u.sel_stride = 0; u.sel_shift = 0; u.own_blk = -1; u.t_lo = 0; u.window = 1 << 30;
                    if (idx < 768) {
                        const int qb = 7 - idx / 96, bh = idx % 96, b = bh / 24, h = bh % 24; const size_t r0 = (size_t)b * T + 256 * qb;
                        u.pos0 = 256 * qb; u.t_hi = 4 * qb + 4;
                        u.q = Y + r0 * ODD_LD + C_SQ + h * 128; u.k = Y + (size_t)b * T * ODD_LD + C_SK + h * 128; u.v = Y + (size_t)b * T * ODD_LD + C_SV + h * 128; u.o = O + r0 * DM + h * 128; u.ostride = DM;
                        fa::run_unit<1>(c, u);
                    } else {
                        int gi, r, b, hd, cls, un;
                        if (idx < 1024) { const int j = idx - 768; gi = 0; r = 1; un = j & 7; hd = (j >> 3) & 7; b = j >> 6; cls = 0; }
                        else if (idx < 1280) { const int j = idx - 1024; gi = 1; r = 4; un = j & 1; cls = (j >> 1) & 3; hd = (j >> 3) & 7; b = j >> 6; }
                        else { const int j = idx - 1280; gi = 2; r = 16; un = 0; cls = j & 15; hd = (j >> 4) & 7; b = j >> 7; }
                        const int nd = gi * 8 + hd, CL = T / r; const size_t tok0 = (size_t)b * T + cls + (size_t)r * 256 * un;
                        u.nrows = CL < 256 ? CL : 256; u.pos0 = 256 * un; u.t_lo = un > 0 ? 4 * un - 2 : 0; u.t_hi = (4 * un + 4) < CL / 64 ? (4 * un + 4) : CL / 64; u.window = 129;
                        u.qstride = r * ODD_LD; u.kstride = r * ODD_LD; u.vstride = r * ODD_LD;
                        u.q = Y + tok0 * ODD_LD + C_DQ + nd * 128; u.k = Y + ((size_t)b * T + cls) * ODD_LD + C_DK + nd * 128; u.v = Y + ((size_t)b * T + cls) * ODD_LD + C_DV + nd * 128;
                        u.o = PART + (size_t)gi * MTOK * 1024 + tok0 * 1024 + hd * 128; u.ostride = r * 1024; u.lse = LSE + (size_t)gi * MTOK * 8 + tok0 * 8 + hd; u.lse_stride = r * 8;
                        fa::run_unit<0>(c, u);
                    }
                }
            }
        }
        SEAM(pb + 5);
        if constexpr (!even) {
            if (IN(pb + 6)) REPS(pb + 6) { if constexpr (FA_ODD && FA_DIL) dil_combine(c, PART, (const float*)(ws + WS_LSE), O); }
            SEAM(pb + 6);
        }
        if (IN(pb + 7)) REPS(pb + 7) {
            pg8::Gemm g{O, WOUT_T, MTOK, DM, DM, DM}; pg8::StaticOrder S; S.init(MTOK, DM, c.G, (int)blockIdx.x);
#if RES_BF16
            if constexpr (layer == 0) { pg8::EpiResBf16N<float> E{x_in, DM, H, SSQ + (size_t)(layer * 3 + 0) * MTOK}; pg8::gemm_phase<pg8::EpiResBf16N<float>, pg8::StaticOrder, true, true>(c.lds, g, S, E); }
            else { pg8::EpiResBf16N<bf16> E{H, DM, H, SSQ + (size_t)(layer * 3 + 0) * MTOK}; pg8::gemm_phase<pg8::EpiResBf16N<bf16>, pg8::StaticOrder, true, true>(c.lds, g, S, E); }
#else
            pg8::EpiResF32N E{xcur, X, DM, H, SSQ + (size_t)(layer * 3 + 0) * MTOK};
            pg8::gemm_phase<pg8::EpiResF32N, pg8::StaticOrder, true, true>(c.lds, g, S, E);
#endif
        }
        SEAM(pb + 7);
        if (IN(pb + 9)) REPS(pb + 9) {
            pg8::Gemm g{H, WQ_T, MTOK, XW, DM, DM / 4}; pg8::SplitKOrder S; S.init(MTOK, XW, 4, c.G, (int)blockIdx.x); pg8::EpiF32Part E{QP, XW, (size_t)MTOK * XW};
            pg8::gemm_phase<pg8::EpiF32Part, pg8::SplitKOrder, true, true>(c.lds, g, S, E);
            headnorm_bf16(c, KVXL, 2048, layer * 1024, 4, MEM_ROWS, args.in[26] + layer * HD, nullptr, nullptr);
        }
        SEAM(pb + 9);
        if (IN(pb + 11)) REPS(pb + 11) {
            if constexpr (!FA_XATTN) { for (int it = c.gw; it < NB * 4 * T; it += c.ngw) { const int bh = it >> 11; xattn_row(c, qs, QX, KVX, OX, bh >> 2, bh & 3, it & (T - 1)); } }
            else for (int idx = (int)blockIdx.x; idx < 128; idx += c.G) {
                const int qb = idx & 7, bh = idx >> 3, b = bh >> 2, h = bh & 3; const size_t r0 = (size_t)b * T + 256 * qb;
                fa::Unit u; u.qp = nullptr; u.qgain = nullptr; u.qssq = nullptr; u.qps = 0; u.comb_gl = nullptr; u.comb_oc = nullptr; u.comb_os = nullptr; u.comb_gls = 0; u.kmean = nullptr; u.lse = nullptr; u.lse_stride = 0; u.causal = 0; u.nrows = 256; u.qstride = XW; u.kstride = 2048; u.vstride = 2048; u.sel = nullptr; u.sel_stride = 0; u.sel_shift = 0; u.own_blk = -1;
                u.t_lo = 0; u.t_hi = 4; u.window = 1 << 30; u.pos0 = 0;
                u.q = nullptr; u.qp = QP + r0 * XW + h * 128; u.qps = (size_t)MTOK * XW; u.qgain = args.in[25] + layer * HD; u.qssq = SSQ + (size_t)(layer * 3 + 0) * MTOK + r0; u.k = KVXL + (size_t)b * MEM_LEN * 2048 + layer * 1024 + h * 128; u.v = KVXL + (size_t)b * MEM_LEN * 2048 + layer * 1024 + XW + h * 128; u.o = OX + r0 * XW + h * 128; u.ostride = XW;
                fa::run_unit<0>(c, u);
            }
            if (FA_XATTN && e_it3x > 0 && (int)blockIdx.x >= 128) { const int j3 = (int)blockIdx.x - 128; __syncthreads();
                if constexpr (layer == 0) conv_weight<decltype(WIN1_RM), EARLY_NT != 0>(c, args.in[16], DM, ODD_LD, ODD_LD, (bf16*)(ws + WS_WIN1), WIN1_RM, args.in[3] + DM, e_it2, e_it2 + e_it3x, j3 * 8 + c.wave, e_ns3 * 8);
                else conv_weight<RmId, EARLY_NT != 0>(c, args.in[30] + (size_t)FFN * DM, FFN, DM, DM, WD_T, RmId{0}, nullptr, 0, e_it3x, j3 * 8 + c.wave, e_ns3 * 8); }
        }
        SEAM(pb + 11);
        if (IN(pb + 12)) REPS(pb + 12) {
            pg8::Gemm g{OX, WO_T, MTOK, DM, XW, XW}; pg8::StaticOrder S; S.init(MTOK, DM, c.G, (int)blockIdx.x);
#if RES_BF16
            pg8::EpiResBf16N<bf16> E{H, DM, H, SSQ + (size_t)(layer * 3 + 1) * MTOK}; pg8::gemm_phase<pg8::EpiResBf16N<bf16>, pg8::StaticOrder, true, true>(c.lds, g, S, E);
#else
            pg8::EpiResF32N E{X, X, DM, H, SSQ + (size_t)(layer * 3 + 1) * MTOK};
            pg8::gemm_phase<pg8::EpiResF32N, pg8::StaticOrder, true, true>(c.lds, g, S, E);
#endif
        }
        SEAM(pb + 12);
        if (IN(pb + 14)) REPS(pb + 14) {
            pg8::Gemm g{H, WGU_T, MTOK, GU_ROWS, DM, DM}; pg8::StaticOrder S; S.init(MTOK, GU_ROWS, c.G, (int)blockIdx.x);
            pg8::EpiSwiGLU E{HID, FFN, SSQ + (size_t)(layer * 3 + 1) * MTOK};
            pg8::gemm_phase<pg8::EpiSwiGLU, pg8::StaticOrder, true, true>(c.lds, g, S, E);
            if constexpr (layer == 0) { const int j2 = (int)blockIdx.x - e_rem2;
                if (e_ns2 > 0 && j2 >= 0) { __syncthreads(); conv_weight<decltype(WIN1_RM), EARLY_NT != 0>(c, args.in[16], DM, ODD_LD, ODD_LD, (bf16*)(ws + WS_WIN1), WIN1_RM, args.in[3] + DM, e_it1, e_it2, j2 * 8 + c.wave, e_ns2 * 8); } }
        }
        SEAM(pb + 14);
        if (IN(pb + 15)) REPS(pb + 15) {
            pg8::Gemm g{HID, WD_T, MTOK, DM, FFN, FFN}; pg8::StaticOrder S; S.init(MTOK, DM, c.G, (int)blockIdx.x);
#if RES_BF16
            if constexpr (layer == 1) { pg8::EpiOutBf16Res E{H, args.out, DM}; pg8::gemm_phase<pg8::EpiOutBf16Res, pg8::StaticOrder, true, true>(c.lds, g, S, E); }
            else { pg8::EpiResBf16N<bf16> E{H, DM, H, SSQ + (size_t)(layer * 3 + 2) * MTOK}; pg8::gemm_phase<pg8::EpiResBf16N<bf16>, pg8::StaticOrder, true, true>(c.lds, g, S, E); }
#else
            if constexpr (layer == 1) { pg8::EpiResF32 E{X, args.out, DM}; pg8::gemm_phase<pg8::EpiResF32, pg8::StaticOrder, true, true>(c.lds, g, S, E); }
            else { pg8::EpiResF32N E{X, X, DM, H, SSQ + (size_t)(layer * 3 + 2) * MTOK}; pg8::gemm_phase<pg8::EpiResF32N, pg8::StaticOrder, true, true>(c.lds, g, S, E); }
#endif
        }
        if constexpr (layer == 0) { if (PROBE_MASK != 0ull) SEAM(pb + 15); } else if (PROBE_MASK != 0ull) { GRID_BAR(); const unsigned long long now_ = __builtin_amdgcn_s_memrealtime(); if ((PROBE_MASK >> (pb + 15)) & 1ull) pacc += now_ - pprev; pprev = now_; }
}
__global__ void __launch_bounds__(NWAVES * 64, 2) fwd(Args args) {
    extern __shared__ __attribute__((aligned(16))) unsigned char lds_raw[];
    Ctx c; c.lds = (LAS unsigned char*)lds_raw; c.tid = threadIdx.x; c.lane = c.tid & 63; c.wave = __builtin_amdgcn_readfirstlane(c.tid >> 6);
    c.G = gridDim.x; c.gw = blockIdx.x * NWAVES + c.wave; c.ngw = c.G * NWAVES;
    unsigned* ctl = (unsigned*)(args.ws + WS_CTL);
    for (int u = c.tid; u < (LDS_BYTES - LDSCTL_OFF) / 4; u += NWAVES * 64) ((LAS unsigned*)(c.lds + LDSCTL_OFF))[u] = 0u;
    __syncthreads();
#if MK_ONE_LAUNCH
    XcdBarrier bar = xcd_barrier_post(ctl + CW_BAR, (volatile LAS unsigned*)(c.lds + MISC_OFF + 32));
#else
    XcdBarrier bar; bar.bar = ctl + CW_BAR; bar.x = 0; bar.st = nullptr;
#endif
    const int lo = args.ph_lo, hi = args.ph_hi;
    unsigned long long pprev = 0ull, pacc = 0ull;
    if (PROBE_MASK != 0ull) pprev = __builtin_amdgcn_s_memrealtime();
    run_layer<0>(args, c, bar, lo, hi, pprev, pacc);
    run_layer<1>(args, c, bar, lo, hi, pprev, pacc);
    if (PROBE_MASK != 0ull) { GRID_BAR(); if (blockIdx.x == 0 && c.tid == 0) args.out[0] += ((float)pacc * 0.01f - PROBE_OFF) * PROBE_SCALE; }
}
#undef IN
#undef SEAM

extern "C" void kernel_launch(void* const* d_in, const int* in_sizes, int n_in, void* d_out, int out_size, void* d_ws, size_t ws_size, hipStream_t stream) {
    static int grid = 0;
    if (grid == 0) {
        if (n_in != 31 || out_size != MTOK * DM || ws_size < WS_END) { fprintf(stderr, "kernel_launch: unexpected shapes (n_in %d, out %d, ws %zu)\n", n_in, out_size, ws_size); grid = -1; return; }
        int dev = 0, cus = 0;
        if (hipGetDevice(&dev) != hipSuccess || hipDeviceGetAttribute(&cus, hipDeviceAttributeMultiprocessorCount, dev) != hipSuccess) { grid = -1; return; }
        if (hipFuncSetAttribute((const void*)fwd, hipFuncAttributeMaxDynamicSharedMemorySize, LDS_BYTES) != hipSuccess) { fprintf(stderr, "kernel_launch: hipFuncSetAttribute failed\n"); grid = -1; return; }
        int per_cu = 0;
        if (hipOccupancyMaxActiveBlocksPerMultiprocessor(&per_cu, (const void*)fwd, NWAVES * 64, LDS_BYTES) != hipSuccess || per_cu < 1) fprintf(stderr, "kernel_launch: occupancy query reports %d\n", per_cu);
        (void)hipGetLastError();
        grid = cus;
    }
    if (grid < 0) return;
    (void)hipMemsetAsync((char*)d_ws + WS_CTL, 0, CTL_ZERO_BYTES, stream);
#ifdef EXTRA_MEMSET
    (void)hipMemsetAsync((char*)d_ws + WS_END, 0, 256, stream);
#endif
    Args a{};
    for (int i = 0; i < 31; ++i) a.in[i] = (const float*)d_in[i];
    a.out = (float*)d_out; a.ws = (unsigned char*)d_ws;
#if MK_ONE_LAUNCH
    a.ph_lo = 0; a.ph_hi = NPH;
    hipLaunchKernelGGL(fwd, dim3(grid), dim3(NWAVES * 64), LDS_BYTES, stream, a);
#else
    for (int ph = 0; ph < NPH; ++ph) {
        if (ph == 3 + NPL || ph == 4 + NPL || ph == 6 || (ph % NPL) == 8 || (ph % NPL) == 10 || (ph % NPL) == 13) continue;
        a.ph_lo = ph; a.ph_hi = ph + 1;
        hipLaunchKernelGGL(fwd, dim3(grid), dim3(NWAVES * 64), LDS_BYTES, stream, a);
    }
#endif
}
```
